# Optimizing an MI355X kernel written in HIP

```python
import jax, jax.numpy as jnp
from jax import lax
import numpy as np

D_MODEL = 1024
BATCH = 32
SEQ = 256
DEPTH = 2
DEC_BATCH = 2
DEC_SEQ = 1024
PAST_LEN = 256

GRID_W = 64
RET_HEADS = 8
RET_DK = 64
RET_DV = 64
RET_QK = RET_HEADS * RET_DK
RET_WIDTH = RET_HEADS * RET_DV
RET_CHUNK = 128
RET_DECAY_OFFSET = 5.0
MLA_HEADS = 8
MLA_NOPE = 64
MLA_ROPE = 32
MLA_V = 64
MLA_WIDTH = MLA_HEADS * MLA_V
Q_RANK = 256
KV_RANK = 128
D_MIX = RET_WIDTH + MLA_WIDTH
IN_COLS = 2 * RET_QK + 2 * RET_WIDTH + Q_RANK + KV_RANK + MLA_ROPE
D_FF = ((8 * D_MODEL // 3 + 255) // 256) * 256
N_MOD = 6
ROPE_BASE = 10000.0
ATTN_BLOCK = 128
EPS = 1e-6

kernel_name = 'hybrid_retention_mla_diffusion_step'


def rms_norm(x, g):
    xf = x.astype(jnp.float32)
    y = xf * lax.rsqrt(jnp.mean(xf * xf, axis=-1, keepdims=True) + EPS)
    return (y * g.astype(jnp.float32)).astype(x.dtype)


def heads(t, n_heads):
    b, n, _ = t.shape
    return t.reshape(b, n, n_heads, -1).transpose(0, 2, 1, 3)


def axial_rope(x, row, col):
    d = x.shape[-1]
    half = d // 2
    nf = half // 2
    inv = ROPE_BASE ** (-jnp.arange(nf, dtype=jnp.float32) / nf)

    def rot(xa, pos):
        ang = pos.astype(jnp.float32)[:, None] * inv
        cos, sin = jnp.cos(ang), jnp.sin(ang)
        x1, x2 = xa[..., :nf], xa[..., nf:]
        return jnp.concatenate([x1 * cos - x2 * sin, x1 * sin + x2 * cos], axis=-1)

    xf = x.astype(jnp.float32)
    out = jnp.concatenate([rot(xf[..., :half], row), rot(xf[..., half:], col)], axis=-1)
    return out.astype(x.dtype)


def modulation(cond, w_mod, b_mod):
    m = jax.nn.silu(cond) @ w_mod + b_mod
    return jnp.split(m[..., None, :], N_MOD, axis=-1)


def project(h, w_in, g_q_a, w_q_b, g_kv_a, g_qn, g_qr, g_kr):
    z = h @ w_in
    i1 = RET_QK
    i2 = i1 + RET_QK
    i3 = i2 + RET_WIDTH
    i4 = i3 + RET_WIDTH
    i5 = i4 + Q_RANK
    i6 = i5 + KV_RANK
    rq, rk, rv, rg, qa, kva, kr = jnp.split(z, [i1, i2, i3, i4, i5, i6], axis=-1)
    q = heads(rms_norm(qa, g_q_a) @ w_q_b, MLA_HEADS)
    qn = rms_norm(q[..., :MLA_NOPE], g_qn)
    qr = rms_norm(q[..., MLA_NOPE:], g_qr)
    ckv = rms_norm(kva, g_kv_a)
    kr = rms_norm(kr, g_kr)
    return (heads(rq, RET_HEADS), heads(rk, RET_HEADS) * (RET_DK ** -0.5), heads(rv, RET_HEADS),
            rg, qn, qr, ckv, kr)


def mla_up(ckv, w_kv_b, g_kn):
    kv = heads(ckv @ w_kv_b, MLA_HEADS)
    return rms_norm(kv[..., :MLA_NOPE], g_kn), kv[..., MLA_NOPE:]


def log_gamma(p):
    return jnp.log1p(-jnp.exp2(-p.astype(jnp.float32)))


def retention_chunkwise(q, k, v, lg, s0):
    b, h, n, _ = q.shape
    c = RET_CHUNK
    nc = n // c
    j = jnp.arange(c, dtype=jnp.float32)
    diff = j[:, None] - j[None, :]
    decay_intra = jnp.where(diff >= 0, jnp.exp(jnp.maximum(diff, 0.0)[None] * lg[:, None, None]), 0.0)
    q_decay = jnp.exp((j + 1.0)[None, :] * lg[:, None])[..., None]
    k_decay = jnp.exp((c - 1.0 - j)[None, :] * lg[:, None])[..., None]
    chunk_decay = jnp.exp(c * lg)[:, None, None]

    def to_chunks(t):
        return jnp.moveaxis(t.astype(jnp.float32).reshape(b, h, nc, c, t.shape[-1]), 2, 0)

    def step(s, inp):
        qi, ki, vi = inp
        scores = jnp.einsum('bhid,bhjd->bhij', qi, ki) * decay_intra
        inner = jnp.einsum('bhij,bhjv->bhiv', scores, vi)
        cross = jnp.einsum('bhid,bhdv->bhiv', qi, s) * q_decay
        s_new = s * chunk_decay + jnp.einsum('bhjd,bhjv->bhdv', ki * k_decay, vi)
        return s_new, inner + cross

    s_fin, out = lax.scan(step, s0.astype(jnp.float32), (to_chunks(q), to_chunks(k), to_chunks(v)))
    return jnp.moveaxis(out, 0, 2).reshape(b, h, n, -1), s_fin


def bidir_retention(q, k, v, p_fwd, p_bwd, s_f0, s_b0):
    o_f, s_f = retention_chunkwise(q, k, v, log_gamma(p_fwd), s_f0)
    flip = lambda t: jnp.flip(t, axis=2)
    o_b, s_b = retention_chunkwise(flip(q), flip(k), flip(v), log_gamma(p_bwd), s_b0)
    return o_f + flip(o_b), s_f, s_b


def head_group_norm(o, g, bias):
    mu = jnp.mean(o, axis=-1, keepdims=True)
    var = jnp.mean(jnp.square(o - mu), axis=-1, keepdims=True)
    y = (o - mu) * lax.rsqrt(var + EPS)
    b, h, n, d = y.shape
    y = y.transpose(0, 2, 1, 3).reshape(b, n, h * d)
    return y * g.astype(jnp.float32) + bias.astype(jnp.float32)


def block_attention(qn, qr, kn, kr, v):
    b, h, nq, _ = qn.shape
    nb = nq // ATTN_BLOCK
    scale = (MLA_NOPE + MLA_ROPE) ** -0.5

    def blk(qs):
        qnb, qrb = qs
        s = (jnp.einsum('bhqd,bhkd->bhqk', qnb, kn) + jnp.einsum('bhqd,bkd->bhqk', qrb, kr)).astype(jnp.float32) * scale
        p = jax.nn.softmax(s, axis=-1)
        return jnp.einsum('bhqk,bhkv->bhqv', p.astype(v.dtype), v)

    to_blocks = lambda t: jnp.moveaxis(t.reshape(b, h, nb, ATTN_BLOCK, t.shape[-1]), 2, 0)
    out = lax.map(blk, (to_blocks(qn), to_blocks(qr)))
    return jnp.moveaxis(out, 0, 2).reshape(b, h, nq, -1)


def trunk_layer(x, cond, grid, ctx, w_mod, b_mod, g_norm_mix, g_norm_ffn, w_in, g_q_a, w_q_b,
                g_kv_a, w_kv_b, g_qn, g_qr, g_kn, g_kr, ret_p_fwd, ret_p_bwd, g_ret_gn, b_ret_gn,
                w_o, w_ffn_in, w_ffn_out):
    sh1, sc1, gt1, sh2, sc2, gt2 = modulation(cond, w_mod, b_mod)
    h = rms_norm(x, g_norm_mix) * (1.0 + sc1) + sh1
    rq, rk, rv, rg, qn, qr, ckv, kr = project(h, w_in, g_q_a, w_q_b, g_kv_a, g_qn, g_qr, g_kr)
    kn, v = mla_up(ckv, w_kv_b, g_kn)
    if grid is None:
        zeros = jnp.zeros((x.shape[0], RET_HEADS, RET_DK, RET_DV), jnp.float32)
        s_f0, s_b0 = zeros, zeros
        kr_keys = kr
    else:
        row, col = grid
        rq, rk, qr = axial_rope(rq, row, col), axial_rope(rk, row, col), axial_rope(qr, row, col)
        ckv_c, kr_c, s_f0, s_b0 = ctx
        kn_c, v_c = mla_up(ckv_c, w_kv_b, g_kn)
        kn = jnp.concatenate([kn, kn_c], axis=2)
        v = jnp.concatenate([v, v_c], axis=2)
        kr_keys = jnp.concatenate([axial_rope(kr, row, col), kr_c], axis=1)
    ret, s_f, s_b = bidir_retention(rq, rk, rv, ret_p_fwd, ret_p_bwd, s_f0, s_b0)
    attn = block_attention(qn, qr, kn, kr_keys, v)
    b, n, _ = x.shape
    ret = head_group_norm(ret, g_ret_gn, b_ret_gn).astype(x.dtype) * jax.nn.silu(rg)
    attn = attn.transpose(0, 2, 1, 3).reshape(b, n, MLA_WIDTH)
    x = x + gt1 * (jnp.concatenate([ret, attn], axis=-1) @ w_o)
    h = rms_norm(x, g_norm_ffn) * (1.0 + sc2) + sh2
    gate, up = jnp.split(h @ w_ffn_in, 2, axis=-1)
    x = x + gt2 * ((jax.nn.silu(gate) * up) @ w_ffn_out)
    return x, (ckv, kr, s_f.astype(x.dtype), s_b.astype(x.dtype))


def setup_inputs(seed: int = 0) -> dict:
    key = jax.random.key(seed)
    keys = jax.random.split(key, 32)

    def nrm(i, shape, scale):
        return jax.random.normal(keys[i], shape, jnp.float32) * scale

    def gain(i, shape):
        return 1.0 + 0.05 * jax.random.normal(keys[i], shape, jnp.float32)

    decay_base = RET_DECAY_OFFSET + jnp.arange(RET_HEADS, dtype=jnp.float32)
    st_shape = (DEC_BATCH, DEPTH, RET_HEADS, RET_DK, RET_DV)
    return {
        'x_prompt': nrm(0, (BATCH, SEQ, D_MODEL), 1.0),
        'x_sample': nrm(1, (DEC_BATCH, DEC_SEQ, D_MODEL), 1.0),
        'cache_ckv': nrm(2, (DEC_BATCH, DEPTH, PAST_LEN, KV_RANK), 1.0),
        'cache_krope': nrm(3, (DEC_BATCH, DEPTH, PAST_LEN, MLA_ROPE), 1.0),
        'state_ret_fwd': nrm(4, st_shape, 0.5),
        'state_ret_bwd': nrm(5, st_shape, 0.5),
        'c': nrm(6, (DEC_BATCH, D_MODEL), 1.0),
        'c_ctx': nrm(7, (D_MODEL,), 1.0),
        'w_mod': nrm(8, (DEPTH, D_MODEL, N_MOD * D_MODEL), 0.5 * D_MODEL ** -0.5),
        'b_mod': nrm(9, (DEPTH, N_MOD * D_MODEL), 0.02),
        'g_norm_mix': gain(10, (DEPTH, D_MODEL)),
        'g_norm_ffn': gain(11, (DEPTH, D_MODEL)),
        'w_in': nrm(12, (DEPTH, D_MODEL, IN_COLS), D_MODEL ** -0.5),
        'g_q_a': gain(13, (DEPTH, Q_RANK)),
        'w_q_b': nrm(14, (DEPTH, Q_RANK, MLA_HEADS * (MLA_NOPE + MLA_ROPE)), Q_RANK ** -0.5),
        'g_kv_a': gain(15, (DEPTH, KV_RANK)),
        'w_kv_b': nrm(16, (DEPTH, KV_RANK, MLA_HEADS * (MLA_NOPE + MLA_V)), KV_RANK ** -0.5),
        'g_qn': gain(17, (DEPTH, MLA_NOPE)),
        'g_qr': gain(18, (DEPTH, MLA_ROPE)),
        'g_kn': gain(19, (DEPTH, MLA_NOPE)),
        'g_kr': gain(20, (DEPTH, MLA_ROPE)),
        'ret_p_fwd': decay_base + nrm(21, (DEPTH, RET_HEADS), 0.1),
        'ret_p_bwd': decay_base + nrm(22, (DEPTH, RET_HEADS), 0.1),
        'g_ret_gn': gain(23, (DEPTH, RET_WIDTH)),
        'b_ret_gn': nrm(24, (DEPTH, RET_WIDTH), 0.02),
        'w_o': nrm(25, (DEPTH, D_MIX, D_MODEL), D_MIX ** -0.5),
        'w_ffn_in': nrm(26, (DEPTH, D_MODEL, 2 * D_FF), D_MODEL ** -0.5),
        'w_ffn_out': nrm(27, (DEPTH, D_FF, D_MODEL), D_FF ** -0.5),
    }


def reference(x_prompt, x_sample, cache_ckv, cache_krope, state_ret_fwd, state_ret_bwd, c, c_ctx,
              w_mod, b_mod, g_norm_mix, g_norm_ffn, w_in, g_q_a, w_q_b, g_kv_a, w_kv_b,
              g_qn, g_qr, g_kn, g_kr, ret_p_fwd, ret_p_bwd, g_ret_gn, b_ret_gn, w_o,
              w_ffn_in, w_ffn_out):
    def layer_params(l):
        return (w_mod[l], b_mod[l], g_norm_mix[l], g_norm_ffn[l], w_in[l], g_q_a[l], w_q_b[l],
                g_kv_a[l], w_kv_b[l], g_qn[l], g_qr[l], g_kn[l], g_kr[l], ret_p_fwd[l],
                ret_p_bwd[l], g_ret_gn[l], b_ret_gn[l], w_o[l], w_ffn_in[l], w_ffn_out[l])

    x = x_prompt
    ckv_l, kr_l, sf_l, sb_l = [], [], [], []
    for l in range(DEPTH):
        x, (ckv, kr, s_f, s_b) = trunk_layer(x, c_ctx, None, None, *layer_params(l))
        ckv_l.append(ckv)
        kr_l.append(kr)
        sf_l.append(s_f)
        sb_l.append(s_b)
    y_prompt = x

    n_lat = x_sample.shape[1]
    rows = n_lat // GRID_W
    grid = (jnp.repeat(jnp.arange(rows), GRID_W), jnp.tile(jnp.arange(GRID_W), rows))
    y = x_sample
    for l in range(DEPTH):
        ctx = (cache_ckv[:, l], cache_krope[:, l], state_ret_fwd[:, l], state_ret_bwd[:, l])
        y, _ = trunk_layer(y, c, grid, ctx, *layer_params(l))

    new_ckv = jnp.stack(ckv_l, axis=1)
    new_krope = jnp.stack(kr_l, axis=1)
    new_ret_fwd = jnp.stack(sf_l, axis=1)
    new_ret_bwd = jnp.stack(sb_l, axis=1)
    return (y_prompt, y, new_ckv, new_krope, new_ret_fwd, new_ret_bwd)
```

```cpp
#include <hip/hip_runtime.h>
#include <cstdio>
#include <cstdint>
namespace pg8 {
#define PG8_LAS __attribute__((address_space(3)))
typedef unsigned short bf16_t;
typedef short bf16x8 __attribute__((ext_vector_type(8)));
typedef float f32x4 __attribute__((ext_vector_type(4)));
typedef unsigned u32x4 __attribute__((ext_vector_type(4)));
constexpr int BM = 256, BK = 64, HALF = 128, HTB = HALF * BK * 2  , STAGE_BYTES = 8 * HTB, NXCD = 8, WGM = 8;

__host__ __device__ __forceinline__ int lds_byte(int r, int c) { const int st = (r >> 4) * 2 + (c >> 5), rr = r & 15, cc = c & 31, ob = rr * 64 + cc * 2; return st * 1024 + (ob ^ (((ob >> 9) & 1) << 5)); }
__host__ __device__ __forceinline__ void stage_rc(int b, int& R, int& C) { const int st = b / 1024, sb = b % 1024, swz = sb ^ (((sb >> 9) & 1) << 5); R = (st >> 1) * 16 + swz / 64; C = (st & 1) * 32 + (swz % 64) / 2; }
__host__ __device__ __forceinline__ int perm32(int rho) { const int n = rho >> 4, i = rho & 15; return 8 * (i >> 2) + 4 * n + (i & 3); }

struct Unit { int pm, pn; };
struct Gemm { const bf16_t* A; const bf16_t* Bt; int M, N, K; };

struct StaticOrder {
    int nM, nN, nwg, G, c;
    __host__ __device__ void init(int M, int N, int G_, int c_) { nM = M / BM; nN = N / BM; nwg = nM * nN; G = G_; c = c_; }
    __host__ __device__ bool next(int i, Unit& u) const {
        const long L = (long)i * G + c; if (L >= nwg) return false;
        int wgid = (int)L; { const int q = nwg / NXCD, r = nwg % NXCD, xcd = wgid % NXCD, off = wgid / NXCD; wgid = (xcd < r ? xcd * (q + 1) : r * (q + 1) + (xcd - r) * q) + off; }
        const int nig = WGM * nN, gid = wgid / nig, fm = gid * WGM, gsz = (nM - fm) < WGM ? (nM - fm) : WGM;
        u.pm = fm + ((wgid % nig) % gsz); u.pn = (wgid % nig) / gsz; return true;
    }
    __device__ __forceinline__ void a_ready(const Unit&) const {}
    __device__ __forceinline__ void done(const Unit&) const {}
};

__device__ __forceinline__ unsigned cvt_pk_bf16(float lo, float hi) { unsigned r; asm volatile("v_cvt_pk_bf16_f32 %0, %1, %2" : "=v"(r) : "v"(lo), "v"(hi)); return r; }
template <class Epi, class Sched, bool ALIGN_EPI = false, bool SP2 = false>
__device__ __forceinline__ void gemm_phase(PG8_LAS unsigned char* lds, const Gemm g, const Sched& S, const Epi& E, int tid_) {
    const int tid = tid_, wid = __builtin_amdgcn_readfirstlane(tid >> 6), lane = tid & 63, wr = wid >> 2, wc = wid & 3, fr = lane & 15, fq = lane >> 4;
    const int K = g.K, nt = K / BK;
    unsigned voffA[2], voffB[2];
#pragma unroll
    for (int i = 0; i < 2; ++i) { int R, C; stage_rc(tid * 16 + i * 8192, R, C); const int Rb = Epi::PERM ? ((R & ~31) + perm32(R & 31)) : R;
        voffA[i] = (unsigned)(R * K + C) * 2u; voffB[i] = (unsigned)(Rb * K + C) * 2u; }
    const size_t kstep = (size_t)(BK * 2);
    const size_t hstep = (size_t)HALF * K * 2;
    const size_t tstep = 2 * hstep;
    const unsigned ldsw = (unsigned)wid * 1024u;
    const int aoff = lds_byte(wr * 64 + fr, fq * 8), boff = lds_byte(wc * 32 + fr, fq * 8);
#define PG8_SA(b, h) (((b) * 2 + (h)) * HTB)
#define PG8_SB(b, h) ((4 + (b) * 2 + (h)) * HTB)
#define PG8_STAGE(bufoff, gbase, voff) do { _Pragma("unroll") for (int _i = 0; _i < 2; ++_i) \
        __builtin_amdgcn_global_load_lds((const unsigned*)((const char*)(gbase) + (voff)[_i]), (PG8_LAS unsigned*)(lds + (bufoff) + ldsw + _i * 8192), 16, 0, 0); } while (0)
#define PG8_LDA(dst, b, h) do { _Pragma("unroll") for (int m = 0; m < 4; ++m) _Pragma("unroll") for (int k = 0; k < 2; ++k) dst[m][k] = *(const PG8_LAS bf16x8*)(lds + PG8_SA(b, h) + aoff + m * 2048 + k * 1024); } while (0)
#define PG8_LDB(dst, b, h) do { _Pragma("unroll") for (int n = 0; n < 2; ++n) _Pragma("unroll") for (int k = 0; k < 2; ++k) dst[n][k] = *(const PG8_LAS bf16x8*)(lds + PG8_SB(b, h) + boff + n * 2048 + k * 1024); } while (0)
#define PG8_MMA(ai, bj, At, Bt) do { __builtin_amdgcn_s_setprio(1); _Pragma("unroll") for (int m = 0; m < 4; ++m) _Pragma("unroll") for (int n = 0; n < 2; ++n) _Pragma("unroll") for (int k = 0; k < 2; ++k) \
        acc[ai][bj][m][n] = __builtin_amdgcn_mfma_f32_16x16x32_bf16(Bt[n][k], At[m][k], acc[ai][bj][m][n], 0, 0, 0); __builtin_amdgcn_s_setprio(0); } while (0)
#define PG8_WAIT_V(n) asm volatile("s_waitcnt vmcnt(" #n ")" ::: "memory")
#define PG8_WAIT_L(n) asm volatile("s_waitcnt lgkmcnt(" #n ")" ::: "memory")
#define PG8_BAR __builtin_amdgcn_s_barrier()
#define PG8_SCHED __builtin_amdgcn_sched_barrier(0)
    Unit cur, nxt; int ui = 0;
    if (!S.next(0, cur)) return;
    f32x4 acc[2][2][4][2];
#pragma unroll
    for (int a = 0; a < 2; ++a)
#pragma unroll
        for (int b = 0; b < 2; ++b)
#pragma unroll
            for (int m = 0; m < 4; ++m)
#pragma unroll
                for (int n = 0; n < 2; ++n) acc[a][b][m][n] = (f32x4){0.f, 0.f, 0.f, 0.f};
    bf16x8 At[4][2], B0[2][2], B1[2][2];
    const char* cA = (const char*)g.A + (size_t)cur.pm * tstep; const char* cB = (const char*)g.Bt + (size_t)cur.pn * tstep;
    S.a_ready(cur);
    if constexpr (SP2) {
        PG8_STAGE(PG8_SB(0, 0), cB, voffB); PG8_STAGE(PG8_SB(0, 1), cB + hstep, voffB); PG8_STAGE(PG8_SA(0, 0), cA, voffA); PG8_STAGE(PG8_SA(0, 1), cA + hstep, voffA);
        if (wr == 1) PG8_BAR;
        PG8_WAIT_V(2); PG8_BAR;
        PG8_STAGE(PG8_SB(1, 0), cB + kstep, voffB); PG8_STAGE(PG8_SA(1, 0), cA + kstep, voffA); PG8_STAGE(PG8_SB(1, 1), cB + hstep + kstep, voffB);
        PG8_WAIT_V(6); PG8_BAR;
    } else {
        PG8_STAGE(PG8_SB(0, 0), cB, voffB); PG8_STAGE(PG8_SA(0, 0), cA, voffA); PG8_STAGE(PG8_SB(0, 1), cB + hstep, voffB); PG8_STAGE(PG8_SA(0, 1), cA + hstep, voffA);
        if (wr == 1) PG8_BAR;
        PG8_WAIT_V(4); PG8_BAR;
        PG8_STAGE(PG8_SB(1, 0), cB + kstep, voffB); PG8_STAGE(PG8_SA(1, 0), cA + kstep, voffA); PG8_STAGE(PG8_SB(1, 1), cB + hstep + kstep, voffB);
        PG8_WAIT_V(6); PG8_BAR;
    }
    for (;;) {
        const bool has_next = S.next(ui + 1, nxt);
        const char* nA = has_next ? (const char*)g.A + (size_t)nxt.pm * tstep : cA; const char* nB = has_next ? (const char*)g.Bt + (size_t)nxt.pn * tstep : cB;
        for (int t = 0; t < nt; t += 2) {
            const bool last = (t == nt - 2);
            const char* a1 = cA + (size_t)(t + 1) * kstep;
            const char* a2 = last ? nA : cA + (size_t)(t + 2) * kstep; const char* b2 = last ? nB : cB + (size_t)(t + 2) * kstep;
            const char* a3 = a2 + kstep; const char* b3 = b2 + kstep;
            if (last && has_next) S.a_ready(nxt);
            if constexpr (SP2) {
            PG8_LDB(B0, 0, 0); PG8_LDB(B1, 0, 1); PG8_SCHED; PG8_LDA(At, 0, 0); PG8_STAGE(PG8_SA(1, 1), a1 + hstep, voffA);
            PG8_WAIT_V(8); PG8_WAIT_L(0); PG8_BAR; PG8_MMA(0, 0, At, B0); PG8_MMA(0, 1, At, B1); PG8_BAR; PG8_SCHED;
            PG8_LDA(At, 0, 1); PG8_STAGE(PG8_SB(0, 0), b2, voffB); PG8_STAGE(PG8_SB(0, 1), b2 + hstep, voffB); PG8_STAGE(PG8_SA(0, 0), a2, voffA);
            PG8_WAIT_V(8); PG8_WAIT_L(0); PG8_BAR; PG8_MMA(1, 0, At, B0); PG8_MMA(1, 1, At, B1); PG8_BAR; PG8_SCHED;
            PG8_LDB(B0, 1, 0); PG8_LDB(B1, 1, 1); PG8_SCHED; PG8_LDA(At, 1, 0); PG8_STAGE(PG8_SA(0, 1), a2 + hstep, voffA);
            PG8_WAIT_V(8); PG8_WAIT_L(0); PG8_BAR; PG8_MMA(0, 0, At, B0); PG8_MMA(0, 1, At, B1); PG8_BAR; PG8_SCHED;
            PG8_LDA(At, 1, 1); PG8_STAGE(PG8_SB(1, 0), b3, voffB); PG8_STAGE(PG8_SB(1, 1), b3 + hstep, voffB); PG8_STAGE(PG8_SA(1, 0), a3, voffA);
            PG8_WAIT_V(8); PG8_WAIT_L(0); PG8_BAR; PG8_MMA(1, 0, At, B0); PG8_MMA(1, 1, At, B1); PG8_BAR; PG8_SCHED;
            } else {
            PG8_LDB(B0, 0, 0); PG8_SCHED; PG8_LDA(At, 0, 0); PG8_STAGE(PG8_SA(1, 1), a1 + hstep, voffA);
            PG8_WAIT_L(8); PG8_BAR; PG8_WAIT_L(0); PG8_MMA(0, 0, At, B0); PG8_BAR; PG8_SCHED;
            PG8_LDB(B1, 0, 1); PG8_STAGE(PG8_SB(0, 0), b2, voffB);
            PG8_BAR; PG8_WAIT_L(0); PG8_MMA(0, 1, At, B1); PG8_BAR;
            PG8_LDA(At, 0, 1); PG8_STAGE(PG8_SA(0, 0), a2, voffA);
            PG8_BAR; PG8_WAIT_L(0); PG8_MMA(1, 0, At, B0); PG8_BAR; PG8_SCHED;
            PG8_STAGE(PG8_SB(0, 1), b2 + hstep, voffB);
            PG8_WAIT_V(6); PG8_BAR; PG8_MMA(1, 1, At, B1); PG8_BAR;
            PG8_LDB(B0, 1, 0); PG8_SCHED; PG8_LDA(At, 1, 0); PG8_STAGE(PG8_SA(0, 1), a2 + hstep, voffA);
            PG8_WAIT_L(8); PG8_BAR; PG8_WAIT_L(0); PG8_MMA(0, 0, At, B0); PG8_BAR; PG8_SCHED;
            PG8_LDB(B1, 1, 1); PG8_STAGE(PG8_SB(1, 0), b3, voffB);
            PG8_BAR; PG8_WAIT_L(0); PG8_MMA(0, 1, At, B1); PG8_BAR;
            PG8_LDA(At, 1, 1); PG8_STAGE(PG8_SA(1, 0), a3, voffA);
            PG8_BAR; PG8_WAIT_L(0); PG8_MMA(1, 0, At, B0); PG8_BAR; PG8_SCHED;
            PG8_STAGE(PG8_SB(1, 1), b3 + hstep, voffB);
            PG8_WAIT_V(6); PG8_BAR; PG8_MMA(1, 1, At, B1); PG8_BAR;
            }
        }
        if constexpr (ALIGN_EPI) { if (wr == 0) PG8_BAR; }
        if constexpr (!Epi::AFTER_DRAIN) { E(acc, cur, wr, wc, fr, fq); S.done(cur); }
        if (!has_next) break;
#pragma unroll
        for (int a = 0; a < 2; ++a)
#pragma unroll
            for (int b = 0; b < 2; ++b)
#pragma unroll
                for (int m = 0; m < 4; ++m)
#pragma unroll
                    for (int n = 0; n < 2; ++n) acc[a][b][m][n] = (f32x4){0.f, 0.f, 0.f, 0.f};
        cur = nxt; cA = nA; cB = nB; ++ui;
        if constexpr (ALIGN_EPI) { if (wr == 1) PG8_BAR; }
    }
    PG8_WAIT_V(0);
    if constexpr (!ALIGN_EPI) { if (wr == 0) PG8_BAR; }
    PG8_BAR;
    if constexpr (Epi::AFTER_DRAIN) { E.fused(acc, cur, wr, wc, fr, fq, lds, wid, lane); S.done(cur); }
#undef PG8_SA
#undef PG8_SB
#undef PG8_STAGE
#undef PG8_LDA
#undef PG8_LDB
#undef PG8_MMA
#undef PG8_WAIT_V
#undef PG8_WAIT_L
#undef PG8_BAR
#undef PG8_SCHED
}
}
#define GAS __attribute__((address_space(1)))
#define LAS __attribute__((address_space(3)))
typedef unsigned short bf16;
typedef unsigned v4u __attribute__((ext_vector_type(4)));
typedef float f32x4 __attribute__((ext_vector_type(4)));
typedef short bf16x8 __attribute__((ext_vector_type(8)));
typedef GAS unsigned gu32;
typedef GAS unsigned long long gu64;
#define RLX_AGENT __ATOMIC_RELAXED, __HIP_MEMORY_SCOPE_AGENT
#define LDS_WAIT() asm volatile("s_waitcnt lgkmcnt(0)" ::: "memory")
#define VM_WAIT() asm volatile("s_waitcnt vmcnt(0)" ::: "memory")
__device__ __forceinline__ unsigned long long rt() { return __builtin_amdgcn_s_memrealtime(); }
__device__ __forceinline__ unsigned f2bf(float f) { unsigned u = __builtin_bit_cast(unsigned, f); return (u + 0x7fffu + ((u >> 16) & 1u)) >> 16; }
__device__ __forceinline__ unsigned pk2(float lo, float hi) { return f2bf(lo) | (f2bf(hi) << 16); }

#define XB_TMO      128
#define XB_XCNT(j)  (256  + 64 * (j))
#define XB_XSUB(j)  (1280 + 64 * (j))
#define XB_XGEN(j)  (2304 + 64 * (j))
#define XB_TOP      3328
#define XB_TOPGEN   3392
#define XCD_BAR_WORDS 3456
#define XB_SPIN_CAP (1u << 18)

__device__ __forceinline__ unsigned xb_ld(unsigned* p)              { return __hip_atomic_load(p, __ATOMIC_RELAXED, __HIP_MEMORY_SCOPE_AGENT); }
__device__ __forceinline__ unsigned xb_add(unsigned* p, unsigned v) { return __hip_atomic_fetch_add(p, v, __ATOMIC_RELAXED, __HIP_MEMORY_SCOPE_AGENT); }
__device__ __forceinline__ unsigned xb_xcc_id() { return (unsigned)__builtin_amdgcn_s_getreg((3 << 11) | 20) & 0xFu; }
#define XB_SPIN(cond, bar) do { unsigned _sp = 0; while (cond) { __builtin_amdgcn_s_sleep(1); \
    if ((++_sp & 255u) == 0u) { if (xb_ld(&(bar)[XB_TMO])) break; if (_sp > XB_SPIN_CAP) { atomicAdd(&(bar)[XB_TMO], 1u); break; } } } } while (0)

struct XcdBarrier {
    unsigned* bar; unsigned x;
    volatile LAS unsigned* st;
};

__device__ __forceinline__ XcdBarrier xcd_barrier_post(unsigned* bar, volatile LAS unsigned* st, int tid) {
    XcdBarrier b; b.bar = bar; b.x = xb_xcc_id(); b.st = st;
    if (tid == 0) (void)xb_add(&bar[XB_XCNT(b.x)], 1u);
    return b;
}
__device__ __forceinline__ void xcd_barrier_complete(unsigned* bar, unsigned x, unsigned& nloc, unsigned& nx) {
    const unsigned G = gridDim.x * gridDim.y * gridDim.z;
    unsigned sum, cnt, mine, sp = 0u;
    for (;;) {
        sum = 0u; cnt = 0u; mine = 0u;
#pragma unroll
        for (unsigned j = 0; j < 16; ++j) { const unsigned c = xb_ld(&bar[XB_XCNT(j)]); sum += c; cnt += (c > 0u) ? 1u : 0u; mine = (j == x) ? c : mine; }
        if (sum == G) break;
        __builtin_amdgcn_s_sleep(1);
        if ((++sp & 255u) == 0u) { if (xb_ld(&bar[XB_TMO])) break; if (sp > XB_SPIN_CAP) { atomicAdd(&bar[XB_TMO], 1u); break; } }
    }
    nloc = mine > 0u ? mine : 1u; nx = cnt > 0u ? cnt : 1u;
}

__device__ __forceinline__ void xcd_barrier(const XcdBarrier& b, int tid) {
    asm volatile("s_waitcnt vmcnt(0)" ::: "memory");
    __syncthreads();
    if (tid == 0) {
        unsigned* bar = b.bar;
        __builtin_amdgcn_s_waitcnt(0);
        unsigned nloc = b.st[0], nx = b.st[1];
        if (nloc == 0u) { xcd_barrier_complete(bar, b.x, nloc, nx); b.st[0] = nloc; b.st[1] = nx; }
        const unsigned old = xb_add(&bar[XB_XSUB(b.x)], 1u);
        const unsigned gen = old / nloc;
        if (old + 1u == (gen + 1u) * nloc) {
            __builtin_amdgcn_fence(__ATOMIC_RELEASE, "agent");
            asm volatile("s_waitcnt vmcnt(0)" ::: "memory");
            const unsigned og = xb_add(&bar[XB_TOP], 1u);
            const unsigned tg = og / nx;
            if (og + 1u == (tg + 1u) * nx) xb_add(&bar[XB_TOPGEN], 1u);
            else XB_SPIN(xb_ld(&bar[XB_TOPGEN]) == tg, bar);
            __builtin_amdgcn_fence(__ATOMIC_ACQUIRE, "agent");
            xb_add(&bar[XB_XGEN(b.x)], 1u);
            asm volatile("s_waitcnt vmcnt(0)" ::: "memory");
        } else {
            XB_SPIN(xb_ld(&bar[XB_XGEN(b.x)]) == gen, bar);
            __builtin_amdgcn_fence(__ATOMIC_ACQUIRE, "agent");
            asm volatile("s_waitcnt vmcnt(0)" ::: "memory");
        }
    }
    __syncthreads();
}

constexpr int NWAVES = 8;
constexpr int M_TOK = 10240, M_CTX = 8192, M_KV = 10752, DM = 1024;
constexpr int N_IN = 2560, N_Q = 768, N_KV = 1024, N_FI = 5632, D_FFN = 2816;
constexpr float EPSF = 1e-6f;
constexpr float QSCALE = 0.10206207261596575f * 1.4426950408889634f;

#ifndef MK_PER_PHASE
#define MK_PER_PHASE 1
#endif
#ifndef PHASE_MASK
#define PHASE_MASK 0x1ff
#endif
#define PH_EN(k) (((PHASE_MASK) >> (k)) & 1)
constexpr int N_PHASES = 17;

constexpr size_t OUT_Y = 0, OUT_CKV = 10485760, OUT_KROPE = 12582912, OUT_SF = 13107200, OUT_SB = 15204352, OUT_TOTAL = 17301504;

constexpr size_t MiB = 1u << 20;
constexpr size_t WS_CTL = 0, CTL_ZERO_BYTES = 1 * MiB;
constexpr int CW_BAR = 4096;
constexpr int CW_SS = 16384;
constexpr size_t WS_MOD = 1 * MiB;
constexpr size_t WS_TAB = WS_MOD + 256 * 1024;
constexpr size_t WS_W = 2 * MiB;
constexpr size_t W_IN_OFF = 0, W_QB_OFF = (size_t)N_IN * 1024 * 2, W_KVB_OFF = W_QB_OFF + (size_t)N_Q * 256 * 2, W_O_OFF = W_KVB_OFF + (size_t)N_KV * 256 * 2,
                 W_FI_OFF = W_O_OFF + (size_t)1024 * 1024 * 2, W_FO_OFF = W_FI_OFF + (size_t)N_FI * 1024 * 2, LAYER_W = W_FO_OFF + (size_t)1024 * D_FFN * 2;
constexpr size_t WS_H = WS_W + 2 * LAYER_W;
constexpr size_t WS_RQ = WS_H + (size_t)M_TOK * 1024 * 2;
constexpr size_t WS_RK = WS_RQ + (size_t)M_TOK * 512 * 2;
constexpr size_t WS_RKT = WS_RK + (size_t)M_TOK * 512 * 2;
constexpr size_t WS_RVT = WS_RKT + (size_t)512 * M_CTX * 2;
constexpr size_t WS_RG = WS_RVT + (size_t)512 * M_TOK * 2;
constexpr size_t WS_QA = WS_RG + (size_t)M_TOK * 512 * 2;
constexpr size_t WS_KVA = WS_QA + (size_t)M_TOK * 256 * 2;
constexpr size_t WS_KR = WS_KVA + (size_t)M_KV * 256 * 2;
constexpr size_t WS_Q = WS_KR + (size_t)M_KV * 32 * 2;
constexpr size_t WS_KN = WS_Q + (size_t)M_TOK * 768 * 2;
constexpr size_t WS_VT = WS_KN + (size_t)M_KV * 512 * 2;
constexpr size_t WS_MIX = WS_VT + (size_t)512 * M_KV * 2;
constexpr size_t WS_ACT = WS_MIX + (size_t)M_TOK * 1024 * 2;
constexpr size_t WS_END = WS_ACT + (size_t)M_TOK * D_FFN * 2;
static_assert(WS_END <= 256 * MiB, "d_ws map exceeds 256 MiB");
static_assert((CW_SS + 4 * M_TOK) * 4 <= (int)CTL_ZERO_BYTES && (CW_BAR + XCD_BAR_WORDS) <= CW_SS, "CTL words");
static_assert(W_QB_OFF % 16 == 0 && W_KVB_OFF % 16 == 0 && W_O_OFF % 16 == 0 && W_FI_OFF % 16 == 0 && W_FO_OFF % 16 == 0 && LAYER_W % 16 == 0, "weight alignment");

constexpr int RING_OFF = 0, RING_BYTES = 131072;
constexpr int LDSCTL_OFF = RING_BYTES, MISC_OFF = LDSCTL_OFF + 320;
constexpr int LDS_BYTES = 147456;

typedef float f32x16 __attribute__((ext_vector_type(16)));
typedef float f32x2_t __attribute__((ext_vector_type(2)));
typedef __bf16 bf16x2_t __attribute__((ext_vector_type(2)));
typedef unsigned u32x2 __attribute__((ext_vector_type(2)));
__device__ __forceinline__ unsigned cvtpk(float lo, float hi) { f32x2_t v = {lo, hi}; bf16x2_t b = __builtin_convertvector(v, bf16x2_t); return __builtin_bit_cast(unsigned, b); }
__device__ __forceinline__ bf16 f2b(float x) { return (bf16)(cvtpk(x, 0.f) & 0xffffu); }
__device__ __forceinline__ float b2f(unsigned short b) { return __builtin_bit_cast(float, (unsigned)b << 16); }
__device__ __forceinline__ float siluf(float x) { return x * __builtin_amdgcn_rcpf(1.0f + __builtin_amdgcn_exp2f(-1.4426950408889634f * x)); }
__device__ __forceinline__ v4u pack8(const float (&v)[8]) { v4u w; w.x = cvtpk(v[0], v[1]); w.y = cvtpk(v[2], v[3]); w.z = cvtpk(v[4], v[5]); w.w = cvtpk(v[6], v[7]); return w; }
__device__ __forceinline__ void ld8(const pg8::f32x4 (&a)[2], float (&v)[8]) { v[0] = a[0][0]; v[1] = a[0][1]; v[2] = a[0][2]; v[3] = a[0][3]; v[4] = a[1][0]; v[5] = a[1][1]; v[6] = a[1][2]; v[7] = a[1][3]; }

struct Params {
    const float* in[28];
    float* out;
    unsigned char* ws;
    int ph_lo, ph_hi;
};


struct EpiG1 {
    static constexpr bool PERM = true, AFTER_DRAIN = false;
    bf16 *RQ, *RK, *RKT, *RVT, *RG, *QA, *KVA, *KR;
    float *ssq, *sskv;
    const float *g_q_a, *g_kv_a, *g_kr;
    const float2 *tab64, *tab32;
    float* out_krope; int layer;
    __device__ __forceinline__ void operator()(const pg8::f32x4 (&acc)[2][2][4][2], const pg8::Unit& u, int wr, int wc, int fr, int fq) const {
        asm volatile("" : "+v"(fr), "+v"(fq));
        const int pn = u.pn; const bool lat = u.pm >= 32;
        if (pn < 4) {
            bf16* dst = (pn < 2) ? RQ : RK; const int cb = (pn & 1) * 256;
#pragma unroll
            for (int ai = 0; ai < 2; ++ai)
#pragma unroll
                for (int m = 0; m < 4; ++m) {
                    asm volatile("" ::: "memory"); const int r = u.pm * 256 + ai * 128 + wr * 64 + m * 16 + fr;
                    const int n = (r - M_CTX) & 1023, prow = n >> 6, pcol = n & 63;
#pragma unroll
                    for (int bj = 0; bj < 2; ++bj) {
                        float v[8]; ld8(acc[ai][bj][m], v);
                        const int c = cb + bj * 128 + wc * 32 + fq * 8;
                        if (lat) {
                            const int pos = (wc & 1) ? pcol : prow;
                            const float2* tb = tab64 + pos * 16 + (fq & 1) * 8;
#pragma unroll
                            for (int e = 0; e < 8; ++e) { const float pv = __shfl_xor(v[e], 32); const float2 cs = tb[e]; v[e] = (fq < 2) ? (v[e] * cs.x - pv * cs.y) : (pv * cs.y + v[e] * cs.x); }
                        }
                        *(v4u*)(dst + (size_t)r * 512 + c) = pack8(v);
                        if (pn >= 2 && !lat) {
#pragma unroll
                            for (int e = 0; e < 8; ++e) RKT[(size_t)(c + e) * M_CTX + r] = f2b(v[e]);
                        }
                    }
                }
        } else if (pn < 6) {
            const int cb = (pn - 4) * 256;
#pragma unroll
            for (int ai = 0; ai < 2; ++ai)
#pragma unroll
                for (int m = 0; m < 4; ++m) {
                    asm volatile("" ::: "memory"); const int r = u.pm * 256 + ai * 128 + wr * 64 + m * 16 + fr;
#pragma unroll
                    for (int bj = 0; bj < 2; ++bj) {
                        float v[8]; ld8(acc[ai][bj][m], v);
                        const int c = cb + bj * 128 + wc * 32 + fq * 8;
#pragma unroll
                        for (int e = 0; e < 8; ++e) RVT[(size_t)(c + e) * M_TOK + r] = f2b(v[e]);
                    }
                }
        } else if (pn < 8) {
            const int cb = (pn - 6) * 256;
#pragma unroll
            for (int ai = 0; ai < 2; ++ai)
#pragma unroll
                for (int m = 0; m < 4; ++m) {
                    asm volatile("" ::: "memory"); const int r = u.pm * 256 + ai * 128 + wr * 64 + m * 16 + fr;
#pragma unroll
                    for (int bj = 0; bj < 2; ++bj) {
                        float v[8]; ld8(acc[ai][bj][m], v);
#pragma unroll
                        for (int e = 0; e < 8; ++e) v[e] = siluf(v[e]);
                        *(v4u*)(RG + (size_t)r * 512 + cb + bj * 128 + wc * 32 + fq * 8) = pack8(v);
                    }
                }
        } else if (pn == 8) {
#pragma unroll
            for (int ai = 0; ai < 2; ++ai)
#pragma unroll
                for (int m = 0; m < 4; ++m) {
                    asm volatile("" ::: "memory"); const int r = u.pm * 256 + ai * 128 + wr * 64 + m * 16 + fr;
                    float part = 0.f;
#pragma unroll
                    for (int bj = 0; bj < 2; ++bj) {
                        float v[8]; ld8(acc[ai][bj][m], v);
                        const int c = bj * 128 + wc * 32 + fq * 8;
                        const pg8::f32x4 g0 = *(const pg8::f32x4*)(g_q_a + c), g1 = *(const pg8::f32x4*)(g_q_a + c + 4);
#pragma unroll
                        for (int e = 0; e < 8; ++e) { part += v[e] * v[e]; v[e] *= (e < 4 ? g0[e & 3] : g1[e & 3]); }
                        *(v4u*)(QA + (size_t)r * 256 + c) = pack8(v);
                    }
                    part += __shfl_xor(part, 16); part += __shfl_xor(part, 32);
                    if (fq == 0) atomicAdd(ssq + r, part);
                }
        } else {
#pragma unroll
            for (int ai = 0; ai < 2; ++ai)
#pragma unroll
                for (int m = 0; m < 4; ++m) {
                    asm volatile("" ::: "memory"); const int r = u.pm * 256 + ai * 128 + wr * 64 + m * 16 + fr;
                    {
                        float v[8]; ld8(acc[ai][0][m], v);
                        const int c = wc * 32 + fq * 8;
                        const pg8::f32x4 g0 = *(const pg8::f32x4*)(g_kv_a + c), g1 = *(const pg8::f32x4*)(g_kv_a + c + 4);
                        float part = 0.f;
#pragma unroll
                        for (int e = 0; e < 8; ++e) { part += v[e] * v[e]; v[e] *= (e < 4 ? g0[e & 3] : g1[e & 3]); }
                        *(v4u*)(KVA + (size_t)r * 256 + c) = pack8(v);
                        part += __shfl_xor(part, 16); part += __shfl_xor(part, 32);
                        if (fq == 0) atomicAdd(sskv + r, part);
                    }
                    if (wc == 0) {
                        float v[8]; ld8(acc[ai][1][m], v);
                        float ss = 0.f;
#pragma unroll
                        for (int e = 0; e < 8; ++e) ss += v[e] * v[e];
                        ss += __shfl_xor(ss, 16); ss += __shfl_xor(ss, 32);
                        const float rstd = 1.0f / sqrtf(ss * (1.0f / 32.0f) + EPSF);
                        const pg8::f32x4 g0 = *(const pg8::f32x4*)(g_kr + fq * 8), g1 = *(const pg8::f32x4*)(g_kr + fq * 8 + 4);
#pragma unroll
                        for (int e = 0; e < 8; ++e) v[e] *= rstd * (e < 4 ? g0[e & 3] : g1[e & 3]);
                        if (!lat) {
                            float* o = out_krope + ((size_t)((r >> 8) * 2 + layer) * 256 + (r & 255)) * 32 + fq * 8;
                            *(pg8::f32x4*)o = (pg8::f32x4){v[0], v[1], v[2], v[3]}; *(pg8::f32x4*)(o + 4) = (pg8::f32x4){v[4], v[5], v[6], v[7]};
                        } else {
                            const int n = (r - M_CTX) & 1023, pos = (fq < 2) ? (n >> 6) : (n & 63);
                            const float2* tb = tab32 + pos * 8;
#pragma unroll
                            for (int e = 0; e < 8; ++e) { const float pv = __shfl_xor(v[e], 16); const float2 cs = tb[e]; v[e] = ((fq & 1) == 0) ? (v[e] * cs.x - pv * cs.y) : (pv * cs.y + v[e] * cs.x); }
                        }
                        *(v4u*)(KR + (size_t)r * 32 + fq * 8) = pack8(v);
                    }
                }
        }
    }
};

struct EpiQ {
    static constexpr bool PERM = true, AFTER_DRAIN = false;
    bf16* Q; const float* ssq; const float *g_qn, *g_qr; const float2* tab32;
    __device__ __forceinline__ void operator()(const pg8::f32x4 (&acc)[2][2][4][2], const pg8::Unit& u, int wr, int wc, int fr, int fq) const {
        asm volatile("" : "+v"(fr), "+v"(fq));
        const int pn = u.pn; const bool lat = u.pm >= 32;
#pragma unroll
        for (int ai = 0; ai < 2; ++ai)
#pragma unroll
            for (int m = 0; m < 4; ++m) {
                asm volatile("" ::: "memory"); const int r = u.pm * 256 + ai * 128 + wr * 64 + m * 16 + fr;
                const float a2 = 1.0f / (ssq[r] * (1.0f / 256.0f) + EPSF);
                if (pn < 2) {
                    float v0[8], v1[8]; ld8(acc[ai][0][m], v0); ld8(acc[ai][1][m], v1);
                    float ss = 0.f;
#pragma unroll
                    for (int e = 0; e < 8; ++e) ss += v0[e] * v0[e] + v1[e] * v1[e];
                    ss += __shfl_xor(ss, 16); ss += __shfl_xor(ss, 32);
                    const float f = sqrtf(a2) * (1.0f / sqrtf(a2 * ss * (1.0f / 64.0f) + EPSF)) * QSCALE;
                    const int h = 4 * pn + wc;
                    const pg8::f32x4 ga = *(const pg8::f32x4*)(g_qn + fq * 8), gb = *(const pg8::f32x4*)(g_qn + fq * 8 + 4), gc = *(const pg8::f32x4*)(g_qn + 32 + fq * 8), gd = *(const pg8::f32x4*)(g_qn + 32 + fq * 8 + 4);
#pragma unroll
                    for (int e = 0; e < 8; ++e) { v0[e] *= f * (e < 4 ? ga[e & 3] : gb[e & 3]); v1[e] *= f * (e < 4 ? gc[e & 3] : gd[e & 3]); }
                    bf16* o = Q + (size_t)r * 768 + h * 96 + fq * 8;
                    *(v4u*)o = pack8(v0); *(v4u*)(o + 32) = pack8(v1);
                } else {
                    const int n = (r - M_CTX) & 1023, pos = (fq < 2) ? (n >> 6) : (n & 63);
                    const float2* tb = tab32 + pos * 8;
                    const pg8::f32x4 g0 = *(const pg8::f32x4*)(g_qr + fq * 8), g1 = *(const pg8::f32x4*)(g_qr + fq * 8 + 4);
#pragma unroll
                    for (int bj = 0; bj < 2; ++bj) {
                        float v[8]; ld8(acc[ai][bj][m], v);
                        float ss = 0.f;
#pragma unroll
                        for (int e = 0; e < 8; ++e) ss += v[e] * v[e];
                        ss += __shfl_xor(ss, 16); ss += __shfl_xor(ss, 32);
                        const float f = sqrtf(a2) * (1.0f / sqrtf(a2 * ss * (1.0f / 32.0f) + EPSF)) * QSCALE;
#pragma unroll
                        for (int e = 0; e < 8; ++e) v[e] *= f * (e < 4 ? g0[e & 3] : g1[e & 3]);
                        if (lat) {
#pragma unroll
                            for (int e = 0; e < 8; ++e) { const float pv = __shfl_xor(v[e], 16); const float2 cs = tb[e]; v[e] = ((fq & 1) == 0) ? (v[e] * cs.x - pv * cs.y) : (pv * cs.y + v[e] * cs.x); }
                        }
                        const int h = 4 * bj + wc;
                        *(v4u*)(Q + (size_t)r * 768 + h * 96 + 64 + fq * 8) = pack8(v);
                    }
                }
            }
    }
};

struct EpiKV {
    static constexpr bool PERM = true, AFTER_DRAIN = false;
    bf16 *KN, *VT; const float* sskv; const float* g_kn;
    __device__ __forceinline__ void operator()(const pg8::f32x4 (&acc)[2][2][4][2], const pg8::Unit& u, int wr, int wc, int fr, int fq) const {
        asm volatile("" : "+v"(fr), "+v"(fq));
        const int pn = u.pn;
#pragma unroll
        for (int ai = 0; ai < 2; ++ai)
#pragma unroll
            for (int m = 0; m < 4; ++m) {
                asm volatile("" ::: "memory"); const int r = u.pm * 256 + ai * 128 + wr * 64 + m * 16 + fr;
                const float a2 = (r < M_TOK) ? 1.0f / (sskv[r < M_TOK ? r : 0] * (1.0f / 128.0f) + EPSF) : 1.0f;
                if (pn < 2) {
                    float v0[8], v1[8]; ld8(acc[ai][0][m], v0); ld8(acc[ai][1][m], v1);
                    float ss = 0.f;
#pragma unroll
                    for (int e = 0; e < 8; ++e) ss += v0[e] * v0[e] + v1[e] * v1[e];
                    ss += __shfl_xor(ss, 16); ss += __shfl_xor(ss, 32);
                    const float f = sqrtf(a2) * (1.0f / sqrtf(a2 * ss * (1.0f / 64.0f) + EPSF));
                    const int h = 4 * pn + wc;
                    const pg8::f32x4 ga = *(const pg8::f32x4*)(g_kn + fq * 8), gb = *(const pg8::f32x4*)(g_kn + fq * 8 + 4), gc = *(const pg8::f32x4*)(g_kn + 32 + fq * 8), gd = *(const pg8::f32x4*)(g_kn + 32 + fq * 8 + 4);
#pragma unroll
                    for (int e = 0; e < 8; ++e) { v0[e] *= f * (e < 4 ? ga[e & 3] : gb[e & 3]); v1[e] *= f * (e < 4 ? gc[e & 3] : gd[e & 3]); }
                    bf16* o = KN + (size_t)r * 512 + h * 64 + fq * 8;
                    *(v4u*)o = pack8(v0); *(v4u*)(o + 32) = pack8(v1);
                } else {
                    const float al = sqrtf(a2); const int h = 4 * (pn - 2) + wc;
#pragma unroll
                    for (int bj = 0; bj < 2; ++bj) {
                        float v[8]; ld8(acc[ai][bj][m], v);
#pragma unroll
                        for (int e = 0; e < 8; ++e) VT[(size_t)(h * 64 + bj * 32 + fq * 8 + e) * M_KV + r] = f2b(v[e] * al);
                    }
                }
            }
    }
};

struct EpiRes {
    static constexpr bool PERM = false, AFTER_DRAIN = false;
    const float *xs0, *xs1;
    float* out; const float* gate;
    __device__ __forceinline__ void operator()(const pg8::f32x4 (&acc)[2][2][4][2], const pg8::Unit& u, int wr, int wc, int fr, int fq) const {
        asm volatile("" : "+v"(fr), "+v"(fq));
        const int cond = (u.pm < 32) ? 0 : 1 + ((u.pm - 32) >> 2);
        const float* gp = gate + cond * 6144;
        const int col0 = u.pn * 256 + wc * 32 + 4 * fq;
        pg8::f32x4 gv[2][2];
#pragma unroll
        for (int bj = 0; bj < 2; ++bj)
#pragma unroll
            for (int n = 0; n < 2; ++n) gv[bj][n] = *(const pg8::f32x4*)(gp + col0 + bj * 128 + n * 16);
#pragma unroll
        for (int ai = 0; ai < 2; ++ai)
#pragma unroll
            for (int m = 0; m < 4; ++m) {
                asm volatile("" ::: "memory"); const int r = u.pm * 256 + ai * 128 + wr * 64 + m * 16 + fr;
                const float* src = (r < M_CTX) ? xs0 + (size_t)r * 1024 : xs1 + (size_t)(r - M_CTX) * 1024;
                float* dst = out + (size_t)r * 1024;
#pragma unroll
                for (int bj = 0; bj < 2; ++bj)
#pragma unroll
                    for (int n = 0; n < 2; ++n) { const int c = col0 + bj * 128 + n * 16; const pg8::f32x4 x = *(const pg8::f32x4*)(src + c); *(pg8::f32x4*)(dst + c) = x + gv[bj][n] * acc[ai][bj][m][n]; }
            }
    }
};

struct EpiFfn {
    static constexpr bool PERM = true, AFTER_DRAIN = false;
    bf16* ACT;
    __device__ __forceinline__ void operator()(const pg8::f32x4 (&acc)[2][2][4][2], const pg8::Unit& u, int wr, int wc, int fr, int fq) const {
        asm volatile("" : "+v"(fr), "+v"(fq));
#pragma unroll
        for (int ai = 0; ai < 2; ++ai)
#pragma unroll
            for (int m = 0; m < 4; ++m) {
                asm volatile("" ::: "memory"); const int r = u.pm * 256 + ai * 128 + wr * 64 + m * 16 + fr;
                float g[8], up[8]; ld8(acc[ai][0][m], g); ld8(acc[ai][1][m], up);
#pragma unroll
                for (int e = 0; e < 8; ++e) g[e] = siluf(g[e]) * up[e];
                *(v4u*)(ACT + (size_t)r * D_FFN + u.pn * 128 + wc * 32 + fq * 8) = pack8(g);
            }
    }
};

struct Frame {
    LAS unsigned char* lds;
    volatile LAS unsigned* MISC;
    gu32* ctl;
    int tid, lane, wave, G, bx;
};

__device__ __forceinline__ int fresh_tid(int wave) { int lane; asm volatile("v_mbcnt_lo_u32_b32 %0, -1, 0\n\tv_mbcnt_hi_u32_b32 %0, -1, %0" : "=v"(lane)); return (wave << 6) | lane; }
__device__ __forceinline__ void frame_refresh(Frame& F) { const int t = fresh_tid(F.wave); F.tid = t; F.lane = t & 63; }
__device__ __forceinline__ float wave_sum(float v) {
#pragma unroll
    for (int o = 1; o < 64; o <<= 1) v += __shfl_xor(v, o);
    return v;
}

__device__ __forceinline__ void transpose_item(const float* W, int Nsrc, int Ksrc, bf16* WT, int Kdst, int k0, int n0dst, int sc0, float scale, LAS float* scr, int lane) {
    const bool zero = (sc0 < 0) || (k0 >= Ksrc);
    if (!zero) {
#pragma unroll 8
        for (int i = 0; i < 32; ++i) { const int kk = 2 * i + (lane >> 5); scr[kk * 33 + (lane & 31)] = W[(size_t)(k0 + kk) * Nsrc + sc0 + (lane & 31)] * scale; }
    }
    LDS_WAIT(); asm volatile("" ::: "memory");
    const int c = lane & 7;
#pragma unroll
    for (int j = 0; j < 4; ++j) { const int n = (lane >> 3) + 8 * j; const LAS float* s = scr + (8 * c) * 33 + n;
        v4u o; if (zero) { o = (v4u){0u, 0u, 0u, 0u}; } else { o.x = cvtpk(s[0 * 33], s[1 * 33]); o.y = cvtpk(s[2 * 33], s[3 * 33]); o.z = cvtpk(s[4 * 33], s[5 * 33]); o.w = cvtpk(s[6 * 33], s[7 * 33]); }
        *(GAS v4u*)(WT + (size_t)(n0dst + n) * Kdst + k0 + 8 * c) = o; }
    LDS_WAIT(); asm volatile("" ::: "memory");
}
__device__ __forceinline__ int map_win(int nb) { return nb < 77 ? nb * 32 : -1; }
__device__ __forceinline__ int map_wqb(int nb) { const int c = nb * 32; if (c < 512) { const int pn = c >> 8, bj = (c >> 7) & 1, wc = (c >> 5) & 3; return (4 * pn + wc) * 96 + 32 * bj; } const int cc = c - 512, bj = cc >> 7, wc = (cc >> 5) & 3; return (4 * bj + wc) * 96 + 64; }
__device__ __forceinline__ int map_wkvb(int nb) { const int c = nb * 32, pn = c >> 8, bj = (c >> 7) & 1, wc = (c >> 5) & 3; return pn < 2 ? (4 * pn + wc) * 128 + 32 * bj : (4 * (pn - 2) + wc) * 128 + 64 + 32 * bj; }
__device__ __forceinline__ int map_wfi(int nb) { const int c = nb * 32, pn = c >> 8, bj = (c >> 7) & 1, j = c & 127; return bj * D_FFN + 128 * pn + j; }

__device__ __forceinline__ void p0_prologue(Frame& F, const Params& P) {
    unsigned char* ws = P.ws;
    if (F.bx < 192) {
        const int l = F.bx / 96, n0 = (F.bx % 96) * 64;
        LAS float* sil = (LAS float*)(F.lds);
        LAS float* red = (LAS float*)(F.lds + 12288);
        for (int i = F.tid; i < 3072; i += 512) { const int cd = i >> 10, k = i & 1023; const float x = (cd == 0) ? P.in[7][k] : P.in[6][(cd - 1) * 1024 + k]; sil[i] = siluf(x); }
        __syncthreads();
        const float* W = P.in[8] + (size_t)l * 1024 * 6144 + n0 + F.lane;
        float a0 = 0.f, a1 = 0.f, a2 = 0.f;
        const int kb = F.wave * 128;
#pragma unroll 16
        for (int k = 0; k < 128; ++k) { const float w = W[(size_t)(kb + k) * 6144]; a0 += sil[kb + k] * w; a1 += sil[1024 + kb + k] * w; a2 += sil[2048 + kb + k] * w; }
        red[(F.wave * 3 + 0) * 64 + F.lane] = a0; red[(F.wave * 3 + 1) * 64 + F.lane] = a1; red[(F.wave * 3 + 2) * 64 + F.lane] = a2;
        __syncthreads();
        if (F.tid < 192) { const int cd = F.tid >> 6, cl = F.tid & 63; float s = P.in[9][l * 6144 + n0 + cl];
#pragma unroll
            for (int w = 0; w < 8; ++w) s += red[(w * 3 + cd) * 64 + cl];
            ((float*)(ws + WS_MOD))[(l * 3 + cd) * 6144 + n0 + cl] = s; }
        __syncthreads();
    }
    if (F.bx == F.G - 1) {
        float2* t64 = (float2*)(ws + WS_TAB); float2* t32 = t64 + 64 * 16;
        for (int i = F.tid; i < 64 * 16; i += 512) { const int pos = i >> 4, j = i & 15; const float inv = powf(10000.0f, -(float)j / 16.0f); const float ang = (float)pos * inv; float s, c; sincosf(ang, &s, &c); t64[i] = make_float2(c, s); }
        for (int i = F.tid; i < 64 * 8; i += 512) { const int pos = i >> 3, j = i & 7; const float inv = powf(10000.0f, -(float)j / 8.0f); const float ang = (float)pos * inv; float s, c; sincosf(ang, &s, &c); t32[i] = make_float2(c, s); }
    }
    {
        LAS float* scr = (LAS float*)(F.lds + RING_OFF + F.wave * 16384);
        const int gw = F.bx * NWAVES + F.wave, NGW = F.G * NWAVES;
        constexpr int I_IN = 16 * 80, I_QB = 4 * 24, I_KVB = 4 * 32, I_O = 16 * 32, I_FI = 16 * 176, I_FO = 44 * 32, I_L = I_IN + I_QB + I_KVB + I_O + I_FI + I_FO;
        for (int it = gw; it < 2 * I_L; it += NGW) {
            const int l = it / I_L; int r = it % I_L;
            unsigned char* wl = ws + WS_W + (size_t)l * LAYER_W;
            if (r < I_IN) { const int kb = r / 80, nb = r % 80; const int sc = map_win(nb); transpose_item(P.in[12] + (size_t)l * 1024 * 2464, 2464, 1024, (bf16*)(wl + W_IN_OFF), 1024, 64 * kb, 32 * nb, sc, (nb >= 16 && nb < 32) ? 0.125f : 1.0f, scr, F.lane); continue; } r -= I_IN;
            if (r < I_QB) { const int kb = r / 24, nb = r % 24; transpose_item(P.in[14] + (size_t)l * 256 * 768, 768, 256, (bf16*)(wl + W_QB_OFF), 256, 64 * kb, 32 * nb, map_wqb(nb), 1.0f, scr, F.lane); continue; } r -= I_QB;
            if (r < I_KVB) { const int kb = r / 32, nb = r % 32; transpose_item(P.in[16] + (size_t)l * 128 * 1024, 1024, 128, (bf16*)(wl + W_KVB_OFF), 256, 64 * kb, 32 * nb, map_wkvb(nb), 1.0f, scr, F.lane); continue; } r -= I_KVB;
            if (r < I_O) { const int kb = r / 32, nb = r % 32; transpose_item(P.in[25] + (size_t)l * 1024 * 1024, 1024, 1024, (bf16*)(wl + W_O_OFF), 1024, 64 * kb, 32 * nb, 32 * nb, 1.0f, scr, F.lane); continue; } r -= I_O;
            if (r < I_FI) { const int kb = r / 176, nb = r % 176; transpose_item(P.in[26] + (size_t)l * 1024 * N_FI, N_FI, 1024, (bf16*)(wl + W_FI_OFF), 1024, 64 * kb, 32 * nb, map_wfi(nb), 1.0f, scr, F.lane); continue; } r -= I_FI;
            { const int kb = r / 32, nb = r % 32; transpose_item(P.in[27] + (size_t)l * D_FFN * 1024, 1024, D_FFN, (bf16*)(wl + W_FO_OFF), D_FFN, 64 * kb, 32 * nb, 32 * nb, 1.0f, scr, F.lane); }
        }
        v4u* kz = (v4u*)(ws + WS_KVA); const size_t nz = (size_t)M_KV * 256 * 2 / 16;
        for (size_t i = (size_t)F.bx * 512 + F.tid; i < nz; i += (size_t)F.G * 512) kz[i] = (v4u){0u, 0u, 0u, 0u};
    }
}

__device__ __forceinline__ void norm_phase(Frame& F, const Params& P, int layer, int which) {
    unsigned char* ws = P.ws;
    const int gw = F.bx * NWAVES + F.wave, NGW = F.G * NWAVES;
    const float* g = P.in[which == 0 ? 10 : 11] + layer * 1024;
    const float* mod = (const float*)(ws + WS_MOD) + (size_t)layer * 3 * 6144;
    bf16* H = (bf16*)(ws + WS_H);
    const int nrows = (which == 0) ? M_KV : M_TOK;
    for (int m = gw; m < nrows; m += NGW) {
        if (m < M_TOK) {
            const float* xrow;
            if (which == 0 && layer == 0) xrow = (m < M_CTX) ? P.in[0] + (size_t)m * 1024 : P.in[1] + (size_t)(m - M_CTX) * 1024;
            else xrow = P.out + (size_t)m * 1024;
            const int cond = (m < M_CTX) ? 0 : 1 + ((m - M_CTX) >> 10);
            const float* sh = mod + cond * 6144 + (which == 0 ? 0 : 3) * 1024;
            const float* sc = sh + 1024;
            const GAS f32x4* xr = (const GAS f32x4*)xrow + F.lane;
            f32x4 v[4]; float s = 0.f;
#pragma unroll
            for (int j = 0; j < 4; ++j) { v[j] = xr[64 * j]; s += (v[j].x * v[j].x + v[j].y * v[j].y) + (v[j].z * v[j].z + v[j].w * v[j].w); }
            const float rstd = 1.0f / sqrtf(wave_sum(s) * (1.0f / 1024.0f) + EPSF);
            GAS unsigned long long* o8 = (GAS unsigned long long*)(H + (size_t)m * 1024) + F.lane;
#pragma unroll
            for (int j = 0; j < 4; ++j) {
                const f32x4 gg = *((const f32x4*)g + F.lane + 64 * j), s1 = *((const f32x4*)sc + F.lane + 64 * j), h1 = *((const f32x4*)sh + F.lane + 64 * j);
                const f32x4 y = v[j] * rstd * gg * (s1 + 1.0f) + h1;
                o8[64 * j] = (unsigned long long)cvtpk(y.x, y.y) | ((unsigned long long)cvtpk(y.z, y.w) << 32);
            }
        } else {
            const int cr = m - M_TOK, b = cr >> 8, n = cr & 255;
            const float* ck = P.in[2] + ((size_t)(b * 2 + layer) * 256 + n) * 128;
            const float* kr = P.in[3] + ((size_t)(b * 2 + layer) * 256 + n) * 32;
            bf16* KVA = (bf16*)(ws + WS_KVA); bf16* KR = (bf16*)(ws + WS_KR);
            const f32x2_t a = *((const f32x2_t*)ck + F.lane);
            *((unsigned*)(KVA + (size_t)m * 256) + F.lane) = cvtpk(a.x, a.y);
            if (F.lane < 16) { const f32x2_t k2 = *((const f32x2_t*)kr + F.lane); *((unsigned*)(KR + (size_t)m * 32) + F.lane) = cvtpk(k2.x, k2.y); }
        }
    }
}

struct MixP {
    const bf16 *Q, *KN, *KR, *VT, *RQ, *RK, *RKT, *RVT, *RG;
    bf16* MIX;
    const float *s_f0, *s_b0;
    const float *p_f, *p_b;
    const float *g_gn, *b_gn;
    float *out_sf, *out_sb;
    int layer;
};
constexpr int KS_OFF = 0, VS_OFF = 16384, VSTR = 136;

template <bool ATT>
__device__ __forceinline__ void mix_unit(const MixP& P, LAS unsigned char* lds, int b, int h, int qb, bool lat, int tid) {
    constexpr int DK = ATT ? 96 : 64, NKS = DK / 16, KSTR = DK * 2 + 16, KCH = DK / 8;
    asm volatile("" : "+v"(tid));
    const int lane = tid & 63, w = __builtin_amdgcn_readfirstlane(tid >> 6), c = lane & 31, hh = lane >> 5;
    const int seq0 = lat ? (M_CTX + b * 1024) : b * 256;
    const int nown = lat ? 16 : 4;
    const int nt = lat ? (ATT ? 20 : 18) : 4;
    const int qpos = qb * 256 + w * 32 + c;
    const int qrow = seq0 + qpos;
    const int NSEQ = lat ? 1024 : 256;
    pg8::bf16x8 qf[NKS];
    {
        const bf16* qp = ATT ? P.Q + (size_t)qrow * 768 + h * 96 : P.RQ + (size_t)qrow * 512 + h * 64;
#pragma unroll
        for (int ks = 0; ks < NKS; ++ks) qf[ks] = *(const pg8::bf16x8*)(qp + 16 * ks + 8 * hh);
    }
    float lgf2 = 0.f, lgb2 = 0.f;
    if (!ATT) { lgf2 = log1pf(-exp2f(-P.p_f[h])) * 1.4426950408889634f; lgb2 = log1pf(-exp2f(-P.p_b[h])) * 1.4426950408889634f; }
    f32x16 o0 = {}, o1 = {};
    float lsum = 0.f;
    const int krow_a = ATT ? (tid / KCH) : (tid >> 3), kch_a = ATT ? (tid % KCH) : (tid & 7);
    const int cid_b = tid + 512; const int krow_b = cid_b / KCH, kch_b = cid_b % KCH; const bool has_b = ATT && (tid < 256);
    const int vrow = tid >> 3, vch = tid & 7;
    v4u ka = {}, kb = {}, va = {};
#define MIX_ISSUE(t) do { const int kr_ = ((t) < nown) ? seq0 + 64 * (t) : (M_TOK + b * 256 + 64 * ((t) - nown)); \
        if (ATT) { ka = (kch_a < 8) ? *(const v4u*)(P.KN + (size_t)(kr_ + krow_a) * 512 + h * 64 + kch_a * 8) : *(const v4u*)(P.KR + (size_t)(kr_ + krow_a) * 32 + (kch_a - 8) * 8); \
                   if (has_b) kb = (kch_b < 8) ? *(const v4u*)(P.KN + (size_t)(kr_ + krow_b) * 512 + h * 64 + kch_b * 8) : *(const v4u*)(P.KR + (size_t)(kr_ + krow_b) * 32 + (kch_b - 8) * 8); \
                   va = *(const v4u*)(P.VT + (size_t)(h * 64 + vrow) * M_KV + kr_ + vch * 8); } \
        else { ka = *(const v4u*)(P.RK + (size_t)(kr_ + krow_a) * 512 + h * 64 + kch_a * 8); va = *(const v4u*)(P.RVT + (size_t)(h * 64 + vrow) * M_TOK + kr_ + vch * 8); } } while (0)
    MIX_ISSUE(0);
    for (int t = 0; t < nt; ++t) {
        const bool state_tile = (!ATT) && (t >= nown);
        __syncthreads();
        if (!state_tile) {
            *(LAS v4u*)(lds + KS_OFF + krow_a * KSTR + kch_a * 16) = ka;
            if (has_b) *(LAS v4u*)(lds + KS_OFF + krow_b * KSTR + kch_b * 16) = kb;
            *(LAS u32x2*)(lds + VS_OFF + vrow * VSTR + vch * 16) = (u32x2){va.x, va.y};
            *(LAS u32x2*)(lds + VS_OFF + vrow * VSTR + vch * 16 + 8) = (u32x2){va.z, va.w};
        } else {
            v4u idv; { unsigned wd[4];
#pragma unroll
                for (int q = 0; q < 4; ++q) { const int d0 = kch_a * 8 + 2 * q; wd[q] = (d0 == krow_a ? 0x3F80u : 0u) | (d0 + 1 == krow_a ? 0x3F800000u : 0u); }
                idv = (v4u){wd[0], wd[1], wd[2], wd[3]}; }
            *(LAS v4u*)(lds + KS_OFF + krow_a * KSTR + kch_a * 16) = idv;
            const float* S0 = ((t == nown) ? P.s_f0 : P.s_b0) + ((size_t)(b * 2 + P.layer) * 8 + h) * 4096;
#pragma unroll
            for (int i = 0; i < 8; ++i) { const int e = tid + 512 * i, dk = e >> 6, dv = e & 63; *(LAS bf16*)(lds + VS_OFF + dv * VSTR + dk * 2) = f2b(S0[e]); }
        }
        __syncthreads();
        if (t + 1 < nt && !((!ATT) && (t + 1 >= nown))) MIX_ISSUE(t + 1);
        f32x16 s0 = {}, s1 = {};
#pragma unroll
        for (int ks = 0; ks < NKS; ++ks) {
            const pg8::bf16x8 a0 = *(const LAS pg8::bf16x8*)(lds + KS_OFF + c * KSTR + (16 * ks + 8 * hh) * 2);
            const pg8::bf16x8 a1 = *(const LAS pg8::bf16x8*)(lds + KS_OFF + (32 + c) * KSTR + (16 * ks + 8 * hh) * 2);
            s0 = __builtin_amdgcn_mfma_f32_32x32x16_bf16(a0, qf[ks], s0, 0, 0, 0);
            s1 = __builtin_amdgcn_mfma_f32_32x32x16_bf16(a1, qf[ks], s1, 0, 0, 0);
        }
        if (ATT) {
#pragma unroll
            for (int r = 0; r < 16; ++r) { s0[r] = __builtin_amdgcn_exp2f(s0[r]); s1[r] = __builtin_amdgcn_exp2f(s1[r]); lsum += s0[r] + s1[r]; }
        } else if (!state_tile) {
            const int kbase = 64 * t + 4 * hh;
#pragma unroll
            for (int r = 0; r < 16; ++r) {
                const int kj = kbase + (r & 3) + 8 * (r >> 2);
                const float d0 = (float)(qpos - kj), d1 = (float)(qpos - kj - 32);
                float e0 = d0 > 0.f ? d0 * lgf2 : -d0 * lgb2, e1 = d1 > 0.f ? d1 * lgf2 : -d1 * lgb2;
                float w0 = __builtin_amdgcn_exp2f(e0), w1 = __builtin_amdgcn_exp2f(e1);
                w0 = (d0 == 0.f) ? 2.0f : w0; w1 = (d1 == 0.f) ? 2.0f : w1;
                s0[r] *= w0; s1[r] *= w1;
            }
        } else {
            const float wq = (t == nown) ? __builtin_amdgcn_exp2f((float)(qpos + 1) * lgf2) : __builtin_amdgcn_exp2f((float)(NSEQ - qpos) * lgb2);
#pragma unroll
            for (int r = 0; r < 16; ++r) { s0[r] *= wq; s1[r] *= wq; }
        }
        pg8::bf16x8 pf[2][2];
        { v4u t0, t1, t2, t3;
          t0 = (v4u){cvtpk(s0[0], s0[1]), cvtpk(s0[2], s0[3]), cvtpk(s0[4], s0[5]), cvtpk(s0[6], s0[7])};
          t1 = (v4u){cvtpk(s0[8], s0[9]), cvtpk(s0[10], s0[11]), cvtpk(s0[12], s0[13]), cvtpk(s0[14], s0[15])};
          t2 = (v4u){cvtpk(s1[0], s1[1]), cvtpk(s1[2], s1[3]), cvtpk(s1[4], s1[5]), cvtpk(s1[6], s1[7])};
          t3 = (v4u){cvtpk(s1[8], s1[9]), cvtpk(s1[10], s1[11]), cvtpk(s1[12], s1[13]), cvtpk(s1[14], s1[15])};
          pf[0][0] = __builtin_bit_cast(pg8::bf16x8, t0); pf[0][1] = __builtin_bit_cast(pg8::bf16x8, t1); pf[1][0] = __builtin_bit_cast(pg8::bf16x8, t2); pf[1][1] = __builtin_bit_cast(pg8::bf16x8, t3); }
#pragma unroll
        for (int kt = 0; kt < 2; ++kt)
#pragma unroll
            for (int s = 0; s < 2; ++s) {
                const int koff = (32 * kt + 16 * s + 4 * hh) * 2;
                const u32x2 l0 = *(const LAS u32x2*)(lds + VS_OFF + c * VSTR + koff), h0 = *(const LAS u32x2*)(lds + VS_OFF + c * VSTR + koff + 16);
                const u32x2 l1 = *(const LAS u32x2*)(lds + VS_OFF + (32 + c) * VSTR + koff), h1 = *(const LAS u32x2*)(lds + VS_OFF + (32 + c) * VSTR + koff + 16);
                const pg8::bf16x8 vf0 = __builtin_bit_cast(pg8::bf16x8, (v4u){l0.x, l0.y, h0.x, h0.y});
                const pg8::bf16x8 vf1 = __builtin_bit_cast(pg8::bf16x8, (v4u){l1.x, l1.y, h1.x, h1.y});
                o0 = __builtin_amdgcn_mfma_f32_32x32x16_bf16(vf0, pf[kt][s], o0, 0, 0, 0);
                o1 = __builtin_amdgcn_mfma_f32_32x32x16_bf16(vf1, pf[kt][s], o1, 0, 0, 0);
            }
    }
#undef MIX_ISSUE
    if (ATT) {
        lsum += __shfl_xor(lsum, 32);
        const float inv = 1.0f / lsum;
        bf16* op = P.MIX + (size_t)qrow * 1024 + 512 + h * 64 + 4 * hh;
#pragma unroll
        for (int g = 0; g < 4; ++g) {
            *(u32x2*)(op + 8 * g) = (u32x2){cvtpk(o0[4 * g] * inv, o0[4 * g + 1] * inv), cvtpk(o0[4 * g + 2] * inv, o0[4 * g + 3] * inv)};
            *(u32x2*)(op + 32 + 8 * g) = (u32x2){cvtpk(o1[4 * g] * inv, o1[4 * g + 1] * inv), cvtpk(o1[4 * g + 2] * inv, o1[4 * g + 3] * inv)};
        }
    } else {
        float sum = 0.f;
#pragma unroll
        for (int r = 0; r < 16; ++r) sum += o0[r] + o1[r];
        sum += __shfl_xor(sum, 32);
        const float mu = sum * (1.0f / 64.0f);
        float var = 0.f;
#pragma unroll
        for (int r = 0; r < 16; ++r) { const float a = o0[r] - mu, bq = o1[r] - mu; var += a * a + bq * bq; }
        var += __shfl_xor(var, 32);
        const float rstd = 1.0f / sqrtf(var * (1.0f / 64.0f) + EPSF);
        const int cbase = h * 64 + 4 * hh;
        bf16* op = P.MIX + (size_t)qrow * 1024 + cbase;
        const bf16* rgp = P.RG + (size_t)qrow * 512 + cbase;
#pragma unroll
        for (int g = 0; g < 4; ++g) {
#pragma unroll
            for (int dvt = 0; dvt < 2; ++dvt) {
                const int cc = 32 * dvt + 8 * g;
                const f32x4 gg = *(const f32x4*)(P.g_gn + cbase + cc), bb = *(const f32x4*)(P.b_gn + cbase + cc);
                const u32x2 rg2 = *(const u32x2*)(rgp + cc);
                float y[4];
#pragma unroll
                for (int i = 0; i < 4; ++i) { const float ov = dvt ? o1[4 * g + i] : o0[4 * g + i]; y[i] = (ov - mu) * rstd * gg[i] + bb[i]; }
                y[0] *= b2f((unsigned short)(rg2.x & 0xffffu)); y[1] *= b2f((unsigned short)(rg2.x >> 16)); y[2] *= b2f((unsigned short)(rg2.y & 0xffffu)); y[3] *= b2f((unsigned short)(rg2.y >> 16));
                *(u32x2*)(op + cc) = (u32x2){cvtpk(y[0], y[1]), cvtpk(y[2], y[3])};
            }
        }
        if (!lat) {
            const int st = w >> 2, dkt = (w >> 1) & 1, dvt = w & 1;
            const float lg = st ? lgb2 : lgf2;
            const bf16* kp = P.RKT + (size_t)(h * 64 + 32 * dkt + c) * M_CTX + b * 256 + 8 * hh;
            const bf16* vp = P.RVT + (size_t)(h * 64 + 32 * dvt + c) * M_TOK + b * 256 + 8 * hh;
            f32x16 acc = {};
#pragma unroll 4
            for (int ks = 0; ks < 16; ++ks) {
                const v4u kraw = *(const v4u*)(kp + 16 * ks);
                const pg8::bf16x8 vfr = *(const pg8::bf16x8*)(vp + 16 * ks);
                const int tok0 = 16 * ks + 8 * hh;
                float kv[8];
                kv[0] = b2f((unsigned short)(kraw.x & 0xffffu)); kv[1] = b2f((unsigned short)(kraw.x >> 16)); kv[2] = b2f((unsigned short)(kraw.y & 0xffffu)); kv[3] = b2f((unsigned short)(kraw.y >> 16));
                kv[4] = b2f((unsigned short)(kraw.z & 0xffffu)); kv[5] = b2f((unsigned short)(kraw.z >> 16)); kv[6] = b2f((unsigned short)(kraw.w & 0xffffu)); kv[7] = b2f((unsigned short)(kraw.w >> 16));
#pragma unroll
                for (int j = 0; j < 8; ++j) { const float ex = st ? (float)(tok0 + j) : (float)(255 - tok0 - j); kv[j] *= __builtin_amdgcn_exp2f(ex * lg); }
                const pg8::bf16x8 kfr = __builtin_bit_cast(pg8::bf16x8, pack8(kv));
                acc = __builtin_amdgcn_mfma_f32_32x32x16_bf16(kfr, vfr, acc, 0, 0, 0);
            }
            float* so = (st ? P.out_sb : P.out_sf) + ((size_t)(b * 2 + P.layer) * 8 + h) * 4096 + 32 * dvt + c;
#pragma unroll
            for (int r = 0; r < 16; ++r) { const int dk = 32 * dkt + (r & 3) + 8 * (r >> 2) + 4 * hh; so[dk * 64] = acc[r]; }
        }
    }
}

__device__ __forceinline__ void mix_phase(Frame& F, const MixP& P) {
    const int v = F.bx; LAS unsigned char* lds = F.lds;
    for (int k = 0; k < 4; ++k) {
        int code = -1;
        if (F.G == 256) {
            if (v < 64) code = (k == 0) ? v : -1;
            else if (v < 128) code = (k == 0) ? v : (k == 1 ? 128 + (v - 64) : -1);
            else { const int idx = 64 + (v - 128) + 128 * k; code = (idx < 512) ? 128 + idx : -1; }
        } else { const int u = v + k * F.G; code = (u < 640 && F.G >= 160) ? u : -1; }
        if (code < 0) continue;
        const bool lat = code < 128;
        const bool att = lat ? (code < 64) : (code >= 384);
        const int uu = lat ? (code & 63) : ((code - 128) & 255);
        const int b = lat ? (uu >> 5) : (uu >> 3), h = lat ? ((uu >> 2) & 7) : (uu & 7), qb = lat ? (uu & 3) : 0;
        if (att) mix_unit<true>(P, lds, b, h, qb, lat, F.tid); else mix_unit<false>(P, lds, b, h, qb, lat, F.tid);
    }
}

__global__ void __launch_bounds__(NWAVES * 64, 2) mk_fwd(Params P) {
    extern __shared__ __attribute__((aligned(16))) unsigned char lds_raw[];
    Frame F;
    F.lds = (LAS unsigned char*)lds_raw;
    F.MISC = (volatile LAS unsigned*)(F.lds + MISC_OFF);
    F.wave = __builtin_amdgcn_readfirstlane((int)threadIdx.x >> 6); frame_refresh(F);
    F.G = gridDim.x; F.bx = blockIdx.x;
    unsigned char* ws = P.ws;
    F.ctl = (gu32*)(ws + WS_CTL);
    for (int u = F.tid; u < (LDS_BYTES - LDSCTL_OFF) / 4; u += NWAVES * 64) ((LAS unsigned*)(F.lds + LDSCTL_OFF))[u] = 0u;
    __syncthreads();
    XcdBarrier bar; bar.bar = (unsigned*)(F.ctl + CW_BAR); bar.x = 0; bar.st = nullptr;
    if (!MK_PER_PHASE) bar = xcd_barrier_post((unsigned*)(F.ctl + CW_BAR), F.MISC + 8, F.tid);
    const int lo = P.ph_lo, hi = P.ph_hi;
#define IN(k) (lo <= (k) && (k) < hi)
#define SEAM(k) do { if (IN(k) && IN((k) + 1)) xcd_barrier(bar, fresh_tid(F.wave)); } while (0)

    if (PH_EN(0) && IN(0)) { frame_refresh(F); p0_prologue(F, P); SEAM(0); }

    const float2* tab64 = (const float2*)(ws + WS_TAB); const float2* tab32 = tab64 + 64 * 16;
    for (int l = 0; l < 2; ++l) {
        const int pb = 1 + 8 * l;
        unsigned char* wl = ws + WS_W + (size_t)l * LAYER_W;
        const float* mod = (const float*)(ws + WS_MOD) + (size_t)l * 3 * 6144;
        float* ssq = (float*)(F.ctl + CW_SS) + (size_t)(l * 2 + 0) * M_TOK;
        float* sskv = (float*)(F.ctl + CW_SS) + (size_t)(l * 2 + 1) * M_TOK;
        if (PH_EN(1) && IN(pb + 0)) { frame_refresh(F); norm_phase(F, P, l, 0); SEAM(pb + 0); }
        if (PH_EN(2) && IN(pb + 1)) {
            pg8::Gemm g{(const pg8::bf16_t*)(ws + WS_H), (const pg8::bf16_t*)(wl + W_IN_OFF), M_TOK, N_IN, 1024}; pg8::StaticOrder S; S.init(M_TOK, N_IN, F.G, F.bx);
            EpiG1 E{(bf16*)(ws + WS_RQ), (bf16*)(ws + WS_RK), (bf16*)(ws + WS_RKT), (bf16*)(ws + WS_RVT), (bf16*)(ws + WS_RG), (bf16*)(ws + WS_QA), (bf16*)(ws + WS_KVA), (bf16*)(ws + WS_KR),
                    ssq, sskv, P.in[13] + l * 256, P.in[15] + l * 128, P.in[20] + l * 32, tab64, tab32, P.out + OUT_KROPE, l};
            pg8::gemm_phase<EpiG1, pg8::StaticOrder, true, true>(F.lds + RING_OFF, g, S, E, fresh_tid(F.wave));
            SEAM(pb + 1);
        }
        if (PH_EN(3) && IN(pb + 2)) {
            {
                pg8::Gemm g{(const pg8::bf16_t*)(ws + WS_QA), (const pg8::bf16_t*)(wl + W_QB_OFF), M_TOK, N_Q, 256}; pg8::StaticOrder S; S.init(M_TOK, N_Q, F.G, F.bx);
                EpiQ E{(bf16*)(ws + WS_Q), ssq, P.in[17] + l * 64, P.in[18] + l * 32, tab32};
                pg8::gemm_phase<EpiQ, pg8::StaticOrder, true, true>(F.lds + RING_OFF, g, S, E, fresh_tid(F.wave));
            }
            {
                pg8::Gemm g{(const pg8::bf16_t*)(ws + WS_KVA), (const pg8::bf16_t*)(wl + W_KVB_OFF), M_KV, N_KV, 256}; pg8::StaticOrder S; S.init(M_KV, N_KV, F.G, (F.bx + 136) % F.G);
                EpiKV E{(bf16*)(ws + WS_KN), (bf16*)(ws + WS_VT), sskv, P.in[19] + l * 64};
                pg8::gemm_phase<EpiKV, pg8::StaticOrder, true, true>(F.lds + RING_OFF, g, S, E, fresh_tid(F.wave));
            }
            {
                frame_refresh(F); const int gw = F.bx * NWAVES + F.wave, NGW = F.G * NWAVES;
                const bf16* KVA = (const bf16*)(ws + WS_KVA);
                for (int m = gw; m < M_CTX; m += NGW) {
                    const float rstd = 1.0f / sqrtf(sskv[m] * (1.0f / 128.0f) + EPSF);
                    const unsigned pk = *((const unsigned*)(KVA + (size_t)m * 256) + F.lane);
                    float* o = P.out + OUT_CKV + ((size_t)((m >> 8) * 2 + l) * 256 + (m & 255)) * 128 + 2 * F.lane;
                    *(f32x2_t*)o = (f32x2_t){b2f((unsigned short)(pk & 0xffffu)) * rstd, b2f((unsigned short)(pk >> 16)) * rstd};
                }
            }
            SEAM(pb + 2);
        }
        if (PH_EN(4) && IN(pb + 3)) {
            MixP MP{(const bf16*)(ws + WS_Q), (const bf16*)(ws + WS_KN), (const bf16*)(ws + WS_KR), (const bf16*)(ws + WS_VT), (const bf16*)(ws + WS_RQ), (const bf16*)(ws + WS_RK),
                    (const bf16*)(ws + WS_RKT), (const bf16*)(ws + WS_RVT), (const bf16*)(ws + WS_RG), (bf16*)(ws + WS_MIX), P.in[4], P.in[5], P.in[21] + l * 8, P.in[22] + l * 8,
                    P.in[23] + l * 512, P.in[24] + l * 512, P.out + OUT_SF, P.out + OUT_SB, l};
            frame_refresh(F); mix_phase(F, MP);
            SEAM(pb + 3);
        }
        if (PH_EN(5) && IN(pb + 4)) {
            pg8::Gemm g{(const pg8::bf16_t*)(ws + WS_MIX), (const pg8::bf16_t*)(wl + W_O_OFF), M_TOK, 1024, 1024}; pg8::StaticOrder S; S.init(M_TOK, 1024, F.G, F.bx);
            EpiRes E{l == 0 ? P.in[0] : P.out, l == 0 ? P.in[1] : P.out + (size_t)M_CTX * 1024, P.out, mod + 2 * 1024};
            pg8::gemm_phase<EpiRes, pg8::StaticOrder, true, true>(F.lds + RING_OFF, g, S, E, fresh_tid(F.wave));
            SEAM(pb + 4);
        }
        if (PH_EN(6) && IN(pb + 5)) { frame_refresh(F); norm_phase(F, P, l, 1); SEAM(pb + 5); }
        if (PH_EN(7) && IN(pb + 6)) {
            pg8::Gemm g{(const pg8::bf16_t*)(ws + WS_H), (const pg8::bf16_t*)(wl + W_FI_OFF), M_TOK, N_FI, 1024}; pg8::StaticOrder S; S.init(M_TOK, N_FI, F.G, F.bx);
            EpiFfn E{(bf16*)(ws + WS_ACT)};
            pg8::gemm_phase<EpiFfn, pg8::StaticOrder, true, true>(F.lds + RING_OFF, g, S, E, fresh_tid(F.wave));
            SEAM(pb + 6);
        }
        if (PH_EN(8) && IN(pb + 7)) {
            pg8::Gemm g{(const pg8::bf16_t*)(ws + WS_ACT), (const pg8::bf16_t*)(wl + W_FO_OFF), M_TOK, 1024, D_FFN}; pg8::StaticOrder S; S.init(M_TOK, 1024, F.G, F.bx);
            EpiRes E{P.out, P.out + (size_t)M_CTX * 1024, P.out, mod + 5 * 1024};
            pg8::gemm_phase<EpiRes, pg8::StaticOrder, true, true>(F.lds + RING_OFF, g, S, E, fresh_tid(F.wave));
            if (l == 0) SEAM(pb + 7);
        }
    }
#undef IN
#undef SEAM
}

extern "C" void kernel_launch(void* const* d_in, const int* in_sizes, int n_in, void* d_out, int out_size, void* d_ws, size_t ws_size, hipStream_t stream) {
    static int grid = 0;
    if (grid == 0) {
        if (n_in != 28 || out_size != (int)OUT_TOTAL || ws_size < WS_END) { fprintf(stderr, "kernel_launch: unexpected shapes (n_in %d, out %d, ws %zu); nothing launched\n", n_in, out_size, ws_size); grid = -1; return; }
        int dev = 0, cus = 0, per_cu = 0;
        if (hipGetDevice(&dev) != hipSuccess || hipDeviceGetAttribute(&cus, hipDeviceAttributeMultiprocessorCount, dev) != hipSuccess) { grid = -1; return; }
        if (hipFuncSetAttribute((const void*)mk_fwd, hipFuncAttributeMaxDynamicSharedMemorySize, LDS_BYTES) != hipSuccess) { fprintf(stderr, "kernel_launch: hipFuncSetAttribute failed\n"); grid = -1; return; }
        if (hipOccupancyMaxActiveBlocksPerMultiprocessor(&per_cu, (const void*)mk_fwd, NWAVES * 64, LDS_BYTES) != hipSuccess || per_cu < 1) { fprintf(stderr, "kernel_launch: occupancy query reports %d blocks per CU\n", per_cu); }
        (void)hipGetLastError();
        grid = cus;
    }
    if (grid < 0) return;
    if (hipMemsetAsync((char*)d_ws + WS_CTL, 0, CTL_ZERO_BYTES, stream) != hipSuccess) { fprintf(stderr, "kernel_launch: memset failed\n"); return; }
    Params p{};
    for (int i = 0; i < 28; ++i) p.in[i] = (const float*)d_in[i];
    p.out = (float*)d_out; p.ws = (unsigned char*)d_ws;
#if MK_PER_PHASE
    for (int ph = 0; ph < N_PHASES; ++ph) { p.ph_lo = ph; p.ph_hi = ph + 1; hipLaunchKernelGGL(mk_fwd, dim3(grid), dim3(NWAVES * 64), LDS_BYTES, stream, p); }
#else
    p.ph_lo = 0; p.ph_hi = N_PHASES;
    hipLaunchKernelGGL(mk_fwd, dim3(grid), dim3(NWAVES * 64), LDS_BYTES, stream, p);
#endif
    const hipError_t le = hipPeekAtLastError();
    if (le != hipSuccess) fprintf(stderr, "kernel_launch: launch failed: %s\n", hipGetErrorName(le));
}
```

```cpp
#include <hip/hip_runtime.h>
#include <cstdio>
#include <cstdint>
namespace pg8 {
#define PG8_LAS __attribute__((address_space(3)))
typedef unsigned short bf16_t;
typedef short bf16x8 __attribute__((ext_vector_type(8)));
typedef float f32x4 __attribute__((ext_vector_type(4)));
typedef unsigned u32x4 __attribute__((ext_vector_type(4)));
constexpr int BM = 256, BK = 64, HALF = 128, HTB = HALF * BK * 2  , STAGE_BYTES = 8 * HTB, NXCD = 8, WGM = 8;

__host__ __device__ __forceinline__ int lds_byte(int r, int c) { const int st = (r >> 4) * 2 + (c >> 5), rr = r & 15, cc = c & 31, ob = rr * 64 + cc * 2; return st * 1024 + (ob ^ (((ob >> 9) & 1) << 5)); }
__host__ __device__ __forceinline__ void stage_rc(int b, int& R, int& C) { const int st = b / 1024, sb = b % 1024, swz = sb ^ (((sb >> 9) & 1) << 5); R = (st >> 1) * 16 + swz / 64; C = (st & 1) * 32 + (swz % 64) / 2; }
__host__ __device__ __forceinline__ int perm32(int rho) { const int n = rho >> 4, i = rho & 15; return 8 * (i >> 2) + 4 * n + (i & 3); }

struct Unit { int pm, pn, k0, nkt, role, slab, src2; };
struct Gemm { const bf16_t* A; const bf16_t* Bt; int M, N, K; };

struct StaticOrder {
    int nM, nN, nwg, G, c;
    __host__ __device__ void init(int M, int N, int G_, int c_) { nM = M / BM; nN = N / BM; nwg = nM * nN; G = G_; c = c_; }
    static constexpr bool SPLITK = false, HANDOFF = false;
    __host__ __device__ __forceinline__ bool next(int i, Unit& u) const {
        const long L = (long)i * G + c; if (L >= nwg) return false;
        map((int)L, u); return true;
    }
    __host__ __device__ __forceinline__ void map(int L, Unit& u) const {
        int wgid = L; { const int q = nwg / NXCD, r = nwg % NXCD, xcd = wgid % NXCD, off = wgid / NXCD; wgid = (xcd < r ? xcd * (q + 1) : r * (q + 1) + (xcd - r) * q) + off; }
        map2(wgid, u);
    }
    __host__ __device__ __forceinline__ void map2(int wgid, Unit& u) const {
        const int nig = WGM * nN, gid = wgid / nig, fm = gid * WGM, gsz = (nM - fm) < WGM ? (nM - fm) : WGM;
        u.pm = fm + ((wgid % nig) % gsz); u.pn = (wgid % nig) / gsz;
    }
    __device__ __forceinline__ void a_ready(const Unit&) const {}
    __device__ __forceinline__ void done(const Unit&) const {}
};

__device__ __forceinline__ unsigned cvt_pk_bf16(float lo, float hi) { unsigned r; asm volatile("v_cvt_pk_bf16_f32 %0, %1, %2" : "=v"(r) : "v"(lo), "v"(hi)); return r; }
template <class Epi, class Sched, bool ALIGN_EPI = false, bool SP2 = false>
__device__ __forceinline__ void gemm_phase(PG8_LAS unsigned char* lds, const Gemm g, const Sched& S, const Epi& E, int tid_) {
    const int tid = tid_, wid = __builtin_amdgcn_readfirstlane(tid >> 6), lane = tid & 63, wr = wid >> 2, wc = wid & 3, fr = lane & 15, fq = lane >> 4;
    int K_ = g.K; asm volatile("" : "+s"(K_));
    const int K = K_; int nt = K / BK;
    unsigned voffA[2], voffB[2];
#pragma unroll
    for (int i = 0; i < 2; ++i) { int R, C; stage_rc(tid * 16 + i * 8192, R, C); const int Rb = Epi::PERM ? ((R & ~31) + perm32(R & 31)) : R;
        voffA[i] = (unsigned)(R * K + C) * 2u; voffB[i] = (unsigned)(Rb * K + C) * 2u; }
    const size_t kstep = (size_t)(BK * 2);
    const size_t hstep = (size_t)HALF * K * 2;
    const size_t tstep = 2 * hstep;
    const unsigned ldsw = (unsigned)wid * 1024u;
    const int aoff = lds_byte(wr * 64 + fr, fq * 8), boff = lds_byte(wc * 32 + fr, fq * 8);
#define PG8_SA(b, h) (((b) * 2 + (h)) * HTB)
#define PG8_SB(b, h) ((4 + (b) * 2 + (h)) * HTB)
#define PG8_STAGE(bufoff, gbase, voff) do { _Pragma("unroll") for (int _i = 0; _i < 2; ++_i) \
        __builtin_amdgcn_global_load_lds((const unsigned*)((const char*)(gbase) + (voff)[_i]), (PG8_LAS unsigned*)(lds + (bufoff) + ldsw + _i * 8192), 16, 0, 0); } while (0)
#define PG8_LDA(dst, b, h) do { _Pragma("unroll") for (int m = 0; m < 4; ++m) _Pragma("unroll") for (int k = 0; k < 2; ++k) dst[m][k] = *(const PG8_LAS bf16x8*)(lds + PG8_SA(b, h) + aoff + m * 2048 + k * 1024); } while (0)
#define PG8_LDB(dst, b, h) do { _Pragma("unroll") for (int n = 0; n < 2; ++n) _Pragma("unroll") for (int k = 0; k < 2; ++k) dst[n][k] = *(const PG8_LAS bf16x8*)(lds + PG8_SB(b, h) + boff + n * 2048 + k * 1024); } while (0)
#define PG8_MMA(ai, bj, At, Bt) do { __builtin_amdgcn_s_setprio(1); _Pragma("unroll") for (int m = 0; m < 4; ++m) _Pragma("unroll") for (int n = 0; n < 2; ++n) _Pragma("unroll") for (int k = 0; k < 2; ++k) \
        acc[ai][bj][m][n] = __builtin_amdgcn_mfma_f32_16x16x32_bf16(Bt[n][k], At[m][k], acc[ai][bj][m][n], 0, 0, 0); __builtin_amdgcn_s_setprio(0); } while (0)
#define PG8_WAIT_V(n) asm volatile("s_waitcnt vmcnt(" #n ")" ::: "memory")
#define PG8_WAIT_L(n) asm volatile("s_waitcnt lgkmcnt(" #n ")" ::: "memory")
#define PG8_BAR __builtin_amdgcn_s_barrier()
#define PG8_SCHED __builtin_amdgcn_sched_barrier(0)
    Unit cur, nxt; int ui = 0;
    if (!S.next(0, cur)) return;
    f32x4 acc[2][2][4][2];
#pragma unroll
    for (int a = 0; a < 2; ++a)
#pragma unroll
        for (int b = 0; b < 2; ++b)
#pragma unroll
            for (int m = 0; m < 4; ++m)
#pragma unroll
                for (int n = 0; n < 2; ++n) acc[a][b][m][n] = (f32x4){0.f, 0.f, 0.f, 0.f};
    bf16x8 At[4][2], B0[2][2], B1[2][2];
    const char* cA = (const char*)g.A + (size_t)cur.pm * tstep; const char* cB = (const char*)g.Bt + (size_t)cur.pn * tstep;
    if constexpr (Sched::SPLITK) { nt = cur.nkt; cA += (size_t)cur.k0 * kstep; cB += (size_t)cur.k0 * kstep; }
    S.a_ready(cur);
    if constexpr (SP2) {
        PG8_STAGE(PG8_SB(0, 0), cB, voffB); PG8_STAGE(PG8_SB(0, 1), cB + hstep, voffB); PG8_STAGE(PG8_SA(0, 0), cA, voffA); PG8_STAGE(PG8_SA(0, 1), cA + hstep, voffA);
        if (wr == 1) PG8_BAR;
        PG8_WAIT_V(2); PG8_BAR;
        PG8_STAGE(PG8_SB(1, 0), cB + kstep, voffB); PG8_STAGE(PG8_SA(1, 0), cA + kstep, voffA); PG8_STAGE(PG8_SB(1, 1), cB + hstep + kstep, voffB);
        PG8_WAIT_V(6); PG8_BAR;
    } else {
        PG8_STAGE(PG8_SB(0, 0), cB, voffB); PG8_STAGE(PG8_SA(0, 0), cA, voffA); PG8_STAGE(PG8_SB(0, 1), cB + hstep, voffB); PG8_STAGE(PG8_SA(0, 1), cA + hstep, voffA);
        if (wr == 1) PG8_BAR;
        PG8_WAIT_V(4); PG8_BAR;
        PG8_STAGE(PG8_SB(1, 0), cB + kstep, voffB); PG8_STAGE(PG8_SA(1, 0), cA + kstep, voffA); PG8_STAGE(PG8_SB(1, 1), cB + hstep + kstep, voffB);
        PG8_WAIT_V(6); PG8_BAR;
    }
    for (;;) {
        const bool has_next = S.next(ui + 1, nxt);
        const char* nA = has_next ? (const char*)g.A + (size_t)nxt.pm * tstep : cA; const char* nB = has_next ? (const char*)g.Bt + (size_t)nxt.pn * tstep : cB;
        if constexpr (Sched::SPLITK) { if (has_next) { nA += (size_t)nxt.k0 * kstep; nB += (size_t)nxt.k0 * kstep; } }
        for (int t = 0; t < nt; t += 2) {
            const bool last = (t == nt - 2);
            const char* a1 = cA + (size_t)(t + 1) * kstep;
            const char* a2 = last ? nA : cA + (size_t)(t + 2) * kstep; const char* b2 = last ? nB : cB + (size_t)(t + 2) * kstep;
            const char* a3 = a2 + kstep; const char* b3 = b2 + kstep;
            if (last && has_next) S.a_ready(nxt);
            if constexpr (SP2) {
            PG8_LDB(B0, 0, 0); PG8_LDB(B1, 0, 1); PG8_SCHED; PG8_LDA(At, 0, 0); PG8_STAGE(PG8_SA(1, 1), a1 + hstep, voffA);
            PG8_WAIT_V(8); PG8_WAIT_L(0); PG8_BAR; PG8_MMA(0, 0, At, B0); PG8_MMA(0, 1, At, B1); PG8_BAR; PG8_SCHED;
            PG8_LDA(At, 0, 1); PG8_STAGE(PG8_SB(0, 0), b2, voffB); PG8_STAGE(PG8_SB(0, 1), b2 + hstep, voffB); PG8_STAGE(PG8_SA(0, 0), a2, voffA);
            PG8_WAIT_V(8); PG8_WAIT_L(0); PG8_BAR; PG8_MMA(1, 0, At, B0); PG8_MMA(1, 1, At, B1); PG8_BAR; PG8_SCHED;
            PG8_LDB(B0, 1, 0); PG8_LDB(B1, 1, 1); PG8_SCHED; PG8_LDA(At, 1, 0); PG8_STAGE(PG8_SA(0, 1), a2 + hstep, voffA);
            PG8_WAIT_V(8); PG8_WAIT_L(0); PG8_BAR; PG8_MMA(0, 0, At, B0); PG8_MMA(0, 1, At, B1); PG8_BAR; PG8_SCHED;
            PG8_LDA(At, 1, 1); PG8_STAGE(PG8_SB(1, 0), b3, voffB); PG8_STAGE(PG8_SB(1, 1), b3 + hstep, voffB); PG8_STAGE(PG8_SA(1, 0), a3, voffA);
            PG8_WAIT_V(8); PG8_WAIT_L(0); PG8_BAR; PG8_MMA(1, 0, At, B0); PG8_MMA(1, 1, At, B1); PG8_BAR; PG8_SCHED;
            } else {
            PG8_LDB(B0, 0, 0); PG8_SCHED; PG8_LDA(At, 0, 0); PG8_STAGE(PG8_SA(1, 1), a1 + hstep, voffA);
            PG8_WAIT_L(8); PG8_BAR; PG8_WAIT_L(0); PG8_MMA(0, 0, At, B0); PG8_BAR; PG8_SCHED;
            PG8_LDB(B1, 0, 1); PG8_STAGE(PG8_SB(0, 0), b2, voffB);
            PG8_BAR; PG8_WAIT_L(0); PG8_MMA(0, 1, At, B1); PG8_BAR;
            PG8_LDA(At, 0, 1); PG8_STAGE(PG8_SA(0, 0), a2, voffA);
            PG8_BAR; PG8_WAIT_L(0); PG8_MMA(1, 0, At, B0); PG8_BAR; PG8_SCHED;
            PG8_STAGE(PG8_SB(0, 1), b2 + hstep, voffB);
            PG8_WAIT_V(6); PG8_BAR; PG8_MMA(1, 1, At, B1); PG8_BAR;
            PG8_LDB(B0, 1, 0); PG8_SCHED; PG8_LDA(At, 1, 0); PG8_STAGE(PG8_SA(0, 1), a2 + hstep, voffA);
            PG8_WAIT_L(8); PG8_BAR; PG8_WAIT_L(0); PG8_MMA(0, 0, At, B0); PG8_BAR; PG8_SCHED;
            PG8_LDB(B1, 1, 1); PG8_STAGE(PG8_SB(1, 0), b3, voffB);
            PG8_BAR; PG8_WAIT_L(0); PG8_MMA(0, 1, At, B1); PG8_BAR;
            PG8_LDA(At, 1, 1); PG8_STAGE(PG8_SA(1, 0), a3, voffA);
            PG8_BAR; PG8_WAIT_L(0); PG8_MMA(1, 0, At, B0); PG8_BAR; PG8_SCHED;
            PG8_STAGE(PG8_SB(1, 1), b3 + hstep, voffB);
            PG8_WAIT_V(6); PG8_BAR; PG8_MMA(1, 1, At, B1); PG8_BAR;
            }
        }
        if constexpr (ALIGN_EPI) { if (wr == 0) PG8_BAR; }
        if constexpr (Sched::SPLITK) {
            int ln; asm volatile("v_mbcnt_lo_u32_b32 %0, -1, 0\n\tv_mbcnt_hi_u32_b32 %0, -1, %0" : "=v"(ln));
            if constexpr (!Sched::HANDOFF) { E(acc, cur, wr, wc, ln & 15, ln >> 4); S.done(cur); } else {
            const __amdgpu_buffer_rsrc_t rs = __builtin_amdgcn_make_buffer_rsrc((void*)S.slab, 0, 256 * 131072, 0x00020000);
            if (cur.role == 2) {
                const unsigned so = ((unsigned)cur.slab * 32768u + (unsigned)wid * 4096u + (unsigned)ln * 4u) * 4u;
#pragma unroll
                for (int a = 0; a < 2; ++a)
#pragma unroll
                    for (int b = 0; b < 2; ++b)
#pragma unroll
                        for (int m = 0; m < 4; ++m) {
                            const f32x4 p0 = acc[a][b][m][0], p1 = acc[a][b][m][1];
                            const u32x4 pk = {cvt_pk_bf16(p0[0], p0[1]), cvt_pk_bf16(p0[2], p0[3]), cvt_pk_bf16(p1[0], p1[1]), cvt_pk_bf16(p1[2], p1[3])};
                            __builtin_amdgcn_raw_buffer_store_b128(pk, rs, so + (unsigned)(((a * 2 + b) * 4 + m) * 1024), 0, 16);
                        }
                asm volatile("s_waitcnt vmcnt(0)" ::: "memory");
                unsigned ep = S.epoch; asm volatile("" : "+s"(ep));
                if (ln == 0) __hip_atomic_store(S.flags + cur.slab * 8 + wid, ep, __ATOMIC_RELAXED, __HIP_MEMORY_SCOPE_AGENT);
            } else {
                if (cur.role == 1) {
                    for (int src = cur.slab, pass = 0; pass < 2 && src >= 0; src = cur.src2, ++pass) {
                        const unsigned* fl = S.flags + src * 8 + wid;
                        for (int sp = 0; sp < (1 << 20) && __hip_atomic_load(fl, __ATOMIC_RELAXED, __HIP_MEMORY_SCOPE_AGENT) != S.epoch; ++sp) __builtin_amdgcn_s_sleep(1);
                        const unsigned so = ((unsigned)src * 32768u + (unsigned)wid * 4096u + (unsigned)ln * 4u) * 4u;
                        u32x4 pv[2][2][4];
#pragma unroll
                        for (int a = 0; a < 2; ++a)
#pragma unroll
                            for (int b = 0; b < 2; ++b)
#pragma unroll
                                for (int m = 0; m < 4; ++m) pv[a][b][m] = __builtin_amdgcn_raw_buffer_load_b128(rs, so + (unsigned)(((a * 2 + b) * 4 + m) * 1024), 0, 16);
#pragma unroll
                        for (int a = 0; a < 2; ++a)
#pragma unroll
                            for (int b = 0; b < 2; ++b)
#pragma unroll
                                for (int m = 0; m < 4; ++m) { const u32x4 w = pv[a][b][m];
                                    acc[a][b][m][0] += (f32x4){__builtin_bit_cast(float, w[0] << 16), __builtin_bit_cast(float, w[0] & 0xffff0000u), __builtin_bit_cast(float, w[1] << 16), __builtin_bit_cast(float, w[1] & 0xffff0000u)};
                                    acc[a][b][m][1] += (f32x4){__builtin_bit_cast(float, w[2] << 16), __builtin_bit_cast(float, w[2] & 0xffff0000u), __builtin_bit_cast(float, w[3] << 16), __builtin_bit_cast(float, w[3] & 0xffff0000u)}; }
                    }
                }
                E(acc, cur, wr, wc, ln & 15, ln >> 4); S.done(cur);
            }
            }
        } else
        if constexpr (!Epi::AFTER_DRAIN) { int ln_; asm volatile("v_mbcnt_lo_u32_b32 %0, -1, 0\n\tv_mbcnt_hi_u32_b32 %0, -1, %0" : "=v"(ln_)); E(acc, cur, wr, wc, ln_ & 15, ln_ >> 4); S.done(cur); }
        if (!has_next) break;
#pragma unroll
        for (int a = 0; a < 2; ++a)
#pragma unroll
            for (int b = 0; b < 2; ++b)
#pragma unroll
                for (int m = 0; m < 4; ++m)
#pragma unroll
                    for (int n = 0; n < 2; ++n) acc[a][b][m][n] = (f32x4){0.f, 0.f, 0.f, 0.f};
        cur = nxt; cA = nA; cB = nB; ++ui;
        if constexpr (Sched::SPLITK) nt = cur.nkt;
        if constexpr (ALIGN_EPI) { if (wr == 1) PG8_BAR; }
    }
    PG8_WAIT_V(0);
    if constexpr (!ALIGN_EPI) { if (wr == 0) PG8_BAR; }
    PG8_BAR;
    if constexpr (Epi::AFTER_DRAIN) { E.fused(acc, cur, wr, wc, fr, fq, lds, wid, lane); S.done(cur); }
#undef PG8_SA
#undef PG8_SB
#undef PG8_STAGE
#undef PG8_LDA
#undef PG8_LDB
#undef PG8_MMA
#undef PG8_WAIT_V
#undef PG8_WAIT_L
#undef PG8_BAR
#undef PG8_SCHED
}
}
#define GAS __attribute__((address_space(1)))
#define LAS __attribute__((address_space(3)))
typedef unsigned short bf16;
typedef unsigned v4u __attribute__((ext_vector_type(4)));
typedef float f32x4 __attribute__((ext_vector_type(4)));
typedef short bf16x8 __attribute__((ext_vector_type(8)));
typedef GAS unsigned gu32;
typedef GAS unsigned long long gu64;
#define RLX_AGENT __ATOMIC_RELAXED, __HIP_MEMORY_SCOPE_AGENT
#define LDS_WAIT() asm volatile("s_waitcnt lgkmcnt(0)" ::: "memory")
#define VM_WAIT() asm volatile("s_waitcnt vmcnt(0)" ::: "memory")
__device__ __forceinline__ unsigned long long rt() { return __builtin_amdgcn_s_memrealtime(); }
__device__ __forceinline__ unsigned f2bf(float f) { unsigned u = __builtin_bit_cast(unsigned, f); return (u + 0x7fffu + ((u >> 16) & 1u)) >> 16; }
__device__ __forceinline__ unsigned pk2(float lo, float hi) { return f2bf(lo) | (f2bf(hi) << 16); }

#define XB_TMO      128
#define XB_XCNT(j)  (256  + 64 * (j))
#define XB_XSUB(j)  (1280 + 64 * (j))
#define XB_XGEN(j)  (2304 + 64 * (j))
#define XB_TOP      3328
#define XB_TOPGEN   3392
#define XCD_BAR_WORDS 3456
#define XB_SPIN_CAP (1u << 18)

__device__ __forceinline__ unsigned xb_ld(unsigned* p)              { return __hip_atomic_load(p, __ATOMIC_RELAXED, __HIP_MEMORY_SCOPE_AGENT); }
__device__ __forceinline__ unsigned xb_add(unsigned* p, unsigned v) { return __hip_atomic_fetch_add(p, v, __ATOMIC_RELAXED, __HIP_MEMORY_SCOPE_AGENT); }
__device__ __forceinline__ unsigned xb_xcc_id() { return (unsigned)__builtin_amdgcn_s_getreg((3 << 11) | 20) & 0xFu; }
#define XB_SPIN(cond, bar) do { unsigned _sp = 0; while (cond) { __builtin_amdgcn_s_sleep(1); \
    if ((++_sp & 255u) == 0u) { if (xb_ld(&(bar)[XB_TMO])) break; if (_sp > XB_SPIN_CAP) { atomicAdd(&(bar)[XB_TMO], 1u); break; } } } } while (0)

struct XcdBarrier {
    unsigned* bar; unsigned x;
    volatile LAS unsigned* st;
};

__device__ __forceinline__ XcdBarrier xcd_barrier_post(unsigned* bar, volatile LAS unsigned* st, int tid) {
    XcdBarrier b; b.bar = bar; b.x = xb_xcc_id(); b.st = st;
    if (tid == 0) (void)xb_add(&bar[XB_XCNT(b.x)], 1u);
    return b;
}
__device__ __forceinline__ void xcd_barrier_complete(unsigned* bar, unsigned x, unsigned& nloc, unsigned& nx) {
    const unsigned G = gridDim.x * gridDim.y * gridDim.z;
    unsigned sum, cnt, mine, sp = 0u;
    for (;;) {
        sum = 0u; cnt = 0u; mine = 0u;
#pragma unroll
        for (unsigned j = 0; j < 16; ++j) { const unsigned c = xb_ld(&bar[XB_XCNT(j)]); sum += c; cnt += (c > 0u) ? 1u : 0u; mine = (j == x) ? c : mine; }
        if (sum == G) break;
        __builtin_amdgcn_s_sleep(1);
        if ((++sp & 255u) == 0u) { if (xb_ld(&bar[XB_TMO])) break; if (sp > XB_SPIN_CAP) { atomicAdd(&bar[XB_TMO], 1u); break; } }
    }
    nloc = mine > 0u ? mine : 1u; nx = cnt > 0u ? cnt : 1u;
}

__device__ __forceinline__ void xcd_barrier(const XcdBarrier& b, int tid) {
    asm volatile("s_waitcnt vmcnt(0)" ::: "memory");
    __syncthreads();
    if (tid == 0) {
        unsigned* bar = b.bar;
        __builtin_amdgcn_s_waitcnt(0);
        unsigned nloc = b.st[0], nx = b.st[1];
        if (nloc == 0u) { xcd_barrier_complete(bar, b.x, nloc, nx); b.st[0] = nloc; b.st[1] = nx; }
        const unsigned old = xb_add(&bar[XB_XSUB(b.x)], 1u);
        const unsigned gen = old / nloc;
        if (old + 1u == (gen + 1u) * nloc) {
            __builtin_amdgcn_fence(__ATOMIC_RELEASE, "agent");
            asm volatile("s_waitcnt vmcnt(0)" ::: "memory");
            const unsigned og = xb_add(&bar[XB_TOP], 1u);
            const unsigned tg = og / nx;
            if (og + 1u == (tg + 1u) * nx) xb_add(&bar[XB_TOPGEN], 1u);
            else XB_SPIN(xb_ld(&bar[XB_TOPGEN]) == tg, bar);
            __builtin_amdgcn_fence(__ATOMIC_ACQUIRE, "agent");
            xb_add(&bar[XB_XGEN(b.x)], 1u);
            asm volatile("s_waitcnt vmcnt(0)" ::: "memory");
        } else {
            XB_SPIN(xb_ld(&bar[XB_XGEN(b.x)]) == gen, bar);
            __builtin_amdgcn_fence(__ATOMIC_ACQUIRE, "agent");
            asm volatile("s_waitcnt vmcnt(0)" ::: "memory");
        }
    }
    __syncthreads();
}

constexpr int NWAVES = 8;
constexpr int M_TOK = 10240, M_CTX = 8192, M_KV = 10752, DM = 1024;
constexpr int N_IN = 2560, N_Q = 768, N_KV = 1024, N_FI = 5632, D_FFN = 2816;
constexpr float EPSF = 1e-6f;
constexpr float QSCALE = 0.10206207261596575f * 1.4426950408889634f;

#ifndef MK_PER_PHASE
#define MK_PER_PHASE 0
#endif
#ifndef PHASE_MASK
#define PHASE_MASK 0x1ff
#endif
#define PH_EN(k) (((PHASE_MASK) >> (k)) & 1)
#ifndef REP_MASK
#define REP_MASK 0
#endif
#define REPS(k) (1 + (((REP_MASK) >> (k)) & 1))
constexpr int N_PHASES = 17;

constexpr size_t OUT_Y = 0, OUT_CKV = 10485760, OUT_KROPE = 12582912, OUT_SF = 13107200, OUT_SB = 15204352, OUT_TOTAL = 17301504;

constexpr size_t MiB = 1u << 20;
constexpr size_t WS_CTL = 0, CTL_ZERO_BYTES = 1 * MiB;
constexpr int CW_BAR = 4096;
constexpr int CW_SPLIT = 8192;
constexpr int CW_SS = 16384;
constexpr size_t WS_MOD = 1 * MiB;
constexpr size_t WS_TAB = WS_MOD + 256 * 1024;
constexpr size_t WS_BIAS = WS_MOD + 512 * 1024;
constexpr int BIAS_LD = 8192;
constexpr size_t WS_W = 2 * MiB;
constexpr size_t W_IN_OFF = 0, W_QB_OFF = (size_t)N_IN * 1024 * 2, W_KVB_OFF = W_QB_OFF + (size_t)N_Q * 256 * 2, W_O_OFF = W_KVB_OFF + (size_t)N_KV * 256 * 2,
                 W_FI_OFF = W_O_OFF + (size_t)1024 * 1024 * 2, W_FO_OFF = W_FI_OFF + (size_t)N_FI * 1024 * 2, LAYER_W = W_FO_OFF + (size_t)1024 * D_FFN * 2;
constexpr size_t WS_H = WS_W + 2 * LAYER_W;
constexpr size_t WS_RQ = WS_H + (size_t)M_TOK * 1024 * 2;
constexpr size_t WS_RK = WS_RQ + (size_t)M_TOK * 512 * 2;
constexpr size_t WS_RKT = WS_RK + (size_t)M_TOK * 512 * 2;
constexpr size_t WS_RVT = WS_RKT + (size_t)512 * M_CTX * 2;
constexpr size_t WS_RG = WS_RVT + (size_t)512 * M_TOK * 2;
constexpr size_t WS_QA = WS_RG + (size_t)M_TOK * 512 * 2;
constexpr size_t WS_KVA = WS_QA + (size_t)M_TOK * 256 * 2;
constexpr size_t WS_KR = WS_KVA + (size_t)M_KV * 256 * 2;
constexpr size_t WS_Q = WS_KR + (size_t)M_KV * 32 * 2;
constexpr size_t WS_KN = WS_Q + (size_t)M_TOK * 768 * 2;
constexpr size_t WS_VT = WS_KN + (size_t)M_KV * 512 * 2;
constexpr size_t WS_MIX = WS_VT + (size_t)512 * M_KV * 2;
constexpr size_t WS_ACT = WS_MIX + (size_t)M_TOK * 1024 * 2;
constexpr size_t WS_END = WS_ACT + (size_t)M_TOK * D_FFN * 2;
static_assert(WS_END <= 256 * MiB, "d_ws map exceeds 256 MiB");
static_assert((CW_SS + 7 * M_TOK) * 4 <= (int)CTL_ZERO_BYTES && (CW_BAR + XCD_BAR_WORDS) <= CW_SS, "CTL words");
static_assert(W_QB_OFF % 16 == 0 && W_KVB_OFF % 16 == 0 && W_O_OFF % 16 == 0 && W_FI_OFF % 16 == 0 && W_FO_OFF % 16 == 0 && LAYER_W % 16 == 0, "weight alignment");

constexpr int RING_OFF = 0, RING_BYTES = 131072;
constexpr int LDSCTL_OFF = RING_BYTES, MISC_OFF = LDSCTL_OFF + 320;
constexpr int LDS_BYTES = 147456;

typedef float f32x16 __attribute__((ext_vector_type(16)));
typedef float f32x2_t __attribute__((ext_vector_type(2)));
typedef __bf16 bf16x2_t __attribute__((ext_vector_type(2)));
typedef unsigned u32x2 __attribute__((ext_vector_type(2)));
__device__ __forceinline__ unsigned cvtpk(float lo, float hi) { f32x2_t v = {lo, hi}; bf16x2_t b = __builtin_convertvector(v, bf16x2_t); return __builtin_bit_cast(unsigned, b); }
#if defined(__HIP_DEVICE_COMPILE__)
#define ASSUME_GLOBAL(p) __builtin_assume(!__builtin_amdgcn_is_shared((const __attribute__((address_space(0))) void*)(p)) && !__builtin_amdgcn_is_private((const __attribute__((address_space(0))) void*)(p)))
#else
#define ASSUME_GLOBAL(p) ((void)0)
#endif
template <int K> __device__ __forceinline__ float shx(float v) { static_assert(K >= 1 && K <= 16, "shx"); return __builtin_bit_cast(float, __builtin_amdgcn_ds_swizzle(__builtin_bit_cast(int, v), (K << 10) | 0x1f)); }
__device__ __forceinline__ float sum32(float v) { const unsigned b = __builtin_bit_cast(unsigned, v); auto rr = __builtin_amdgcn_permlane32_swap(b, b, false, false); return __builtin_bit_cast(float, (unsigned)rr[0]) + __builtin_bit_cast(float, (unsigned)rr[1]); }
__device__ __forceinline__ float partner32(float v, bool upper_half) { const unsigned b = __builtin_bit_cast(unsigned, v); auto rr = __builtin_amdgcn_permlane32_swap(b, b, false, false); return __builtin_bit_cast(float, (unsigned)(upper_half ? rr[0] : rr[1])); }
__device__ __forceinline__ bf16 f2b(float x) { return (bf16)(cvtpk(x, 0.f) & 0xffffu); }
__device__ __forceinline__ float b2f(unsigned short b) { return __builtin_bit_cast(float, (unsigned)b << 16); }
__device__ __forceinline__ float siluf(float x) { return x * __builtin_amdgcn_rcpf(1.0f + __builtin_amdgcn_exp2f(-1.4426950408889634f * x)); }
__device__ __forceinline__ v4u pack8(const float (&v)[8]) { v4u w; w.x = cvtpk(v[0], v[1]); w.y = cvtpk(v[2], v[3]); w.z = cvtpk(v[4], v[5]); w.w = cvtpk(v[6], v[7]); return w; }
__device__ __forceinline__ void ld8(const pg8::f32x4 (&a)[2], float (&v)[8]) { v[0] = a[0][0]; v[1] = a[0][1]; v[2] = a[0][2]; v[3] = a[0][3]; v[4] = a[1][0]; v[5] = a[1][1]; v[6] = a[1][2]; v[7] = a[1][3]; }

struct Params {
    const float* in[28];
    float* out;
    unsigned char* ws;
    int ph_lo, ph_hi;
};


struct EpiG1 {
    static constexpr bool PERM = true, AFTER_DRAIN = false;
    unsigned char* ws_; const float* gin[3]; float* out_; int layer; int no_atomics; int rs_idx; LAS float* lss;
    __device__ __forceinline__ void operator()(const pg8::f32x4 (&acc)[2][2][4][2], const pg8::Unit& u, int wr, int wc, int fr, int fq) const {
        asm volatile("" : "+v"(fr), "+v"(fq));
        unsigned long long zo_ = 0ull; asm volatile("" : "+s"(zo_)); unsigned char* ws = ws_ + zo_;
        bf16* const RQ = (bf16*)(ws + WS_RQ); bf16* const RK = (bf16*)(ws + WS_RK); bf16* const RKT = (bf16*)(ws + WS_RKT); bf16* const RVT = (bf16*)(ws + WS_RVT); bf16* const RG = (bf16*)(ws + WS_RG);
        bf16* const QA = (bf16*)(ws + WS_QA); bf16* const KVA = (bf16*)(ws + WS_KVA); bf16* const KR = (bf16*)(ws + WS_KR);
        float* const ssq = (float*)(ws + WS_CTL + 4 * CW_SS) + (size_t)(layer * 2) * M_TOK; float* const sskv = ssq + M_TOK;
        const float2* const tab64 = (const float2*)(ws + WS_TAB); const float2* const tab32 = tab64 + 64 * 16;
        const float* const g_q_a = gin[0]; const float* const g_kv_a = gin[1]; const float* const g_kr = gin[2]; float* const out_krope = out_ + OUT_KROPE;
        const int pn = u.pn; const bool lat = u.pm >= 32;
        const bool rs_on = rs_idx >= 0;
        const float* const rsp = (const float*)(ws + WS_CTL + 4 * CW_SS) + (size_t)(rs_on ? rs_idx : 0) * M_TOK;
        float bz[2][8];
        { const int cond = (u.pm < 32) ? 0 : 1 + ((u.pm - 32) >> 2); const float* bp = (const float*)(ws + WS_BIAS) + (size_t)(layer * 3 + cond) * BIAS_LD + pn * 256 + wc * 32 + fq * 8;
#pragma unroll
          for (int bj = 0; bj < 2; ++bj) {
              pg8::f32x4 b0 = {0.f, 0.f, 0.f, 0.f}, b1 = b0; if (rs_on) { b0 = *(const pg8::f32x4*)(bp + bj * 128); b1 = *(const pg8::f32x4*)(bp + bj * 128 + 4); }
#pragma unroll
              for (int e = 0; e < 4; ++e) { bz[bj][e] = b0[e]; bz[bj][4 + e] = b1[e]; } } }
        float rsv[2][4];
#pragma unroll
        for (int ai = 0; ai < 2; ++ai)
#pragma unroll
            for (int m = 0; m < 4; ++m) rsv[ai][m] = rs_on ? rsp[u.pm * 256 + ai * 128 + wr * 64 + m * 16 + fr] : 0.f;
#define G1_LD(bj_, v_) do { ld8(acc[ai][bj_][m], v_); if (rs_on) { _Pragma("unroll") for (int e_ = 0; e_ < 8; ++e_) v_[e_] = v_[e_] * rs + bz[bj_][e_]; } } while (0)
        if (pn < 4) {
            bf16* dst = (pn < 2) ? RQ : RK; const int cb = (pn & 1) * 256;
#pragma unroll
            for (int ai = 0; ai < 2; ++ai)
#pragma unroll
                for (int m = 0; m < 4; ++m) {
                    asm volatile("" ::: "memory"); const int r = u.pm * 256 + ai * 128 + wr * 64 + m * 16 + fr; const float rs = rs_on ? 1.0f / sqrtf(rsv[ai][m] * (1.0f / 1024.0f) + EPSF) : 1.0f;
                    const int n = (r - M_CTX) & 1023, prow = n >> 6, pcol = n & 63;
#pragma unroll
                    for (int bj = 0; bj < 2; ++bj) {
                        float v[8]; G1_LD(bj, v);
                        const int c = cb + bj * 128 + wc * 32 + fq * 8;
                        if (lat) {
                            const int pos = (wc & 1) ? pcol : prow;
                            const float2* tb = tab64 + pos * 16 + (fq & 1) * 8;
#pragma unroll
                            for (int e = 0; e < 8; ++e) { const float pv = partner32(v[e], fq >= 2); const float2 cs = tb[e]; v[e] = (fq < 2) ? (v[e] * cs.x - pv * cs.y) : (pv * cs.y + v[e] * cs.x); }
                        }
                        *(v4u*)(dst + (size_t)r * 512 + c) = pack8(v);
                        if (pn >= 2 && !lat) {
#pragma unroll
                            for (int e = 0; e < 8; ++e) RKT[(size_t)(c + e) * M_CTX + r] = f2b(v[e]);
                        }
                    }
                }
        } else if (pn < 6) {
            const int cb = (pn - 4) * 256;
#pragma unroll
            for (int ai = 0; ai < 2; ++ai)
#pragma unroll
                for (int m = 0; m < 4; ++m) {
                    asm volatile("" ::: "memory"); const int r = u.pm * 256 + ai * 128 + wr * 64 + m * 16 + fr; const float rs = rs_on ? 1.0f / sqrtf(rsv[ai][m] * (1.0f / 1024.0f) + EPSF) : 1.0f;
#pragma unroll
                    for (int bj = 0; bj < 2; ++bj) {
                        float v[8]; G1_LD(bj, v);
                        const int c = cb + bj * 128 + wc * 32 + fq * 8;
#pragma unroll
                        for (int e = 0; e < 8; ++e) RVT[(size_t)(c + e) * M_TOK + r] = f2b(v[e]);
                    }
                }
        } else if (pn < 8) {
            const int cb = (pn - 6) * 256;
#pragma unroll
            for (int ai = 0; ai < 2; ++ai)
#pragma unroll
                for (int m = 0; m < 4; ++m) {
                    asm volatile("" ::: "memory"); const int r = u.pm * 256 + ai * 128 + wr * 64 + m * 16 + fr; const float rs = rs_on ? 1.0f / sqrtf(rsv[ai][m] * (1.0f / 1024.0f) + EPSF) : 1.0f;
#pragma unroll
                    for (int bj = 0; bj < 2; ++bj) {
                        float v[8]; G1_LD(bj, v);
#pragma unroll
                        for (int e = 0; e < 8; ++e) v[e] = siluf(v[e]);
                        *(v4u*)(RG + (size_t)r * 512 + cb + bj * 128 + wc * 32 + fq * 8) = pack8(v);
                    }
                }
        } else if (pn == 8) {
#pragma unroll
            for (int ai = 0; ai < 2; ++ai)
#pragma unroll
                for (int m = 0; m < 4; ++m) {
                    asm volatile("" ::: "memory"); const int r = u.pm * 256 + ai * 128 + wr * 64 + m * 16 + fr; const float rs = rs_on ? 1.0f / sqrtf(rsv[ai][m] * (1.0f / 1024.0f) + EPSF) : 1.0f;
                    float part = 0.f;
#pragma unroll
                    for (int bj = 0; bj < 2; ++bj) {
                        float v[8]; G1_LD(bj, v);
                        const int c = bj * 128 + wc * 32 + fq * 8;
                        const pg8::f32x4 g0 = *(const pg8::f32x4*)(g_q_a + c), g1 = *(const pg8::f32x4*)(g_q_a + c + 4);
#pragma unroll
                        for (int e = 0; e < 8; ++e) { part += v[e] * v[e]; v[e] *= (e < 4 ? g0[e & 3] : g1[e & 3]); }
                        *(v4u*)(QA + (size_t)r * 256 + c) = pack8(v);
                    }
                    part += shx<16>(part); part = sum32(part);
                    if (fq == 0) { if (lss) lss[wc * 256 + ai * 128 + wr * 64 + m * 16 + fr] = part; else if (!no_atomics) atomicAdd(ssq + r, part); }
                }
        } else {
#pragma unroll
            for (int ai = 0; ai < 2; ++ai)
#pragma unroll
                for (int m = 0; m < 4; ++m) {
                    asm volatile("" ::: "memory"); const int r = u.pm * 256 + ai * 128 + wr * 64 + m * 16 + fr; const float rs = rs_on ? 1.0f / sqrtf(rsv[ai][m] * (1.0f / 1024.0f) + EPSF) : 1.0f;
                    {
                        float v[8]; G1_LD(0, v);
                        const int c = wc * 32 + fq * 8;
                        const pg8::f32x4 g0 = *(const pg8::f32x4*)(g_kv_a + c), g1 = *(const pg8::f32x4*)(g_kv_a + c + 4);
                        float part = 0.f;
#pragma unroll
                        for (int e = 0; e < 8; ++e) { part += v[e] * v[e]; v[e] *= (e < 4 ? g0[e & 3] : g1[e & 3]); }
                        *(v4u*)(KVA + (size_t)r * 256 + c) = pack8(v);
                        part += shx<16>(part); part = sum32(part);
                        if (fq == 0) { if (lss) lss[wc * 256 + ai * 128 + wr * 64 + m * 16 + fr] = part; else if (!no_atomics) atomicAdd(sskv + r, part); }
                    }
                    if (wc == 0) {
                        float v[8]; G1_LD(1, v);
                        float ss = 0.f;
#pragma unroll
                        for (int e = 0; e < 8; ++e) ss += v[e] * v[e];
                        ss += shx<16>(ss); ss = sum32(ss);
                        const float rstd = 1.0f / sqrtf(ss * (1.0f / 32.0f) + EPSF);
                        const pg8::f32x4 g0 = *(const pg8::f32x4*)(g_kr + fq * 8), g1 = *(const pg8::f32x4*)(g_kr + fq * 8 + 4);
#pragma unroll
                        for (int e = 0; e < 8; ++e) v[e] *= rstd * (e < 4 ? g0[e & 3] : g1[e & 3]);
                        if (!lat) {
                            float* o = out_krope + ((size_t)((r >> 8) * 2 + layer) * 256 + (r & 255)) * 32 + fq * 8;
                            __builtin_nontemporal_store((pg8::f32x4){v[0], v[1], v[2], v[3]}, (pg8::f32x4*)o); __builtin_nontemporal_store((pg8::f32x4){v[4], v[5], v[6], v[7]}, (pg8::f32x4*)(o + 4));
                        } else {
                            const int n = (r - M_CTX) & 1023, pos = (fq < 2) ? (n >> 6) : (n & 63);
                            const float2* tb = tab32 + pos * 8;
#pragma unroll
                            for (int e = 0; e < 8; ++e) { const float pv = shx<16>(v[e]); const float2 cs = tb[e]; v[e] = ((fq & 1) == 0) ? (v[e] * cs.x - pv * cs.y) : (pv * cs.y + v[e] * cs.x); }
                        }
                        *(v4u*)(KR + (size_t)r * 32 + fq * 8) = pack8(v);
                    }
                }
        }
    }
#undef G1_LD
};

struct EpiQ {
    static constexpr bool PERM = true, AFTER_DRAIN = false;
    unsigned char* ws_; const float *g_qn, *g_qr; int layer;
    __device__ __forceinline__ void operator()(const pg8::f32x4 (&acc)[2][2][4][2], const pg8::Unit& u, int wr, int wc, int fr, int fq) const {
        asm volatile("" : "+v"(fr), "+v"(fq));
        unsigned long long zo_ = 0ull; asm volatile("" : "+s"(zo_)); unsigned char* ws = ws_ + zo_;
        bf16* const Q = (bf16*)(ws + WS_Q); const float* const ssq = (const float*)(ws + WS_CTL + 4 * CW_SS) + (size_t)(layer * 2) * M_TOK; const float2* const tab32 = (const float2*)(ws + WS_TAB) + 64 * 16;
        const int pn = u.pn; const bool lat = u.pm >= 32;
        float ssv[2][4];
#pragma unroll
        for (int ai = 0; ai < 2; ++ai)
#pragma unroll
            for (int m = 0; m < 4; ++m) ssv[ai][m] = ssq[u.pm * 256 + ai * 128 + wr * 64 + m * 16 + fr];
#pragma unroll
        for (int ai = 0; ai < 2; ++ai)
#pragma unroll
            for (int m = 0; m < 4; ++m) {
                asm volatile("" ::: "memory"); const int r = u.pm * 256 + ai * 128 + wr * 64 + m * 16 + fr;
                const float al = __builtin_amdgcn_rsqf(ssv[ai][m] * (1.0f / 256.0f) + EPSF), a2 = al * al;
                if (pn < 2) {
                    float ss = 0.f;
#pragma unroll
                    for (int bj = 0; bj < 2; ++bj)
#pragma unroll
                        for (int n = 0; n < 2; ++n) { const pg8::f32x4 x = acc[ai][bj][m][n]; ss += (x[0] * x[0] + x[1] * x[1]) + (x[2] * x[2] + x[3] * x[3]); }
                    ss += shx<16>(ss); ss = sum32(ss);
                    const float f = al * __builtin_amdgcn_rsqf(a2 * ss * (1.0f / 64.0f) + EPSF) * QSCALE;
                    const int h = 4 * pn + wc;
                    bf16* o = Q + (size_t)r * 768 + h * 96 + fq * 8;
#pragma unroll
                    for (int bj = 0; bj < 2; ++bj) {
                        float v[8]; ld8(acc[ai][bj][m], v);
                        const pg8::f32x4 ga = *(const pg8::f32x4*)(g_qn + 32 * bj + fq * 8), gb = *(const pg8::f32x4*)(g_qn + 32 * bj + fq * 8 + 4);
#pragma unroll
                        for (int e = 0; e < 8; ++e) v[e] *= f * (e < 4 ? ga[e & 3] : gb[e & 3]);
                        *(v4u*)(o + 32 * bj) = pack8(v);
                    }
                } else {
                    const int n = (r - M_CTX) & 1023, pos = (fq < 2) ? (n >> 6) : (n & 63);
                    const float2* tb = tab32 + pos * 8;
                    const pg8::f32x4 g0 = *(const pg8::f32x4*)(g_qr + fq * 8), g1 = *(const pg8::f32x4*)(g_qr + fq * 8 + 4);
#pragma unroll
                    for (int bj = 0; bj < 2; ++bj) {
                        float v[8]; ld8(acc[ai][bj][m], v);
                        float ss = 0.f;
#pragma unroll
                        for (int e = 0; e < 8; ++e) ss += v[e] * v[e];
                        ss += shx<16>(ss); ss = sum32(ss);
                        const float f = al * __builtin_amdgcn_rsqf(a2 * ss * (1.0f / 32.0f) + EPSF) * QSCALE;
#pragma unroll
                        for (int e = 0; e < 8; ++e) v[e] *= f * (e < 4 ? g0[e & 3] : g1[e & 3]);
                        if (lat) {
#pragma unroll
                            for (int e = 0; e < 8; ++e) { const float pv = shx<16>(v[e]); const float2 cs = tb[e]; v[e] = ((fq & 1) == 0) ? (v[e] * cs.x - pv * cs.y) : (pv * cs.y + v[e] * cs.x); }
                        }
                        const int h = 4 * bj + wc;
                        *(v4u*)(Q + (size_t)r * 768 + h * 96 + 64 + fq * 8) = pack8(v);
                    }
                }
            }
    }
};

struct EpiKV {
    static constexpr bool PERM = true, AFTER_DRAIN = false;
    unsigned char* ws_; const float* g_kn; int layer;
    __device__ __forceinline__ void operator()(const pg8::f32x4 (&acc)[2][2][4][2], const pg8::Unit& u, int wr, int wc, int fr, int fq) const {
        asm volatile("" : "+v"(fr), "+v"(fq));
        unsigned long long zo_ = 0ull; asm volatile("" : "+s"(zo_)); unsigned char* ws = ws_ + zo_;
        bf16* const KN = (bf16*)(ws + WS_KN); bf16* const VT = (bf16*)(ws + WS_VT); const float* const sskv = (const float*)(ws + WS_CTL + 4 * CW_SS) + (size_t)(layer * 2 + 1) * M_TOK;
        const int pn = u.pn;
        float ssv[2][4];
#pragma unroll
        for (int ai = 0; ai < 2; ++ai)
#pragma unroll
            for (int m = 0; m < 4; ++m) { const int r_ = u.pm * 256 + ai * 128 + wr * 64 + m * 16 + fr; ssv[ai][m] = sskv[r_ < M_TOK ? r_ : 0]; }
#pragma unroll
        for (int ai = 0; ai < 2; ++ai)
#pragma unroll
            for (int m = 0; m < 4; ++m) {
                asm volatile("" ::: "memory"); const int r = u.pm * 256 + ai * 128 + wr * 64 + m * 16 + fr;
                const float al = (r < M_TOK) ? __builtin_amdgcn_rsqf(ssv[ai][m] * (1.0f / 128.0f) + EPSF) : 1.0f, a2 = al * al;
                if (pn < 2) {
                    float ss = 0.f;
#pragma unroll
                    for (int bj = 0; bj < 2; ++bj)
#pragma unroll
                        for (int n = 0; n < 2; ++n) { const pg8::f32x4 x = acc[ai][bj][m][n]; ss += (x[0] * x[0] + x[1] * x[1]) + (x[2] * x[2] + x[3] * x[3]); }
                    ss += shx<16>(ss); ss = sum32(ss);
                    const float f = al * __builtin_amdgcn_rsqf(a2 * ss * (1.0f / 64.0f) + EPSF);
                    const int h = 4 * pn + wc;
                    bf16* o = KN + (size_t)r * 512 + h * 64 + fq * 8;
#pragma unroll
                    for (int bj = 0; bj < 2; ++bj) {
                        float v[8]; ld8(acc[ai][bj][m], v);
                        const pg8::f32x4 ga = *(const pg8::f32x4*)(g_kn + 32 * bj + fq * 8), gb = *(const pg8::f32x4*)(g_kn + 32 * bj + fq * 8 + 4);
#pragma unroll
                        for (int e = 0; e < 8; ++e) v[e] *= f * (e < 4 ? ga[e & 3] : gb[e & 3]);
                        *(v4u*)(o + 32 * bj) = pack8(v);
                    }
                } else {
                    const int h = 4 * (pn - 2) + wc;
#pragma unroll
                    for (int bj = 0; bj < 2; ++bj) {
                        float v[8]; ld8(acc[ai][bj][m], v);
#pragma unroll
                        for (int e = 0; e < 8; ++e) VT[(size_t)(h * 64 + bj * 32 + fq * 8 + e) * M_KV + r] = f2b(v[e] * al);
                    }
                }
            }
    }
};

template <bool SRC16, bool DST16>
struct EpiResT {
    static constexpr bool PERM = false, AFTER_DRAIN = false;
    const float *xs0, *xs1;
    float* out; const float* gate;
    bf16* H; const float* nn_g; const float* nn_sc; float* rowss; int final_out;
    bf16* xb_dst; const bf16* xb_src;
    __device__ __forceinline__ void operator()(const pg8::f32x4 (&acc_)[2][2][4][2], const pg8::Unit& u, int wr, int wc, int fr, int fq) const {
        asm volatile("" : "+v"(fr), "+v"(fq));
        pg8::f32x4 (&acc)[2][2][4][2] = const_cast<pg8::f32x4 (&)[2][2][4][2]>(acc_);
        const int cond = (u.pm < 32) ? 0 : 1 + ((u.pm - 32) >> 2);
        const float* gp = gate + cond * 6144;
        const int col0 = u.pn * 256 + wc * 32 + 4 * fq;
        const bool nn = nn_g != nullptr;
        pg8::f32x4 gv[2][2], gg[2][2]; float ssv[2][4];
#pragma unroll
        for (int bj = 0; bj < 2; ++bj)
#pragma unroll
            for (int n = 0; n < 2; ++n) { const int c = col0 + bj * 128 + n * 16; gv[bj][n] = *(const pg8::f32x4*)(gp + c);
                if (nn) { const pg8::f32x4 g0 = *(const pg8::f32x4*)(nn_g + c), s0 = *(const pg8::f32x4*)(nn_sc + cond * 6144 + c); gg[bj][n] = g0 * (s0 + 1.0f); } else gg[bj][n] = (pg8::f32x4){0.f, 0.f, 0.f, 0.f}; }
#pragma unroll
        for (int ai = 0; ai < 2; ++ai)
#pragma unroll
            for (int bj = 0; bj < 2; ++bj)
#pragma unroll
                for (int m = 0; m < 4; ++m)
#pragma unroll
                    for (int n = 0; n < 2; ++n) acc[ai][bj][m][n] *= gv[bj][n];
        asm volatile("" ::: "memory");
        const int r0 = u.pm * 256 + wr * 64 + fr;
        const float* src0 = (r0 < M_CTX) ? xs0 + (size_t)r0 * 1024 : xs1 + (size_t)(r0 - M_CTX) * 1024;
        pg8::f32x4 x[2][2][2];
#define RES_LOAD(q_) do { _Pragma("unroll") for (int mm = 0; mm < 2; ++mm) _Pragma("unroll") for (int bj = 0; bj < 2; ++bj) _Pragma("unroll") for (int n = 0; n < 2; ++n) \
            x[mm][bj][n] = *(const pg8::f32x4*)(src0 + (size_t)(((q_) >> 1) * 128 + (((q_) & 1) * 2 + mm) * 16) * 1024 + col0 + bj * 128 + n * 16); } while (0)
#define RES_MATH(q_) do { _Pragma("unroll") for (int mm = 0; mm < 2; ++mm) { float ss = 0.f; _Pragma("unroll") for (int bj = 0; bj < 2; ++bj) _Pragma("unroll") for (int n = 0; n < 2; ++n) { \
            const pg8::f32x4 o = x[mm][bj][n] + acc[(q_) >> 1][bj][((q_) & 1) * 2 + mm][n]; acc[(q_) >> 1][bj][((q_) & 1) * 2 + mm][n] = o; ss += (o[0] * o[0] + o[1] * o[1]) + (o[2] * o[2] + o[3] * o[3]); } \
            ssv[(q_) >> 1][((q_) & 1) * 2 + mm] = ss; } } while (0)
#define RES_STORE(q_) do { _Pragma("unroll") for (int mm = 0; mm < 2; ++mm) { const size_t ro = (size_t)(r0 + ((q_) >> 1) * 128 + (((q_) & 1) * 2 + mm) * 16) * 1024; _Pragma("unroll") for (int bj = 0; bj < 2; ++bj) _Pragma("unroll") for (int n = 0; n < 2; ++n) { \
            const int c = col0 + bj * 128 + n * 16; const pg8::f32x4 o = acc[(q_) >> 1][bj][((q_) & 1) * 2 + mm][n]; if constexpr (DST16) *(u32x2*)(xb_dst + ro + c) = (u32x2){cvtpk(o[0], o[1]), cvtpk(o[2], o[3])}; else if (final_out) __builtin_nontemporal_store(o, (pg8::f32x4*)(out + ro + c)); else *(pg8::f32x4*)(out + ro + c) = o; \
            if (nn) { const pg8::f32x4 y = o * gg[bj][n]; *(u32x2*)(H + ro + c) = (u32x2){cvtpk(y[0], y[1]), cvtpk(y[2], y[3])}; } } } } while (0)
#define RES_FENCE() asm volatile("" ::: "memory")
        if constexpr (SRC16) {
            const bf16* sb0 = xb_src + (size_t)r0 * 1024;
            u32x2 xh[2][2][2][2];
#define HALF_LOAD(h_) do { _Pragma("unroll") for (int qq = 0; qq < 2; ++qq) _Pragma("unroll") for (int mm = 0; mm < 2; ++mm) _Pragma("unroll") for (int bj = 0; bj < 2; ++bj) _Pragma("unroll") for (int n = 0; n < 2; ++n) \
                xh[qq][mm][bj][n] = *(const u32x2*)(sb0 + (size_t)((h_) * 128 + (qq * 2 + mm) * 16) * 1024 + col0 + bj * 128 + n * 16); } while (0)
#define HALF_CVT(qq_) do { _Pragma("unroll") for (int mm = 0; mm < 2; ++mm) _Pragma("unroll") for (int bj = 0; bj < 2; ++bj) _Pragma("unroll") for (int n = 0; n < 2; ++n) { const u32x2 w = xh[qq_][mm][bj][n]; \
                x[mm][bj][n] = (pg8::f32x4){__builtin_bit_cast(float, w.x << 16), __builtin_bit_cast(float, w.x & 0xffff0000u), __builtin_bit_cast(float, w.y << 16), __builtin_bit_cast(float, w.y & 0xffff0000u)}; } } while (0)
            HALF_LOAD(0); HALF_CVT(0); RES_MATH(0); HALF_CVT(1); RES_MATH(1); RES_FENCE();
            HALF_LOAD(1); RES_FENCE(); RES_STORE(0); RES_STORE(1); HALF_CVT(0); RES_MATH(2); HALF_CVT(1); RES_MATH(3); RES_FENCE();
            RES_STORE(2); RES_STORE(3);
#undef HALF_LOAD
#undef HALF_CVT
        } else {
        RES_LOAD(0); RES_MATH(0); RES_FENCE();
        RES_LOAD(1); RES_FENCE(); RES_STORE(0); RES_MATH(1); RES_FENCE();
        RES_LOAD(2); RES_FENCE(); RES_STORE(1); RES_MATH(2); RES_FENCE();
        RES_LOAD(3); RES_FENCE(); RES_STORE(2); RES_MATH(3); RES_FENCE();
        RES_STORE(3);
        }
#undef RES_FENCE
#undef RES_LOAD
#undef RES_MATH
#undef RES_STORE
        if (nn) {
#pragma unroll
            for (int ai = 0; ai < 2; ++ai)
#pragma unroll
                for (int m = 0; m < 4; ++m) { float ss = ssv[ai][m]; ss += shx<16>(ss); ss = sum32(ss);
                    if (fq == 0) atomicAdd(rowss + r0 + ai * 128 + m * 16, ss); }
        }
    }
};
template <bool SRC16, bool DST16>
struct EpiResW {
    static constexpr bool PERM = true, AFTER_DRAIN = false;
    const float *xs0, *xs1;
    float* out; const float* gate;
    bf16* H; const float* nn_g; const float* nn_sc; float* rowss; int final_out;
    bf16* xb_dst; const bf16* xb_src;
    __device__ __forceinline__ void operator()(const pg8::f32x4 (&acc_)[2][2][4][2], const pg8::Unit& u, int wr, int wc, int fr, int fq) const {
        asm volatile("" : "+v"(fr), "+v"(fq));
        pg8::f32x4 (&acc)[2][2][4][2] = const_cast<pg8::f32x4 (&)[2][2][4][2]>(acc_);
        const int cond = (u.pm < 32) ? 0 : 1 + ((u.pm - 32) >> 2);
        const float* gp = gate + cond * 6144;
        const int col0 = u.pn * 256 + wc * 32 + 8 * fq;
        const bool nn = nn_g != nullptr;
        pg8::f32x4 gv[2][2], gg[2][2]; float ssv[2][4];
#pragma unroll
        for (int bj = 0; bj < 2; ++bj)
#pragma unroll
            for (int n = 0; n < 2; ++n) { const int c = col0 + bj * 128 + n * 4; gv[bj][n] = *(const pg8::f32x4*)(gp + c);
                if (nn) { const pg8::f32x4 g0 = *(const pg8::f32x4*)(nn_g + c), s0 = *(const pg8::f32x4*)(nn_sc + cond * 6144 + c); gg[bj][n] = g0 * (s0 + 1.0f); } else gg[bj][n] = (pg8::f32x4){0.f, 0.f, 0.f, 0.f}; }
#pragma unroll
        for (int ai = 0; ai < 2; ++ai)
#pragma unroll
            for (int bj = 0; bj < 2; ++bj)
#pragma unroll
                for (int m = 0; m < 4; ++m)
#pragma unroll
                    for (int n = 0; n < 2; ++n) acc[ai][bj][m][n] *= gv[bj][n];
        asm volatile("" ::: "memory");
        const int r0 = u.pm * 256 + wr * 64 + fr;
        const float* src0 = (r0 < M_CTX) ? xs0 + (size_t)r0 * 1024 : xs1 + (size_t)(r0 - M_CTX) * 1024;
        pg8::f32x4 x[2][2][2];
#define RES_LOAD(q_) do { _Pragma("unroll") for (int mm = 0; mm < 2; ++mm) _Pragma("unroll") for (int bj = 0; bj < 2; ++bj) _Pragma("unroll") for (int n = 0; n < 2; ++n) \
            x[mm][bj][n] = *(const pg8::f32x4*)(src0 + (size_t)(((q_) >> 1) * 128 + (((q_) & 1) * 2 + mm) * 16) * 1024 + col0 + bj * 128 + n * 4); } while (0)
#define RES_MATH(q_) do { _Pragma("unroll") for (int mm = 0; mm < 2; ++mm) { float ss = 0.f; _Pragma("unroll") for (int bj = 0; bj < 2; ++bj) _Pragma("unroll") for (int n = 0; n < 2; ++n) { \
            const pg8::f32x4 o = x[mm][bj][n] + acc[(q_) >> 1][bj][((q_) & 1) * 2 + mm][n]; acc[(q_) >> 1][bj][((q_) & 1) * 2 + mm][n] = o; ss += (o[0] * o[0] + o[1] * o[1]) + (o[2] * o[2] + o[3] * o[3]); } \
            ssv[(q_) >> 1][((q_) & 1) * 2 + mm] = ss; } } while (0)
#define RES_STORE(q_) do { _Pragma("unroll") for (int mm = 0; mm < 2; ++mm) { const size_t ro = (size_t)(r0 + ((q_) >> 1) * 128 + (((q_) & 1) * 2 + mm) * 16) * 1024; _Pragma("unroll") for (int bj = 0; bj < 2; ++bj) { \
            const int c = col0 + bj * 128; const pg8::f32x4 o0 = acc[(q_) >> 1][bj][((q_) & 1) * 2 + mm][0], o1 = acc[(q_) >> 1][bj][((q_) & 1) * 2 + mm][1]; \
            if constexpr (DST16) *(v4u*)(xb_dst + ro + c) = (v4u){cvtpk(o0[0], o0[1]), cvtpk(o0[2], o0[3]), cvtpk(o1[0], o1[1]), cvtpk(o1[2], o1[3])}; \
            else if (final_out) { __builtin_nontemporal_store(o0, (pg8::f32x4*)(out + ro + c)); __builtin_nontemporal_store(o1, (pg8::f32x4*)(out + ro + c + 4)); } else { *(pg8::f32x4*)(out + ro + c) = o0; *(pg8::f32x4*)(out + ro + c + 4) = o1; } \
            if (nn) { const pg8::f32x4 y0 = o0 * gg[bj][0], y1 = o1 * gg[bj][1]; *(v4u*)(H + ro + c) = (v4u){cvtpk(y0[0], y0[1]), cvtpk(y0[2], y0[3]), cvtpk(y1[0], y1[1]), cvtpk(y1[2], y1[3])}; } } } } while (0)
#define RES_FENCE() asm volatile("" ::: "memory")
        if constexpr (SRC16) {
            const bf16* sb0 = xb_src + (size_t)r0 * 1024;
            v4u xh[2][2][2];
#define HALF_LOAD(h_) do { _Pragma("unroll") for (int qq = 0; qq < 2; ++qq) _Pragma("unroll") for (int mm = 0; mm < 2; ++mm) _Pragma("unroll") for (int bj = 0; bj < 2; ++bj) \
                xh[qq][mm][bj] = *(const v4u*)(sb0 + (size_t)((h_) * 128 + (qq * 2 + mm) * 16) * 1024 + col0 + bj * 128); } while (0)
#define HALF_CVT(qq_) do { _Pragma("unroll") for (int mm = 0; mm < 2; ++mm) _Pragma("unroll") for (int bj = 0; bj < 2; ++bj) { const v4u w = xh[qq_][mm][bj]; \
                x[mm][bj][0] = (pg8::f32x4){__builtin_bit_cast(float, w.x << 16), __builtin_bit_cast(float, w.x & 0xffff0000u), __builtin_bit_cast(float, w.y << 16), __builtin_bit_cast(float, w.y & 0xffff0000u)}; \
                x[mm][bj][1] = (pg8::f32x4){__builtin_bit_cast(float, w.z << 16), __builtin_bit_cast(float, w.z & 0xffff0000u), __builtin_bit_cast(float, w.w << 16), __builtin_bit_cast(float, w.w & 0xffff0000u)}; } } while (0)
            HALF_LOAD(0); HALF_CVT(0); RES_MATH(0); HALF_CVT(1); RES_MATH(1); RES_FENCE();
            HALF_LOAD(1); RES_FENCE(); RES_STORE(0); RES_STORE(1); HALF_CVT(0); RES_MATH(2); HALF_CVT(1); RES_MATH(3); RES_FENCE();
            RES_STORE(2); RES_STORE(3);
#undef HALF_LOAD
#undef HALF_CVT
        } else {
        RES_LOAD(0); RES_MATH(0); RES_FENCE();
        RES_LOAD(1); RES_FENCE(); RES_STORE(0); RES_MATH(1); RES_FENCE();
        RES_LOAD(2); RES_FENCE(); RES_STORE(1); RES_MATH(2); RES_FENCE();
        RES_LOAD(3); RES_FENCE(); RES_STORE(2); RES_MATH(3); RES_FENCE();
        RES_STORE(3);
        }
#undef RES_FENCE
#undef RES_LOAD
#undef RES_MATH
#undef RES_STORE
        if (nn) {
            int lq_; asm volatile("v_mbcnt_lo_u32_b32 %0, -1, 0\n\tv_mbcnt_hi_u32_b32 %0, -1, %0" : "=v"(lq_)); lq_ >>= 4;
#pragma unroll
            for (int ai = 0; ai < 2; ++ai)
#pragma unroll
                for (int m = 0; m < 4; ++m) { float ss = ssv[ai][m]; ss += shx<16>(ss); ss = sum32(ss);
                    if (lq_ == 0) atomicAdd(rowss + r0 + ai * 128 + m * 16, ss); }
        }
    }
};

struct EpiFfn {
    static constexpr bool PERM = true, AFTER_DRAIN = false;
    bf16* ACT_; const float* rowss; const float* bias;
    __device__ __forceinline__ void operator()(const pg8::f32x4 (&acc)[2][2][4][2], const pg8::Unit& u, int wr, int wc, int fr, int fq) const {
        asm volatile("" : "+v"(fr), "+v"(fq));
        unsigned long long zo_ = 0ull; asm volatile("" : "+s"(zo_)); bf16* ACT = ACT_ + zo_;
        const int cond = (u.pm < 32) ? 0 : 1 + ((u.pm - 32) >> 2);
        const float* bp = bias + (size_t)cond * BIAS_LD + u.pn * 256 + wc * 32 + fq * 8;
        float bg[8], bu[8];
        { const pg8::f32x4 b0 = *(const pg8::f32x4*)bp, b1 = *(const pg8::f32x4*)(bp + 4), b2 = *(const pg8::f32x4*)(bp + 128), b3 = *(const pg8::f32x4*)(bp + 132);
#pragma unroll
          for (int e = 0; e < 4; ++e) { bg[e] = b0[e]; bg[4 + e] = b1[e]; bu[e] = b2[e]; bu[4 + e] = b3[e]; } }
        float rsv[2][4];
#pragma unroll
        for (int ai = 0; ai < 2; ++ai)
#pragma unroll
            for (int m = 0; m < 4; ++m) rsv[ai][m] = rowss[u.pm * 256 + ai * 128 + wr * 64 + m * 16 + fr];
#pragma unroll
        for (int ai = 0; ai < 2; ++ai)
#pragma unroll
            for (int m = 0; m < 4; ++m) {
                asm volatile("" ::: "memory"); const int r = u.pm * 256 + ai * 128 + wr * 64 + m * 16 + fr;
                const float rs = 1.0f / sqrtf(rsv[ai][m] * (1.0f / 1024.0f) + EPSF);
                float g[8], up[8]; ld8(acc[ai][0][m], g); ld8(acc[ai][1][m], up);
#pragma unroll
                for (int e = 0; e < 8; ++e) g[e] = siluf(g[e] * rs + bg[e]) * (up[e] * rs + bu[e]);
                *(v4u*)(ACT + (size_t)r * D_FFN + u.pn * 128 + wc * 32 + fq * 8) = pack8(g);
            }
    }
};

struct RevOrder : pg8::StaticOrder {
    __device__ __forceinline__ bool next(int i, pg8::Unit& u) const { if (!pg8::StaticOrder::next(i, u)) return false; u.pm = nM - 1 - u.pm; return true; }
};

#ifndef CHAIN_QREP
#define CHAIN_QREP 1
#endif
#ifndef CHAIN_KVREP
#define CHAIN_KVREP 1
#endif
struct WinOrder : pg8::StaticOrder {
    bool sp;
    __device__ __forceinline__ bool next(int i, pg8::Unit& u) const {
        if (!sp) { if (!pg8::StaticOrder::next(i, u)) return false; u.pm = nM - 1 - u.pm; return true; }
        const int x = c & 7, k = c >> 3;
        if (k < 10) { if (i > 0) return false; u.pm = 39 - (5 * x + (k >> 1)); u.pn = 8 + (k & 1); return true; }
        const int j = (k - 10) + 22 * i; if (i > 1 || j >= 40) return false;
        u.pm = 39 - (5 * x + j % 5); u.pn = j / 5; return true;
    }
};
struct QOrder : pg8::StaticOrder {
    int cpm;
    __device__ __forceinline__ bool next(int i, pg8::Unit& u) const {
        if (cpm < 0) { if (!pg8::StaticOrder::next(i, u)) return false; u.pm = nM - 1 - u.pm; return true; }
        if (i >= nN * CHAIN_QREP) return false; u.pm = cpm; u.pn = i % nN; return true;
    }
};

struct KvOrder : pg8::StaticOrder {
    static constexpr bool SPLITK = true, HANDOFF = false;
    int cpm, cn0, cn1;
    __device__ __forceinline__ bool next(int i, pg8::Unit& u) const {
        u.k0 = 0; u.nkt = 2; u.role = 0; u.slab = -1; u.src2 = -1;
        if (cpm >= 0) { if (i >= (cn1 - cn0) * CHAIN_KVREP) return false; u.pm = cpm; u.pn = cn0 + i % (cn1 - cn0); return true; }
        if (G != 256) return pg8::StaticOrder::next(i, u);
        if (c < 120 || i > 1) return false;
        const int L = i * 136 + (c - 120); if (L >= nwg) return false;
        map(L, u); return true;
    }
};

struct PanelOrder : pg8::StaticOrder {
    __device__ __forceinline__ bool next(int i, pg8::Unit& u) const {
        if (G != 256 || nwg != 160) return pg8::StaticOrder::next(i, u);
        if (i > 0 || c >= 160) return false;
        const int x = c & 7, t = c >> 3; u.pm = 5 * x + t % 5; u.pn = t / 5; return true;
    }
};

#ifndef FO_NMAIN
#define FO_NMAIN 32
#endif
template <int NMAIN, int NTOT>
struct SplitOrder : pg8::StaticOrder {
    static constexpr bool SPLITK = true, HANDOFF = true;
    float* slab; unsigned* flags; unsigned epoch;
    __device__ __forceinline__ bool next(int i, pg8::Unit& u) const {
        u.src2 = -1;
        if (G != 256) { if (!pg8::StaticOrder::next(i, u)) return false; u.k0 = 0; u.nkt = NTOT; u.role = 0; u.slab = -1; return true; }
        if (c < 160) { if (i > 0) return false; pmap(c, u); u.k0 = 0; u.nkt = NMAIN; u.role = 1; u.slab = c; return true; }
        const int L = (i == 0) ? c - 160 : c - 64; if (i > 1 || L >= 160) return false;
        pmap(L, u); u.k0 = NMAIN; u.nkt = NTOT - NMAIN; u.role = 2; u.slab = L; return true;
    }
    __device__ __forceinline__ void pmap(int L, pg8::Unit& u) const { const int x = L & 7, t = L >> 3; u.pm = 5 * x + t % 5; u.pn = t / 5;
    }
};

template <int P, bool REV>
struct StreamKOrder : pg8::StaticOrder {
    static constexpr bool SPLITK = true, HANDOFF = true;
    float* slab; unsigned* flags; unsigned epoch;
    __device__ __forceinline__ bool next(int i, pg8::Unit& u) const {
        if (G != 256 || (nwg & 7)) { if (!pg8::StaticOrder::next(i, u)) return false; if (REV) u.pm = nM - 1 - u.pm; u.k0 = 0; u.nkt = 2 * P; u.role = 0; u.slab = -1; u.src2 = -1; return true; }
        const int x = c & 7, k = c >> 3, TX = nwg >> 3, R = TX * P;
        const int s = (k * R) >> 5, e = ((k + 1) * R) >> 5;
        const int ta = s / P, oa = s - ta * P, tb = (e - 1) / P, ob = e - tb * P, nseg = tb - ta + 1;
        if (i >= nseg) return false;
        const bool dl = ob < P;
        const int j = dl ? (i == 0 ? nseg - 1 : i - 1) : i;
        const int t = ta + j, lo = (j == 0) ? oa : 0, hi = (j == nseg - 1) ? ob : P;
        map2(x * TX + t, u); if (REV) u.pm = nM - 1 - u.pm;
        u.k0 = 2 * lo; u.nkt = 2 * (hi - lo); u.slab = -1; u.src2 = -1;
        if (hi < P) { u.role = 2; u.slab = c; }
        else if (lo == 0) u.role = 0;
        else { u.role = 1; u.slab = c - 8; const int sp = ((k - 1) * R) >> 5; if (sp > t * P) u.src2 = c - 16; }
        return true;
    }
};

struct Frame {
    LAS unsigned char* lds;
    volatile LAS unsigned* MISC;
    gu32* ctl;
    int tid, lane, wave, G, bx;
};

__device__ __forceinline__ int fresh_tid(int wave) { int lane; asm volatile("v_mbcnt_lo_u32_b32 %0, -1, 0\n\tv_mbcnt_hi_u32_b32 %0, -1, %0" : "=v"(lane)); return (wave << 6) | lane; }
__device__ __forceinline__ void frame_refresh(Frame& F) { const int t = fresh_tid(F.wave); F.tid = t; F.lane = t & 63; }
__device__ __forceinline__ float wave_sum(float v) {
    v += shx<1>(v); v += shx<2>(v); v += shx<4>(v); v += shx<8>(v); v += shx<16>(v); v = sum32(v);
    return v;
}

__device__ __forceinline__ void transpose_item(const float* W, int Nsrc, int Ksrc, bf16* WT, int Kdst, int k0, int n0dst, int sc0, float scale, LAS float* scr, int lane) {
    const bool zero = (sc0 < 0) || (k0 >= Ksrc);
    if (!zero) {
        float tv[32];
#pragma unroll
        for (int i = 0; i < 32; ++i) tv[i] = __builtin_nontemporal_load(&W[(size_t)(k0 + 2 * i + (lane >> 5)) * Nsrc + sc0 + (lane & 31)]);
#pragma unroll
        for (int i = 0; i < 32; ++i) scr[(2 * i + (lane >> 5)) * 33 + (lane & 31)] = tv[i] * scale;
    }
    LDS_WAIT(); asm volatile("" ::: "memory");
    const int c = lane & 7;
#pragma unroll
    for (int j = 0; j < 4; ++j) { const int n = (lane >> 3) + 8 * j; const LAS float* s = scr + (8 * c) * 33 + n;
        v4u o; if (zero) { o = (v4u){0u, 0u, 0u, 0u}; } else { o.x = cvtpk(s[0 * 33], s[1 * 33]); o.y = cvtpk(s[2 * 33], s[3 * 33]); o.z = cvtpk(s[4 * 33], s[5 * 33]); o.w = cvtpk(s[6 * 33], s[7 * 33]); }
        *(GAS v4u*)(WT + (size_t)(n0dst + n) * Kdst + k0 + 8 * c) = o; }
    LDS_WAIT(); asm volatile("" ::: "memory");
}
__device__ __forceinline__ int map_win(int nb) { return nb < 77 ? nb * 32 : -1; }
__device__ __forceinline__ int map_wqb(int nb) { const int c = nb * 32; if (c < 512) { const int pn = c >> 8, bj = (c >> 7) & 1, wc = (c >> 5) & 3; return (4 * pn + wc) * 96 + 32 * bj; } const int cc = c - 512, bj = cc >> 7, wc = (cc >> 5) & 3; return (4 * bj + wc) * 96 + 64; }
__device__ __forceinline__ int map_wkvb(int nb) { const int c = nb * 32, pn = c >> 8, bj = (c >> 7) & 1, wc = (c >> 5) & 3; return pn < 2 ? (4 * pn + wc) * 128 + 32 * bj : (4 * (pn - 2) + wc) * 128 + 64 + 32 * bj; }
__device__ __forceinline__ int map_wfi(int nb) { const int c = nb * 32, pn = c >> 8, bj = (c >> 7) & 1, j = c & 127; return bj * D_FFN + 128 * pn + j; }

__device__ __forceinline__ void p0_prologue(Frame& F, const Params& P) {
    unsigned char* ws = P.ws;
    if (F.bx < 192) {
        const int l = F.bx / 96, n0 = (F.bx % 96) * 64;
        LAS float* sil = (LAS float*)(F.lds);
        LAS float* red = (LAS float*)(F.lds + 12288);
        for (int i = F.tid; i < 3072; i += 512) { const int cd = i >> 10, k = i & 1023; const float x = (cd == 0) ? P.in[7][k] : P.in[6][(cd - 1) * 1024 + k]; sil[i] = siluf(x); }
        __syncthreads();
        const float* W = P.in[8] + (size_t)l * 1024 * 6144 + n0 + F.lane;
        float a0 = 0.f, a1 = 0.f, a2 = 0.f;
        const int kb = F.wave * 128;
#pragma unroll 16
        for (int k = 0; k < 128; ++k) { const float w = __builtin_nontemporal_load(&W[(size_t)(kb + k) * 6144]); a0 += sil[kb + k] * w; a1 += sil[1024 + kb + k] * w; a2 += sil[2048 + kb + k] * w; }
        red[(F.wave * 3 + 0) * 64 + F.lane] = a0; red[(F.wave * 3 + 1) * 64 + F.lane] = a1; red[(F.wave * 3 + 2) * 64 + F.lane] = a2;
        __syncthreads();
        if (F.tid < 192) { const int cd = F.tid >> 6, cl = F.tid & 63; float s = P.in[9][l * 6144 + n0 + cl];
#pragma unroll
            for (int w = 0; w < 8; ++w) s += red[(w * 3 + cd) * 64 + cl];
            ((float*)(ws + WS_MOD))[(l * 3 + cd) * 6144 + n0 + cl] = s; }
        __syncthreads();
    }
    if (F.bx == F.G - 1) {
        if (F.tid < 32) { const int l_ = F.tid >> 4, d_ = (F.tid >> 3) & 1, h_ = F.tid & 7; const float p_ = (d_ ? P.in[22] : P.in[21])[l_ * 8 + h_];
            ((float*)(ws + WS_TAB + 16384))[F.tid] = log1pf(-exp2f(-p_)) * 1.4426950408889634f; }
        float2* t64 = (float2*)(ws + WS_TAB); float2* t32 = t64 + 64 * 16;
        for (int i = F.tid; i < 64 * 16; i += 512) { const int pos = i >> 4, j = i & 15; const float inv = powf(10000.0f, -(float)j / 16.0f); const float ang = (float)pos * inv; float s, c; sincosf(ang, &s, &c); t64[i] = make_float2(c, s); }
        for (int i = F.tid; i < 64 * 8; i += 512) { const int pos = i >> 3, j = i & 7; const float inv = powf(10000.0f, -(float)j / 8.0f); const float ang = (float)pos * inv; float s, c; sincosf(ang, &s, &c); t32[i] = make_float2(c, s); }
    }
    {
        LAS float* scr = (LAS float*)(F.lds + RING_OFF + F.wave * 16384);
        const int gw = F.bx * NWAVES + F.wave, NGW = F.G * NWAVES;
        constexpr int I_IN = 16 * 80, I_QB = 4 * 24, I_KVB = 4 * 32, I_O = 16 * 32, I_FI = 16 * 176, I_FO = 44 * 32, I_L = I_IN + I_QB + I_KVB + I_O + I_FI + I_FO;
        for (int it = gw; it < 2 * I_L; it += NGW) {
            const int l = it / I_L; int r = it % I_L;
            unsigned char* wl = ws + WS_W + (size_t)l * LAYER_W;
            if (r < I_IN) { const int kb = r / 80, nb = r % 80; const int sc = map_win(nb); transpose_item(P.in[12] + (size_t)l * 1024 * 2464, 2464, 1024, (bf16*)(wl + W_IN_OFF), 1024, 64 * kb, 32 * nb, sc, (nb >= 16 && nb < 32) ? 0.125f : 1.0f, scr, F.lane); continue; } r -= I_IN;
            if (r < I_QB) { const int kb = r / 24, nb = r % 24; transpose_item(P.in[14] + (size_t)l * 256 * 768, 768, 256, (bf16*)(wl + W_QB_OFF), 256, 64 * kb, 32 * nb, map_wqb(nb), 1.0f, scr, F.lane); continue; } r -= I_QB;
            if (r < I_KVB) { const int kb = r / 32, nb = r % 32; transpose_item(P.in[16] + (size_t)l * 128 * 1024, 1024, 128, (bf16*)(wl + W_KVB_OFF), 256, 64 * kb, 32 * nb, map_wkvb(nb), 1.0f, scr, F.lane); continue; } r -= I_KVB;
            if (r < I_O) { const int kb = r / 32, nb = r % 32; transpose_item(P.in[25] + (size_t)l * 1024 * 1024, 1024, 1024, (bf16*)(wl + W_O_OFF), 1024, 64 * kb, 32 * nb, 32 * nb, 1.0f, scr, F.lane); continue; } r -= I_O;
            if (r < I_FI) { const int kb = r / 176, nb = r % 176; transpose_item(P.in[26] + (size_t)l * 1024 * N_FI, N_FI, 1024, (bf16*)(wl + W_FI_OFF), 1024, 64 * kb, 32 * nb, map_wfi(nb), 1.0f, scr, F.lane); continue; } r -= I_FI;
            { const int kb = r / 32, nb = r % 32; transpose_item(P.in[27] + (size_t)l * D_FFN * 1024, 1024, D_FFN, (bf16*)(wl + W_FO_OFF), D_FFN, 64 * kb, 32 * nb, 32 * nb, 1.0f, scr, F.lane); }
        }
    }
}

__device__ __forceinline__ void norm_phase(Frame& F, const Params& P, int layer, int which) {
    unsigned char* ws = P.ws;
    const int gw = F.bx * NWAVES + F.wave, NGW = F.G * NWAVES;
    const float* g = P.in[which == 0 ? 10 : 11] + layer * 1024;
    const float* mod = (const float*)(ws + WS_MOD) + (size_t)layer * 3 * 6144;
    bf16* H = (bf16*)(ws + WS_H);
    for (int m = gw; m < M_TOK; m += NGW) {
        const float* xrow;
        if (which == 0 && layer == 0) xrow = (m < M_CTX) ? P.in[0] + (size_t)m * 1024 : P.in[1] + (size_t)(m - M_CTX) * 1024;
        else xrow = P.out + (size_t)m * 1024;
        const int cond = (m < M_CTX) ? 0 : 1 + ((m - M_CTX) >> 10);
        const float* sh = mod + cond * 6144 + (which == 0 ? 0 : 3) * 1024;
        const float* sc = sh + 1024;
        const GAS f32x4* xr = (const GAS f32x4*)xrow + F.lane;
        f32x4 v[4]; float s = 0.f;
#pragma unroll
        for (int j = 0; j < 4; ++j) { v[j] = __builtin_nontemporal_load(xr + 64 * j); s += (v[j].x * v[j].x + v[j].y * v[j].y) + (v[j].z * v[j].z + v[j].w * v[j].w); }
        const float rstd = 1.0f / sqrtf(wave_sum(s) * (1.0f / 1024.0f) + EPSF);
        GAS unsigned long long* o8 = (GAS unsigned long long*)(H + (size_t)m * 1024) + F.lane;
#pragma unroll
        for (int j = 0; j < 4; ++j) {
            const f32x4 gg = *((const f32x4*)g + F.lane + 64 * j), s1 = *((const f32x4*)sc + F.lane + 64 * j), h1 = *((const f32x4*)sh + F.lane + 64 * j);
            const f32x4 y = v[j] * rstd * gg * (s1 + 1.0f) + h1;
            o8[64 * j] = (unsigned long long)cvtpk(y.x, y.y) | ((unsigned long long)cvtpk(y.z, y.w) << 32);
        }
    }
}
__device__ __forceinline__ void cache_rows_job(Frame& F, const Params& P, int layer) {
    unsigned char* ws = P.ws;
    const int gw = F.bx * NWAVES + F.wave, NGW = F.G * NWAVES;
    bf16* KVA = (bf16*)(ws + WS_KVA); bf16* KR = (bf16*)(ws + WS_KR);
    for (int cr = gw; cr < M_KV - M_TOK; cr += NGW) {
        const int m = M_TOK + cr, b = cr >> 8, n = cr & 255;
        const float* ck = P.in[2] + ((size_t)(b * 2 + layer) * 256 + n) * 128;
        const float* kr = P.in[3] + ((size_t)(b * 2 + layer) * 256 + n) * 32;
        const f32x2_t a = *((const f32x2_t*)ck + F.lane);
        *((unsigned*)(KVA + (size_t)m * 256) + F.lane) = cvtpk(a.x, a.y);
        if (F.lane < 16) { const f32x2_t k2 = *((const f32x2_t*)kr + F.lane); *((unsigned*)(KR + (size_t)m * 32) + F.lane) = cvtpk(k2.x, k2.y); }
    }
}
__device__ __forceinline__ void bias_job(Frame& F, const Params& P, int gw, int NGW) {
    unsigned char* ws = P.ws;
    for (int it = gw; it < 2 * (BIAS_LD / 8); it += NGW) {
        const int l = it / (BIAS_LD / 8), cc0 = (it % (BIAS_LD / 8)) * 8;
        const bf16* wrow = (cc0 < 2560) ? (const bf16*)(ws + WS_W + (size_t)l * LAYER_W + W_IN_OFF) + (size_t)cc0 * 1024 : (const bf16*)(ws + WS_W + (size_t)l * LAYER_W + W_FI_OFF) + (size_t)(cc0 - 2560) * 1024;
        const float* shb = (const float*)(ws + WS_MOD) + (size_t)l * 3 * 6144 + (cc0 < 2560 ? 0 : 3) * 1024 + F.lane * 16;
        f32x4 sh[3][4];
#pragma unroll
        for (int cd = 0; cd < 3; ++cd)
#pragma unroll
            for (int q = 0; q < 4; ++q) sh[cd][q] = *(const f32x4*)(shb + cd * 6144 + 4 * q);
        float res[3] = {0.f, 0.f, 0.f};
#pragma unroll
        for (int jb = 0; jb < 2; ++jb) {
        v4u wv[4][2];
#pragma unroll
        for (int j = 0; j < 4; ++j) { wv[j][0] = *(const v4u*)(wrow + (size_t)(4 * jb + j) * 1024 + F.lane * 16); wv[j][1] = *(const v4u*)(wrow + (size_t)(4 * jb + j) * 1024 + F.lane * 16 + 8); }
#pragma unroll
        for (int j = 0; j < 4; ++j) {
            float wf[16];
#pragma unroll
            for (int h = 0; h < 2; ++h) { const v4u x = wv[j][h];
                wf[8 * h + 0] = b2f((unsigned short)(x.x & 0xffffu)); wf[8 * h + 1] = b2f((unsigned short)(x.x >> 16)); wf[8 * h + 2] = b2f((unsigned short)(x.y & 0xffffu)); wf[8 * h + 3] = b2f((unsigned short)(x.y >> 16));
                wf[8 * h + 4] = b2f((unsigned short)(x.z & 0xffffu)); wf[8 * h + 5] = b2f((unsigned short)(x.z >> 16)); wf[8 * h + 6] = b2f((unsigned short)(x.w & 0xffffu)); wf[8 * h + 7] = b2f((unsigned short)(x.w >> 16)); }
#pragma unroll
            for (int cd = 0; cd < 3; ++cd) { float a = 0.f;
#pragma unroll
                for (int e = 0; e < 16; ++e) a += wf[e] * sh[cd][e >> 2][e & 3];
                a = wave_sum(a);
                res[cd] = (F.lane == 4 * jb + j) ? a : res[cd]; }
        }
        }
        if (F.lane < 8) { float* bo = (float*)(ws + WS_BIAS) + (size_t)l * 3 * BIAS_LD + cc0 + F.lane; bo[0] = res[0]; bo[BIAS_LD] = res[1]; bo[2 * BIAS_LD] = res[2]; }
    }
}

struct MixP {
    const bf16 *Q, *KN, *KR, *VT, *RQ, *RK, *RKT, *RVT, *RG;
    bf16* MIX;
    const float *s_f0, *s_b0;
    const float *p_f, *p_b;
    const float *g_gn, *b_gn;
    float *out_sf, *out_sb;
    int layer;
    const float* lgtab;
    int defer_states;
};
constexpr int MIX_KBYTES = 128 * 208, MIX_VSTR = 264, MIX_VBYTES = 64 * MIX_VSTR, MIX_BUF = MIX_KBYTES + MIX_VBYTES;

#ifndef MIX_DEFER
#define MIX_DEFER 1
#endif
__device__ __forceinline__ int mix_code(int v, int G, bool att, int i) {
    if (G == 256 && MIX_DEFER) {
        if (att) { if (v < 64) return i == 0 ? v : (i == 1 ? 384 + v : -1); return i == 0 ? 384 + v : -1; }
        if (v < 64) return -1;
        if (v < 128) return i == 0 ? v : -1;
        return i < 2 ? 128 + 2 * (v - 128) + i : -1;
    }
    if (G == 256) {
        if (att) { if (v < 64) return i == 0 ? v : (i <= 2 ? 384 + 2 * v + (i - 1) : -1); if (v < 128) return i < 2 ? 384 + 2 * v + i : -1; return -1; }
        if (v < 64) return -1;
        if (v < 128) return i == 0 ? v : -1;
        return i < 2 ? 128 + 2 * (v - 128) + i : -1;
    }
    if (att) { const int j = v + i * G; return j < 64 ? j : (j < 320 ? 384 + (j - 64) : -1); }
    const int j = v + i * G; return j < 320 ? 64 + j : -1;
}

template <bool ATT>
__device__ __forceinline__ void mix_run(const MixP& P, LAS unsigned char* lds, int v, int G, int tid) {
    constexpr int DK = ATT ? 96 : 64, NKS = DK / 16, KSTR = DK * 2 + 16, KCH = DK / 8, NKL = ATT ? 3 : 2;
    int code = mix_code(v, G, ATT, 0);
    if (code < 0) return;
    asm volatile("" : "+v"(tid));
    const int lane = tid & 63, w = __builtin_amdgcn_readfirstlane(tid >> 6), c = lane & 31, hh = lane >> 5;
    int krow[NKL], kch[NKL];
#pragma unroll
    for (int i = 0; i < NKL; ++i) { const int cid = tid + 512 * i; krow[i] = ATT ? cid / KCH : cid >> 3; kch[i] = ATT ? cid % KCH : cid & 7; }
    const int vrow0 = tid >> 4, vch = tid & 15;
    v4u rk0[NKL], rk1[NKL], rv0[2], rv1[2];
    pg8::bf16x8 qf[NKS];
    LAS unsigned char* const kb0 = lds, * const vb0 = lds + MIX_KBYTES, * const kb1 = lds + MIX_BUF, * const vb1 = lds + MIX_BUF + MIX_KBYTES;
#define MIX_DECODE(code_, lat_, b_, h_, qb_) const bool lat_ = (code_) < 128; const int uu_##b_ = lat_ ? ((code_) & 63) : (((code_) - 128) & 255); \
        const int b_ = lat_ ? (uu_##b_ >> 5) : (uu_##b_ >> 3), h_ = lat_ ? ((uu_##b_ >> 2) & 7) : (uu_##b_ & 7), qb_ = lat_ ? (uu_##b_ & 3) : 0
#define MIX_KROW(lat_, b_, ci) ((lat_) ? (((ci) < 8) ? M_CTX + (b_) * 1024 + 128 * (ci) : M_TOK + (b_) * 256 + 128 * ((ci) - 8)) : (b_) * 256 + 128 * (ci))
#define MIX_LDNT(p) __builtin_nontemporal_load((const v4u*)(p))
#define MIX_ISSUE(SK_, SV_, lat_, b_, h_, ci) do { const int kr_ = MIX_KROW(lat_, b_, ci); \
        _Pragma("unroll") for (int i_ = 0; i_ < NKL; ++i_) { \
            if (ATT) SK_[i_] = (kch[i_] < 8) ? MIX_LDNT(P.KN + (size_t)(kr_ + krow[i_]) * 512 + (h_) * 64 + kch[i_] * 8) : MIX_LDNT(P.KR + (size_t)(kr_ + krow[i_]) * 32 + (kch[i_] - 8) * 8); \
            else SK_[i_] = MIX_LDNT(P.RK + (size_t)(kr_ + krow[i_]) * 512 + (h_) * 64 + kch[i_] * 8); } \
        _Pragma("unroll") for (int i_ = 0; i_ < 2; ++i_) { \
            if (ATT) SV_[i_] = MIX_LDNT(P.VT + (size_t)((h_) * 64 + vrow0 + 32 * i_) * M_KV + kr_ + vch * 8); \
            else SV_[i_] = MIX_LDNT(P.RVT + (size_t)((h_) * 64 + vrow0 + 32 * i_) * M_TOK + kr_ + vch * 8); } } while (0)
#define MIX_STORE(SK_, SV_, kb_, vb_) do { \
        _Pragma("unroll") for (int i_ = 0; i_ < NKL; ++i_) *(LAS v4u*)((kb_) + krow[i_] * KSTR + kch[i_] * 16) = SK_[i_]; \
        _Pragma("unroll") for (int i_ = 0; i_ < 2; ++i_) { LAS unsigned char* p_ = (vb_) + (vrow0 + 32 * i_) * MIX_VSTR + vch * 16; \
            *(LAS u32x2*)p_ = (u32x2){SV_[i_].x, SV_[i_].y}; *(LAS u32x2*)(p_ + 8) = (u32x2){SV_[i_].z, SV_[i_].w}; } } while (0)
#define MIX_LOADQ(QF_, lat_, b_, h_, qb_) do { const int qr_ = ((lat_) ? M_CTX + (b_) * 1024 : (b_) * 256) + (qb_) * 256 + w * 32 + c; \
        const bf16* qp_ = ATT ? P.Q + (size_t)qr_ * 768 + (h_) * 96 : P.RQ + (size_t)qr_ * 512 + (h_) * 64; \
        _Pragma("unroll") for (int ks_ = 0; ks_ < NKS; ++ks_) QF_[ks_] = *(const pg8::bf16x8*)(qp_ + 16 * ks_ + 8 * hh); } while (0)
#define MIX_DECAY(SX_, kblk_, kb0_) do { \
        if ((kblk_) == qblk) { \
            _Pragma("unroll") for (int r = 0; r < 16; ++r) { const float d_ = (float)(qpos - ((kb0_) + (r & 3) + 8 * (r >> 2))); \
                const float e_ = d_ > 0.f ? d_ * lgf2 : -d_ * lgb2; float w_ = __builtin_amdgcn_exp2f(e_); w_ = (d_ == 0.f) ? 2.0f : w_; SX_[r] *= w_; } \
        } else { const bool fw_ = (kblk_) < qblk; const float lg_ = fw_ ? lgf2 : -lgb2; const float eq_ = __builtin_amdgcn_exp2f((float)(qpos - (kb0_)) * lg_); \
              \
            const float c0_ = eq_, c1_ = eq_ * (fw_ ? tf8[0] : tb8[0]), c2_ = eq_ * (fw_ ? tf8[1] : tb8[1]), c3_ = eq_ * (fw_ ? tf8[2] : tb8[2]); \
            const float u1_ = fw_ ? tf1[0] : tb1[0], u2_ = fw_ ? tf1[1] : tb1[1], u3_ = fw_ ? tf1[2] : tb1[2]; \
            SX_[0] *= c0_; SX_[1] *= c0_ * u1_; SX_[2] *= c0_ * u2_; SX_[3] *= c0_ * u3_; \
            SX_[4] *= c1_; SX_[5] *= c1_ * u1_; SX_[6] *= c1_ * u2_; SX_[7] *= c1_ * u3_; \
            SX_[8] *= c2_; SX_[9] *= c2_ * u1_; SX_[10] *= c2_ * u2_; SX_[11] *= c2_ * u3_; \
            SX_[12] *= c3_; SX_[13] *= c3_ * u1_; SX_[14] *= c3_ * u2_; SX_[15] *= c3_ * u3_; } } while (0)
#define MIX_QK(SA_, SB_, kt_) do { \
        _Pragma("unroll") \
        for (int ks = 0; ks < NKS; ++ks) { \
            const pg8::bf16x8 a0 = *(const LAS pg8::bf16x8*)((kt_) + c * KSTR + (16 * ks + 8 * hh) * 2); \
            const pg8::bf16x8 a1 = *(const LAS pg8::bf16x8*)((kt_) + (32 + c) * KSTR + (16 * ks + 8 * hh) * 2); \
            SA_ = __builtin_amdgcn_mfma_f32_32x32x16_bf16(a0, qf[ks], SA_, 0, 0, 0); \
            SB_ = __builtin_amdgcn_mfma_f32_32x32x16_bf16(a1, qf[ks], SB_, 0, 0, 0); \
        } } while (0)
#define MIX_EW(SA_, SB_, ci, sub, STATE_) do { \
        if (ATT) { \
            _Pragma("unroll") \
            for (int r = 0; r < 16; ++r) { SA_[r] = __builtin_amdgcn_exp2f(SA_[r]); SB_[r] = __builtin_amdgcn_exp2f(SB_[r]); lsum += SA_[r] + SB_[r]; } \
        } else if (!(STATE_)) { \
            const int kblk0_ = 4 * (ci) + 2 * (sub), kpos0_ = 128 * (ci) + 64 * (sub) + 4 * hh; \
            MIX_DECAY(SA_, kblk0_, kpos0_); MIX_DECAY(SB_, kblk0_ + 1, kpos0_ + 32); \
        } else { \
            const float wq = ((sub) == 0) ? __builtin_amdgcn_exp2f((float)(qpos + 1) * lgf2) : __builtin_amdgcn_exp2f((float)(1024 - qpos) * lgb2); \
            _Pragma("unroll") \
            for (int r = 0; r < 16; ++r) { SA_[r] *= wq; SB_[r] *= wq; } \
        } } while (0)
#define MIX_PV(SA_, SB_, vb, sub) do { \
        pg8::bf16x8 pf[2][2]; \
        { v4u t0, t1, t2, t3; \
          t0 = (v4u){cvtpk(SA_[0], SA_[1]), cvtpk(SA_[2], SA_[3]), cvtpk(SA_[4], SA_[5]), cvtpk(SA_[6], SA_[7])}; \
          t1 = (v4u){cvtpk(SA_[8], SA_[9]), cvtpk(SA_[10], SA_[11]), cvtpk(SA_[12], SA_[13]), cvtpk(SA_[14], SA_[15])}; \
          t2 = (v4u){cvtpk(SB_[0], SB_[1]), cvtpk(SB_[2], SB_[3]), cvtpk(SB_[4], SB_[5]), cvtpk(SB_[6], SB_[7])}; \
          t3 = (v4u){cvtpk(SB_[8], SB_[9]), cvtpk(SB_[10], SB_[11]), cvtpk(SB_[12], SB_[13]), cvtpk(SB_[14], SB_[15])}; \
          pf[0][0] = __builtin_bit_cast(pg8::bf16x8, t0); pf[0][1] = __builtin_bit_cast(pg8::bf16x8, t1); pf[1][0] = __builtin_bit_cast(pg8::bf16x8, t2); pf[1][1] = __builtin_bit_cast(pg8::bf16x8, t3); } \
        _Pragma("unroll") \
        for (int kt = 0; kt < 2; ++kt) \
            _Pragma("unroll") \
            for (int s = 0; s < 2; ++s) { \
                const int koff = (64 * (sub) + 32 * kt + 16 * s + 4 * hh) * 2; \
                const u32x2 l0 = *(const LAS u32x2*)((vb) + c * MIX_VSTR + koff), h0 = *(const LAS u32x2*)((vb) + c * MIX_VSTR + koff + 16); \
                const u32x2 l1 = *(const LAS u32x2*)((vb) + (32 + c) * MIX_VSTR + koff), h1 = *(const LAS u32x2*)((vb) + (32 + c) * MIX_VSTR + koff + 16); \
                const pg8::bf16x8 vf0 = __builtin_bit_cast(pg8::bf16x8, (v4u){l0.x, l0.y, h0.x, h0.y}); \
                const pg8::bf16x8 vf1 = __builtin_bit_cast(pg8::bf16x8, (v4u){l1.x, l1.y, h1.x, h1.y}); \
                o0 = __builtin_amdgcn_mfma_f32_32x32x16_bf16(vf0, pf[kt][s], o0, 0, 0, 0); \
                o1 = __builtin_amdgcn_mfma_f32_32x32x16_bf16(vf1, pf[kt][s], o1, 0, 0, 0); \
            } } while (0)
#define MIX_COMPUTE(kb, vb, ci, STATE_) do { \
        f32x16 sa0 = {}, sb0 = {}, sa1 = {}, sb1 = {}; \
        MIX_QK(sa0, sb0, (kb)); \
        MIX_QK(sa1, sb1, (kb) + 64 * KSTR); \
        MIX_EW(sa0, sb0, ci, 0, STATE_); \
        MIX_PV(sa0, sb0, vb, 0); \
        MIX_EW(sa1, sb1, ci, 1, STATE_); \
        MIX_PV(sa1, sb1, vb, 1); \
        } while (0)
    {
        MIX_DECODE(code, lat0, b0, h0, qb0);
        MIX_LOADQ(qf, lat0, b0, h0, qb0);
        MIX_ISSUE(rk0, rv0, lat0, b0, h0, 0);
        MIX_ISSUE(rk1, rv1, lat0, b0, h0, 1);
    }
    for (int ui = 0; code >= 0; ++ui) {
        const int ncode = mix_code(v, G, ATT, ui + 1);
        const int pcode = ncode >= 0 ? ncode : code;
        MIX_DECODE(code, lat, b, h, qb);
        MIX_DECODE(pcode, nlat, nb, nh, nqb);
        const int nld = lat ? (ATT ? 10 : 8) : 2;
        const int qpos = qb * 256 + w * 32 + c;
        const int qblk = qb * 8 + w;
        const int qrow = (lat ? M_CTX + b * 1024 : b * 256) + qpos;
        float lgf2 = 0.f, lgb2 = 0.f;
        float tf1[3] = {1.f, 1.f, 1.f}, tf8[3] = {1.f, 1.f, 1.f}, tb1[3] = {1.f, 1.f, 1.f}, tb8[3] = {1.f, 1.f, 1.f};
        if (!ATT) { lgf2 = P.lgtab[h]; lgb2 = P.lgtab[8 + h];
#pragma unroll
            for (int i = 0; i < 3; ++i) { tf1[i] = __builtin_amdgcn_exp2f(-(float)(i + 1) * lgf2); tf8[i] = __builtin_amdgcn_exp2f(-(float)(8 * (i + 1)) * lgf2);
                                          tb1[i] = __builtin_amdgcn_exp2f((float)(i + 1) * lgb2); tb8[i] = __builtin_amdgcn_exp2f((float)(8 * (i + 1)) * lgb2); } }

        f32x16 o0 = {}, o1 = {};
        float lsum = 0.f;
        for (int c2 = 0; c2 < nld; c2 += 2) {
            const bool lastp = (c2 + 2 >= nld);
            const bool ilat = lastp ? nlat : lat; const int ib = lastp ? nb : b, ih = lastp ? nh : h, ic = lastp ? 0 : c2 + 2;
            MIX_STORE(rk0, rv0, kb0, vb0);
            __syncthreads();
            MIX_ISSUE(rk0, rv0, ilat, ib, ih, ic);
            MIX_COMPUTE(kb0, vb0, c2, 0);
            MIX_STORE(rk1, rv1, kb1, vb1);
            __syncthreads();
            MIX_ISSUE(rk1, rv1, ilat, ib, ih, ic + 1);
            MIX_COMPUTE(kb1, vb1, c2 + 1, 0);
        }
        if (!ATT && lat) {
#pragma unroll
            for (int i = 0; i < NKL; ++i) { unsigned wd[4];
#pragma unroll
                for (int q = 0; q < 4; ++q) { const int d0 = kch[i] * 8 + 2 * q, rr = krow[i] & 63; wd[q] = (d0 == rr ? 0x3F80u : 0u) | (d0 + 1 == rr ? 0x3F800000u : 0u); }
                *(LAS v4u*)(kb0 + krow[i] * KSTR + kch[i] * 16) = (v4u){wd[0], wd[1], wd[2], wd[3]}; }
            const float* Sf = P.s_f0 + ((size_t)(b * 2 + P.layer) * 8 + h) * 4096; const float* Sb = P.s_b0 + ((size_t)(b * 2 + P.layer) * 8 + h) * 4096;
#pragma unroll
            for (int i = 0; i < 8; ++i) { const int e = tid + 512 * i, dk = e >> 6, dv = e & 63;
                *(LAS bf16*)(vb0 + dv * MIX_VSTR + dk * 2) = f2b(Sf[e]); *(LAS bf16*)(vb0 + dv * MIX_VSTR + (64 + dk) * 2) = f2b(Sb[e]); }
            __syncthreads();
            MIX_COMPUTE(kb0, vb0, 0, 1);
            __syncthreads();
        }
        MIX_LOADQ(qf, nlat, nb, nh, nqb);
        int lane_e = lane; asm volatile("" : "+v"(lane_e));
        const int c_e = lane_e & 31, hh_e = lane_e >> 5; const int qrow_e = (lat ? M_CTX + b * 1024 : b * 256) + qb * 256 + w * 32 + c_e;
#define MIX_ROWSWAP_STORE(colbase_) do { \
            _Pragma("unroll") for (int dvt = 0; dvt < 2; ++dvt) _Pragma("unroll") for (int k_ = 0; k_ < 4; ++k_) { auto r_ = __builtin_amdgcn_permlane16_swap(pc[dvt][0][k_], pc[dvt][1][k_], false, false); pc[dvt][0][k_] = r_[0]; pc[dvt][1][k_] = r_[1]; } \
            bf16* ob_ = P.MIX + (size_t)(qrow_e - c_e + (c_e & 15)) * 1024 + (colbase_) + 16 * (c_e >> 4) + 8 * hh_e; \
            _Pragma("unroll") for (int dvt = 0; dvt < 2; ++dvt) { \
                *(v4u*)(ob_ + 32 * dvt) = (v4u){pc[dvt][0][0], pc[dvt][0][1], pc[dvt][0][2], pc[dvt][0][3]}; \
                *(v4u*)(ob_ + (size_t)16 * 1024 + 32 * dvt) = (v4u){pc[dvt][1][0], pc[dvt][1][1], pc[dvt][1][2], pc[dvt][1][3]}; } } while (0)
        if (ATT) {
            lsum = sum32(lsum);
            const float inv = 1.0f / lsum;
            unsigned pc[2][2][4];
#pragma unroll
            for (int dvt = 0; dvt < 2; ++dvt)
#pragma unroll
                for (int g = 0; g < 4; g += 2) {
                    unsigned ax, ay, bx, by;
                    if (dvt == 0) { ax = cvtpk(o0[4 * g] * inv, o0[4 * g + 1] * inv); ay = cvtpk(o0[4 * g + 2] * inv, o0[4 * g + 3] * inv); bx = cvtpk(o0[4 * g + 4] * inv, o0[4 * g + 5] * inv); by = cvtpk(o0[4 * g + 6] * inv, o0[4 * g + 7] * inv); }
                    else          { ax = cvtpk(o1[4 * g] * inv, o1[4 * g + 1] * inv); ay = cvtpk(o1[4 * g + 2] * inv, o1[4 * g + 3] * inv); bx = cvtpk(o1[4 * g + 4] * inv, o1[4 * g + 5] * inv); by = cvtpk(o1[4 * g + 6] * inv, o1[4 * g + 7] * inv); }
                    { auto r_ = __builtin_amdgcn_permlane32_swap(ax, bx, false, false); ax = r_[0]; bx = r_[1]; }
                    { auto r_ = __builtin_amdgcn_permlane32_swap(ay, by, false, false); ay = r_[0]; by = r_[1]; }
                    pc[dvt][g >> 1][0] = ax; pc[dvt][g >> 1][1] = ay; pc[dvt][g >> 1][2] = bx; pc[dvt][g >> 1][3] = by;
                }
            MIX_ROWSWAP_STORE(512 + h * 64);
        } else {
            float sum = 0.f;
#pragma unroll
            for (int r = 0; r < 16; ++r) sum += o0[r] + o1[r];
            sum = sum32(sum);
            const float mu = sum * (1.0f / 64.0f);
            float var = 0.f;
#pragma unroll
            for (int r = 0; r < 16; ++r) { const float a = o0[r] - mu, bq = o1[r] - mu; var += a * a + bq * bq; }
            var = sum32(var);
            const float rstd = 1.0f / sqrtf(var * (1.0f / 64.0f) + EPSF);
            const int cbase = h * 64 + 4 * hh_e;
            unsigned pc[2][2][4];
            const bf16* rgp = P.RG + (size_t)qrow_e * 512 + cbase;
#pragma unroll
            for (int dvt = 0; dvt < 2; ++dvt)
#pragma unroll
                for (int g = 0; g < 4; g += 2) {
                    unsigned pk[2][2];
#pragma unroll
                    for (int gi = 0; gi < 2; ++gi) {
                        const int cc = 32 * dvt + 8 * (g + gi);
                        const f32x4 gg = *(const f32x4*)(P.g_gn + cbase + cc), bb = *(const f32x4*)(P.b_gn + cbase + cc);
                        const u32x2 rg2 = *(const u32x2*)(rgp + cc);
                        float y[4];
#pragma unroll
                        for (int i = 0; i < 4; ++i) { const float ov = dvt ? o1[4 * (g + gi) + i] : o0[4 * (g + gi) + i]; y[i] = (ov - mu) * rstd * gg[i] + bb[i]; }
                        y[0] *= b2f((unsigned short)(rg2.x & 0xffffu)); y[1] *= b2f((unsigned short)(rg2.x >> 16)); y[2] *= b2f((unsigned short)(rg2.y & 0xffffu)); y[3] *= b2f((unsigned short)(rg2.y >> 16));
                        pk[gi][0] = cvtpk(y[0], y[1]); pk[gi][1] = cvtpk(y[2], y[3]);
                    }
                    { auto r_ = __builtin_amdgcn_permlane32_swap(pk[0][0], pk[1][0], false, false); pk[0][0] = r_[0]; pk[1][0] = r_[1]; }
                    { auto r_ = __builtin_amdgcn_permlane32_swap(pk[0][1], pk[1][1], false, false); pk[0][1] = r_[0]; pk[1][1] = r_[1]; }
                    pc[dvt][g >> 1][0] = pk[0][0]; pc[dvt][g >> 1][1] = pk[0][1]; pc[dvt][g >> 1][2] = pk[1][0]; pc[dvt][g >> 1][3] = pk[1][1];
                }
            MIX_ROWSWAP_STORE(h * 64);
            if (!lat && !P.defer_states) {
                const int st = w >> 2, dkt = (w >> 1) & 1, dvt = w & 1;
                const float lg = st ? lgb2 : lgf2;
                float stj[8];
#pragma unroll
                for (int j = 0; j < 8; ++j) stj[j] = __builtin_amdgcn_exp2f((st ? (float)j : -(float)j) * lg);
                const bf16* kp = P.RKT + (size_t)(h * 64 + 32 * dkt + c_e) * M_CTX + b * 256 + 8 * hh_e;
                const bf16* vp = P.RVT + (size_t)(h * 64 + 32 * dvt + c_e) * M_TOK + b * 256 + 8 * hh_e;
                f32x16 acc = {};
                v4u kra[4], krb[4]; pg8::bf16x8 vra[4], vrb[4];
#define ST_LOAD(KR_, VR_, bt_) do { _Pragma("unroll") for (int i = 0; i < 4; ++i) { KR_[i] = *(const v4u*)(kp + 16 * (4 * (bt_) + i)); VR_[i] = *(const pg8::bf16x8*)(vp + 16 * (4 * (bt_) + i)); } } while (0)
#define ST_COMP(KR_, VR_, bt_) do { _Pragma("unroll") for (int i = 0; i < 4; ++i) { \
                    const int tok0 = 16 * (4 * (bt_) + i) + 8 * hh_e; float kv[8]; \
                    kv[0] = b2f((unsigned short)(KR_[i].x & 0xffffu)); kv[1] = b2f((unsigned short)(KR_[i].x >> 16)); kv[2] = b2f((unsigned short)(KR_[i].y & 0xffffu)); kv[3] = b2f((unsigned short)(KR_[i].y >> 16)); \
                    kv[4] = b2f((unsigned short)(KR_[i].z & 0xffffu)); kv[5] = b2f((unsigned short)(KR_[i].z >> 16)); kv[6] = b2f((unsigned short)(KR_[i].w & 0xffffu)); kv[7] = b2f((unsigned short)(KR_[i].w >> 16)); \
                    const float wb_ = __builtin_amdgcn_exp2f((st ? (float)tok0 : (float)(255 - tok0)) * lg); _Pragma("unroll") for (int j = 0; j < 8; ++j) kv[j] *= wb_ * stj[j]; \
                    const pg8::bf16x8 kfr = __builtin_bit_cast(pg8::bf16x8, pack8(kv)); \
                    acc = __builtin_amdgcn_mfma_f32_32x32x16_bf16(kfr, VR_[i], acc, 0, 0, 0); } } while (0)
                ST_LOAD(kra, vra, 0); ST_LOAD(krb, vrb, 1);
                ST_COMP(kra, vra, 0); ST_LOAD(kra, vra, 2);
                ST_COMP(krb, vrb, 1); ST_LOAD(krb, vrb, 3);
                ST_COMP(kra, vra, 2); ST_COMP(krb, vrb, 3);
#undef ST_LOAD
#undef ST_COMP
                float* so = (st ? P.out_sb : P.out_sf) + ((size_t)(b * 2 + P.layer) * 8 + h) * 4096 + 32 * dvt + c_e;
#pragma unroll
                for (int r = 0; r < 16; ++r) { const int dk = 32 * dkt + (r & 3) + 8 * (r >> 2) + 4 * hh_e; __builtin_nontemporal_store(acc[r], so + dk * 64); }
            }
        }
        code = ncode;
    }
#undef MIX_ROWSWAP_STORE
#undef MIX_DECODE
#undef MIX_KROW
#undef MIX_ISSUE
#undef MIX_STORE
#undef MIX_LOADQ
#undef MIX_DECAY
#undef MIX_COMPUTE
#undef MIX_QK
#undef MIX_EW
#undef MIX_PV
}

__device__ __forceinline__ void ret_state_job(const MixP& P, int b, int h, int w, int lane) {
    const float lgf2 = P.lgtab[h], lgb2 = P.lgtab[8 + h];
    int lane_e = lane; asm volatile("" : "+v"(lane_e));
    const int c_e = lane_e & 31, hh_e = lane_e >> 5;
    const int st = w >> 2, dkt = (w >> 1) & 1, dvt = w & 1;
    const float lg = st ? lgb2 : lgf2;
    const bf16* kp = P.RKT + (size_t)(h * 64 + 32 * dkt + c_e) * M_CTX + b * 256 + 8 * hh_e;
    const bf16* vp = P.RVT + (size_t)(h * 64 + 32 * dvt + c_e) * M_TOK + b * 256 + 8 * hh_e;
    f32x16 acc = {};
#pragma nounroll
    for (int bt = 0; bt < 4; ++bt) {
        v4u kr[4]; pg8::bf16x8 vr[4];
#pragma unroll
        for (int i = 0; i < 4; ++i) { kr[i] = *(const v4u*)(kp + 16 * (4 * bt + i)); vr[i] = *(const pg8::bf16x8*)(vp + 16 * (4 * bt + i)); }
#pragma unroll
        for (int i = 0; i < 4; ++i) {
            const int tok0 = 16 * (4 * bt + i) + 8 * hh_e; float kv[8];
            kv[0] = b2f((unsigned short)(kr[i].x & 0xffffu)); kv[1] = b2f((unsigned short)(kr[i].x >> 16)); kv[2] = b2f((unsigned short)(kr[i].y & 0xffffu)); kv[3] = b2f((unsigned short)(kr[i].y >> 16));
            kv[4] = b2f((unsigned short)(kr[i].z & 0xffffu)); kv[5] = b2f((unsigned short)(kr[i].z >> 16)); kv[6] = b2f((unsigned short)(kr[i].w & 0xffffu)); kv[7] = b2f((unsigned short)(kr[i].w >> 16));
#pragma unroll
            for (int j = 0; j < 8; ++j) kv[j] *= __builtin_amdgcn_exp2f((st ? (float)(tok0 + j) : (float)(255 - tok0 - j)) * lg);
            const pg8::bf16x8 kfr = __builtin_bit_cast(pg8::bf16x8, pack8(kv));
            acc = __builtin_amdgcn_mfma_f32_32x32x16_bf16(kfr, vr[i], acc, 0, 0, 0);
        }
    }
    float* so = (st ? P.out_sb : P.out_sf) + ((size_t)(b * 2 + P.layer) * 8 + h) * 4096 + 32 * dvt + c_e;
#pragma unroll
    for (int r = 0; r < 16; ++r) { const int dk = 32 * dkt + (r & 3) + 8 * (r >> 2) + 4 * hh_e; __builtin_nontemporal_store(acc[r], so + dk * 64); }
}

__device__ __forceinline__ void mix_phase(Frame& F, const MixP& P) {
    mix_run<false>(P, F.lds, F.bx, F.G, F.tid);
    __syncthreads();
    mix_run<true>(P, F.lds, F.bx, F.G, F.tid);
}

__global__ void __launch_bounds__(NWAVES * 64, 2) mk_fwd(Params P) {
    extern __shared__ __attribute__((aligned(16))) unsigned char lds_raw[];
    Frame F;
    F.lds = (LAS unsigned char*)lds_raw;
    F.MISC = (volatile LAS unsigned*)(F.lds + MISC_OFF);
    F.wave = __builtin_amdgcn_readfirstlane((int)threadIdx.x >> 6); frame_refresh(F);
    F.G = gridDim.x; F.bx = blockIdx.x;
    unsigned char* ws = P.ws;
    F.ctl = (gu32*)(ws + WS_CTL);
    for (int u = F.tid; u < (LDS_BYTES - LDSCTL_OFF) / 4; u += NWAVES * 64) ((LAS unsigned*)(F.lds + LDSCTL_OFF))[u] = 0u;
    __syncthreads();
    XcdBarrier bar; bar.bar = (unsigned*)(F.ctl + CW_BAR); bar.x = 0; bar.st = nullptr;
    if (!MK_PER_PHASE) bar = xcd_barrier_post((unsigned*)(F.ctl + CW_BAR), F.MISC + 8, F.tid);
    const int lo = P.ph_lo, hi = P.ph_hi;
#define IN(k) (lo <= (k) && (k) < hi)
#define SEAM(k) do { if (IN(k) && IN((k) + 1)) { xcd_barrier(bar, fresh_tid(F.wave)); if (REPS(15) > 1) xcd_barrier(bar, fresh_tid(F.wave)); } } while (0)

    if (PH_EN(0) && IN(0)) { for (int rep = 0; rep < REPS(0); ++rep) { frame_refresh(F); p0_prologue(F, P); if (rep + 1 < REPS(0)) xcd_barrier(bar, fresh_tid(F.wave)); } SEAM(0); }

    const float2* tab64 = (const float2*)(ws + WS_TAB); const float2* tab32 = tab64 + 64 * 16;
    for (int l = 0; l < 2; ++l) {
        const int pb = 1 + 8 * l;
        const bool chain = F.G == 256 && !MK_PER_PHASE;
        unsigned char* wl = ws + WS_W + (size_t)l * LAYER_W;
        const float* mod = (const float*)(ws + WS_MOD) + (size_t)l * 3 * 6144;
        float* const ssb = (float*)(F.ctl + CW_SS);
        float* sskv = ssb + (size_t)(l * 2 + 1) * M_TOK;
        const float* bias = (const float*)(ws + WS_BIAS) + (size_t)l * 3 * BIAS_LD;
        if (l == 0 && PH_EN(1) && IN(pb + 0)) { for (int rep = 0; rep < REPS(1); ++rep) { frame_refresh(F); norm_phase(F, P, 0, 0); cache_rows_job(F, P, 0); if (F.G < 64) bias_job(F, P, F.bx * NWAVES + F.wave, F.G * NWAVES); if (rep + 1 < REPS(1)) xcd_barrier(bar, fresh_tid(F.wave)); } SEAM(pb + 0); }
        if (PH_EN(2) && IN(pb + 1)) {
            unsigned long long zz_ = 0ull; asm volatile("" : "+s"(zz_)); unsigned char* const ws = P.ws + zz_; (void)ws;
            unsigned char* const wl = ws + WS_W + (size_t)l * LAYER_W; (void)wl; const float* const mod = (const float*)(ws + WS_MOD) + (size_t)l * 3 * 6144; (void)mod;
            const float* const bias = (const float*)(ws + WS_BIAS) + (size_t)l * 3 * BIAS_LD; (void)bias; float* const ssb = (float*)(F.ctl + CW_SS); (void)ssb; float* const sskv = ssb + (size_t)(l * 2 + 1) * M_TOK; (void)sskv;
            {
                pg8::Gemm g{(const pg8::bf16_t*)(ws + WS_H), (const pg8::bf16_t*)(wl + W_IN_OFF), M_TOK, N_IN, 1024}; WinOrder S; S.init(M_TOK, N_IN, F.G, F.bx); S.sp = chain;
                EpiG1 E{ws, {P.in[13] + l * 256, P.in[15] + l * 128, P.in[20] + l * 32}, P.out, l, 0, l == 0 ? -1 : 5, chain ? (LAS float*)(F.lds + LDSCTL_OFF + 8192) : (LAS float*)nullptr};
                pg8::gemm_phase<EpiG1, WinOrder, true, true>(F.lds + RING_OFF, g, S, E, fresh_tid(F.wave));
            }
            if (chain) {
                frame_refresh(F);
                const int xk = F.bx >> 3, xx = F.bx & 7;
                if (xk < 10) {
                    const int cpm = 39 - (5 * xx + (xk >> 1));
                    if (F.tid < 256) { const LAS float* lp = (const LAS float*)(F.lds + LDSCTL_OFF + 8192) + F.tid;
                        (((xk & 1) == 0) ? ssb + (size_t)(l * 2) * M_TOK : sskv)[cpm * 256 + F.tid] = (lp[0] + lp[256]) + (lp[512] + lp[768]); }
                    asm volatile("s_waitcnt vmcnt(0)" ::: "memory"); __syncthreads();
                    __builtin_amdgcn_fence(__ATOMIC_ACQUIRE, "agent");
                    if ((xk & 1) == 0) {
                        pg8::Gemm g{(const pg8::bf16_t*)(ws + WS_QA), (const pg8::bf16_t*)(wl + W_QB_OFF), M_TOK, N_Q, 256}; QOrder S; S.init(M_TOK, N_Q, F.G, F.bx); S.cpm = cpm;
                        EpiQ E{ws, P.in[17] + l * 64, P.in[18] + l * 32, l};
                        pg8::gemm_phase<EpiQ, QOrder, true, true>(F.lds + RING_OFF, g, S, E, fresh_tid(F.wave));
                    } else {
                        pg8::Gemm g{(const pg8::bf16_t*)(ws + WS_KVA), (const pg8::bf16_t*)(wl + W_KVB_OFF), M_KV, N_KV, 256}; KvOrder S; S.init(M_KV, N_KV, F.G, F.bx); S.cpm = cpm; S.cn0 = 0; S.cn1 = 4;
                        EpiKV E{ws, P.in[19] + l * 64, l};
                        pg8::gemm_phase<EpiKV, KvOrder, true, true>(F.lds + RING_OFF, g, S, E, fresh_tid(F.wave));
                        if (cpm < 32) {
                            frame_refresh(F); const bf16* KVA = (const bf16*)(ws + WS_KVA);
                            for (int m = cpm * 256 + F.wave; m < cpm * 256 + 256; m += NWAVES) {
                                const float rstd = 1.0f / sqrtf(sskv[m] * (1.0f / 128.0f) + EPSF);
                                const unsigned pk = *((const unsigned*)(KVA + (size_t)m * 256) + F.lane);
                                float* o = P.out + OUT_CKV + ((size_t)((m >> 8) * 2 + l) * 256 + (m & 255)) * 128 + 2 * F.lane;
                                __builtin_nontemporal_store((f32x2_t){b2f((unsigned short)(pk & 0xffffu)) * rstd, b2f((unsigned short)(pk >> 16)) * rstd}, (f32x2_t*)o);
                            }
                        }
                    }
                } else if (xk >= 28) {
                    if (xk == 28) {
                        pg8::Gemm g{(const pg8::bf16_t*)(ws + WS_KVA), (const pg8::bf16_t*)(wl + W_KVB_OFF), M_KV, N_KV, 256}; KvOrder S; S.init(M_KV, N_KV, F.G, F.bx); S.cpm = 40 + (xx >> 2); S.cn0 = xx & 3; S.cn1 = S.cn0 + 1;
                        EpiKV E{ws, P.in[19] + l * 64, l};
                        pg8::gemm_phase<EpiKV, KvOrder, true, true>(F.lds + RING_OFF, g, S, E, fresh_tid(F.wave));
                    }
                }
                SEAM(pb + 2);
            } else SEAM(pb + 1);
        }
        if (PH_EN(3) && IN(pb + 2) && !chain) {
            unsigned long long zz_ = 0ull; asm volatile("" : "+s"(zz_)); unsigned char* const ws = P.ws + zz_; (void)ws;
            unsigned char* const wl = ws + WS_W + (size_t)l * LAYER_W; (void)wl; const float* const mod = (const float*)(ws + WS_MOD) + (size_t)l * 3 * 6144; (void)mod;
            const float* const bias = (const float*)(ws + WS_BIAS) + (size_t)l * 3 * BIAS_LD; (void)bias; float* const ssb = (float*)(F.ctl + CW_SS); (void)ssb; float* const sskv = ssb + (size_t)(l * 2 + 1) * M_TOK; (void)sskv;
            {
                pg8::Gemm g{(const pg8::bf16_t*)(ws + WS_QA), (const pg8::bf16_t*)(wl + W_QB_OFF), M_TOK, N_Q, 256}; QOrder S; S.init(M_TOK, N_Q, F.G, F.bx); S.cpm = -1;
                EpiQ E{ws, P.in[17] + l * 64, P.in[18] + l * 32, l};
                pg8::gemm_phase<EpiQ, QOrder, true, true>(F.lds + RING_OFF, g, S, E, fresh_tid(F.wave));
            }
            {
                pg8::Gemm g{(const pg8::bf16_t*)(ws + WS_KVA), (const pg8::bf16_t*)(wl + W_KVB_OFF), M_KV, N_KV, 256}; KvOrder S; S.init(M_KV, N_KV, F.G, F.G == 256 ? F.bx : (F.bx + 136) % F.G); S.cpm = -1; S.cn0 = 0; S.cn1 = 0;
                EpiKV E{ws, P.in[19] + l * 64, l};
                pg8::gemm_phase<EpiKV, KvOrder, true, true>(F.lds + RING_OFF, g, S, E, fresh_tid(F.wave));
            }
            {
                frame_refresh(F); const bool sl = F.G == 256;
                const int gw = (sl ? F.bx - 152 : F.bx) * NWAVES + F.wave, NGW = (sl ? 104 : F.G) * NWAVES;
                const bf16* KVA = (const bf16*)(ws + WS_KVA);
                for (int m = gw < 0 ? M_CTX : gw; m < M_CTX; m += NGW) {
                    const float rstd = 1.0f / sqrtf(sskv[m] * (1.0f / 128.0f) + EPSF);
                    const unsigned pk = *((const unsigned*)(KVA + (size_t)m * 256) + F.lane);
                    float* o = P.out + OUT_CKV + ((size_t)((m >> 8) * 2 + l) * 256 + (m & 255)) * 128 + 2 * F.lane;
                    __builtin_nontemporal_store((f32x2_t){b2f((unsigned short)(pk & 0xffffu)) * rstd, b2f((unsigned short)(pk >> 16)) * rstd}, (f32x2_t*)o);
                }
            }
            if (l == 0 && F.G >= 256) { frame_refresh(F); if (F.bx < 120 || F.bx >= 152) bias_job(F, P, (F.bx < 120 ? F.bx : F.bx - 32) * NWAVES + F.wave, (F.G - 32) * NWAVES); }
            else if (l == 0) { frame_refresh(F); bias_job(F, P, F.bx * NWAVES + F.wave, F.G * NWAVES); }
            SEAM(pb + 2);
        }
        if (PH_EN(4) && IN(pb + 3)) {
            unsigned long long zz_ = 0ull; asm volatile("" : "+s"(zz_)); unsigned char* const ws = P.ws + zz_; (void)ws;
            unsigned char* const wl = ws + WS_W + (size_t)l * LAYER_W; (void)wl; const float* const mod = (const float*)(ws + WS_MOD) + (size_t)l * 3 * 6144; (void)mod;
            const float* const bias = (const float*)(ws + WS_BIAS) + (size_t)l * 3 * BIAS_LD; (void)bias; float* const ssb = (float*)(F.ctl + CW_SS); (void)ssb; float* const sskv = ssb + (size_t)(l * 2 + 1) * M_TOK; (void)sskv;
            MixP MP{(const bf16*)(ws + WS_Q), (const bf16*)(ws + WS_KN), (const bf16*)(ws + WS_KR), (const bf16*)(ws + WS_VT), (const bf16*)(ws + WS_RQ), (const bf16*)(ws + WS_RK),
                    (const bf16*)(ws + WS_RKT), (const bf16*)(ws + WS_RVT), (const bf16*)(ws + WS_RG), (bf16*)(ws + WS_MIX), P.in[4], P.in[5], P.in[21] + l * 8, P.in[22] + l * 8,
                    P.in[23] + l * 512, P.in[24] + l * 512, P.out + OUT_SF, P.out + OUT_SB, l, (const float*)(ws + WS_TAB + 16384) + l * 16, (chain && MIX_DEFER) ? 1 : 0};
            for (int rep = 0; rep < REPS(4); ++rep) { frame_refresh(F); mix_phase(F, MP); if (rep + 1 < REPS(4)) xcd_barrier(bar, fresh_tid(F.wave)); }
            SEAM(pb + 3);
        }
        if (PH_EN(5) && IN(pb + 4)) {
            unsigned long long zz_ = 0ull; asm volatile("" : "+s"(zz_)); unsigned char* const ws = P.ws + zz_; (void)ws;
            unsigned char* const wl = ws + WS_W + (size_t)l * LAYER_W; (void)wl; const float* const mod = (const float*)(ws + WS_MOD) + (size_t)l * 3 * 6144; (void)mod;
            const float* const bias = (const float*)(ws + WS_BIAS) + (size_t)l * 3 * BIAS_LD; (void)bias; float* const ssb = (float*)(F.ctl + CW_SS); (void)ssb; float* const sskv = ssb + (size_t)(l * 2 + 1) * M_TOK; (void)sskv;
            pg8::Gemm g{(const pg8::bf16_t*)(ws + WS_MIX), (const pg8::bf16_t*)(wl + W_O_OFF), M_TOK, 1024, 1024}; PanelOrder S; S.init(M_TOK, 1024, F.G, F.bx);
            if (l == 0) { EpiResW<false, true> E{P.in[0], P.in[1], P.out, mod + 2 * 1024, (bf16*)(ws + WS_H), P.in[11] + l * 1024, mod + 4 * 1024, ssb + (size_t)4 * M_TOK, 0, (bf16*)(ws + WS_Q), nullptr};
                pg8::gemm_phase<EpiResW<false, true>, PanelOrder, true, true>(F.lds + RING_OFF, g, S, E, fresh_tid(F.wave)); }
            else { EpiResW<true, true> E{nullptr, nullptr, P.out, mod + 2 * 1024, (bf16*)(ws + WS_H), P.in[11] + l * 1024, mod + 4 * 1024, ssb + (size_t)6 * M_TOK, 0, (bf16*)(ws + WS_Q), (const bf16*)P.out};
                pg8::gemm_phase<EpiResW<true, true>, PanelOrder, true, true>(F.lds + RING_OFF, g, S, E, fresh_tid(F.wave)); }
            if (l == 0 && chain) { frame_refresh(F); if (F.bx >= 160) bias_job(F, P, (F.bx - 160) * NWAVES + F.wave, 96 * NWAVES); }
            SEAM(pb + 4);
        }
        if (PH_EN(7) && IN(pb + 6)) {
            unsigned long long zz_ = 0ull; asm volatile("" : "+s"(zz_)); unsigned char* const ws = P.ws + zz_; (void)ws;
            unsigned char* const wl = ws + WS_W + (size_t)l * LAYER_W; (void)wl; const float* const mod = (const float*)(ws + WS_MOD) + (size_t)l * 3 * 6144; (void)mod;
            const float* const bias = (const float*)(ws + WS_BIAS) + (size_t)l * 3 * BIAS_LD; (void)bias; float* const ssb = (float*)(F.ctl + CW_SS); (void)ssb; float* const sskv = ssb + (size_t)(l * 2 + 1) * M_TOK; (void)sskv;
            if (chain && MIX_DEFER && F.bx >= 112) {
                frame_refresh(F);
                unsigned long long zs_ = 0ull; asm volatile("" : "+s"(zs_)); unsigned char* const wsx = ws + zs_; float* const outx = P.out + zs_;
                MixP SP{nullptr, nullptr, nullptr, nullptr, nullptr, nullptr, (const bf16*)(wsx + WS_RKT), (const bf16*)(wsx + WS_RVT), nullptr, nullptr, nullptr, nullptr, nullptr, nullptr,
                        nullptr, nullptr, outx + OUT_SF, outx + OUT_SB, l, (const float*)(wsx + WS_TAB + 16384) + l * 16, 1};
                for (int uu = F.bx - 112; uu < 256; uu += 144) ret_state_job(SP, uu >> 3, uu & 7, F.wave, F.lane);
            }
            pg8::Gemm g{(const pg8::bf16_t*)(ws + WS_H), (const pg8::bf16_t*)(wl + W_FI_OFF), M_TOK, N_FI, 1024}; pg8::StaticOrder S; S.init(M_TOK, N_FI, F.G, F.bx);
            EpiFfn E{(bf16*)(ws + WS_ACT), ssb + (size_t)(l == 0 ? 4 : 6) * M_TOK, bias + 2560};
            for (int rep = 0; rep < REPS(7); ++rep) { pg8::gemm_phase<EpiFfn, pg8::StaticOrder, true, true>(F.lds + RING_OFF, g, S, E, fresh_tid(F.wave)); if (rep + 1 < REPS(7)) xcd_barrier(bar, fresh_tid(F.wave)); }
            SEAM(pb + 6);
        }
        if (PH_EN(8) && IN(pb + 7)) {
            unsigned long long zz_ = 0ull; asm volatile("" : "+s"(zz_)); unsigned char* const ws = P.ws + zz_; (void)ws;
            unsigned char* const wl = ws + WS_W + (size_t)l * LAYER_W; (void)wl; const float* const mod = (const float*)(ws + WS_MOD) + (size_t)l * 3 * 6144; (void)mod;
            const float* const bias = (const float*)(ws + WS_BIAS) + (size_t)l * 3 * BIAS_LD; (void)bias; float* const ssb = (float*)(F.ctl + CW_SS); (void)ssb; float* const sskv = ssb + (size_t)(l * 2 + 1) * M_TOK; (void)sskv;
            pg8::Gemm g{(const pg8::bf16_t*)(ws + WS_ACT), (const pg8::bf16_t*)(wl + W_FO_OFF), M_TOK, 1024, D_FFN}; SplitOrder<FO_NMAIN, D_FFN / 64> S; S.init(M_TOK, 1024, F.G, F.bx);
            S.slab = (float*)(ws + WS_RQ); S.flags = (unsigned*)(F.ctl + CW_SPLIT); S.epoch = (unsigned)(pb + 8);
            if (l == 0) { EpiResW<true, true> E{nullptr, nullptr, P.out, mod + 5 * 1024, (bf16*)(ws + WS_H), P.in[10] + 1024, (const float*)(ws + WS_MOD) + (size_t)3 * 6144 + 1 * 1024, ssb + (size_t)5 * M_TOK, 0, (bf16*)P.out, (const bf16*)(ws + WS_Q)};
                pg8::gemm_phase<EpiResW<true, true>, SplitOrder<FO_NMAIN, D_FFN / 64>, true, true>(F.lds + RING_OFF, g, S, E, fresh_tid(F.wave)); }
            else { EpiResW<true, false> E{nullptr, nullptr, P.out, mod + 5 * 1024, (bf16*)(ws + WS_H), nullptr, (const float*)(ws + WS_MOD) + (size_t)3 * 6144 + 1 * 1024, ssb + (size_t)5 * M_TOK, 1, nullptr, (const bf16*)(ws + WS_Q)};
                pg8::gemm_phase<EpiResW<true, false>, SplitOrder<FO_NMAIN, D_FFN / 64>, true, true>(F.lds + RING_OFF, g, S, E, fresh_tid(F.wave)); }
            if (l == 0) { frame_refresh(F); cache_rows_job(F, P, 1); SEAM(pb + 7); }
        }
    }
#undef IN
#undef SEAM
}

extern "C" void kernel_launch(void* const* d_in, const int* in_sizes, int n_in, void* d_out, int out_size, void* d_ws, size_t ws_size, hipStream_t stream) {
    static int grid = 0;
    if (grid == 0) {
        if (n_in != 28 || out_size != (int)OUT_TOTAL || ws_size < WS_END) { fprintf(stderr, "kernel_launch: unexpected shapes (n_in %d, out %d, ws %zu); nothing launched\n", n_in, out_size, ws_size); grid = -1; return; }
        int dev = 0, cus = 0, per_cu = 0;
        if (hipGetDevice(&dev) != hipSuccess || hipDeviceGetAttribute(&cus, hipDeviceAttributeMultiprocessorCount, dev) != hipSuccess) { grid = -1; return; }
        if (hipFuncSetAttribute((const void*)mk_fwd, hipFuncAttributeMaxDynamicSharedMemorySize, LDS_BYTES) != hipSuccess) { fprintf(stderr, "kernel_launch: hipFuncSetAttribute failed\n"); grid = -1; return; }
        if (hipOccupancyMaxActiveBlocksPerMultiprocessor(&per_cu, (const void*)mk_fwd, NWAVES * 64, LDS_BYTES) != hipSuccess || per_cu < 1) { fprintf(stderr, "kernel_launch: occupancy query reports %d blocks per CU\n", per_cu); }
        (void)hipGetLastError();
        grid = cus;
    }
    if (grid < 0) return;
    if (hipMemsetAsync((char*)d_ws + WS_CTL, 0, CTL_ZERO_BYTES, stream) != hipSuccess) { fprintf(stderr, "kernel_launch: memset failed\n"); return; }
    Params p{};
    for (int i = 0; i < 28; ++i) p.in[i] = (const float*)d_in[i];
    p.out = (float*)d_out; p.ws = (unsigned char*)d_ws;
#if MK_PER_PHASE
    for (int ph = 0; ph < N_PHASES; ++ph) { p.ph_lo = ph; p.ph_hi = ph + 1; hipLaunchKernelGGL(mk_fwd, dim3(grid), dim3(NWAVES * 64), LDS_BYTES, stream, p); }
#else
    p.ph_lo = 0; p.ph_hi = N_PHASES;
    hipLaunchKernelGGL(mk_fwd, dim3(grid), dim3(NWAVES * 64), LDS_BYTES, stream, p);
#endif
    const hipError_t le = hipPeekAtLastError();
    if (le != hipSuccess) fprintf(stderr, "kernel_launch: launch failed: %s\n", hipGetErrorName(le));
}
```

```cpp
#include <hip/hip_runtime.h>
#include <cstdio>
#include <cstdint>
namespace pg8 {
#define PG8_LAS __attribute__((address_space(3)))
typedef unsigned short bf16_t;
typedef short bf16x8 __attribute__((ext_vector_type(8)));
typedef float f32x4 __attribute__((ext_vector_type(4)));
typedef unsigned u32x4 __attribute__((ext_vector_type(4)));
constexpr int BM = 256, BK = 64, HALF = 128, HTB = HALF * BK * 2  , STAGE_BYTES = 8 * HTB, NXCD = 8, WGM = 8;

__host__ __device__ __forceinline__ int lds_byte(int r, int c) { const int st = (r >> 4) * 2 + (c >> 5), rr = r & 15, cc = c & 31, ob = rr * 64 + cc * 2; return st * 1024 + (ob ^ (((ob >> 9) & 1) << 5)); }
__host__ __device__ __forceinline__ void stage_rc(int b, int& R, int& C) { const int st = b / 1024, sb = b % 1024, swz = sb ^ (((sb >> 9) & 1) << 5); R = (st >> 1) * 16 + swz / 64; C = (st & 1) * 32 + (swz % 64) / 2; }
__host__ __device__ __forceinline__ int perm32(int rho) { const int n = rho >> 4, i = rho & 15; return 8 * (i >> 2) + 4 * n + (i & 3); }

struct Unit { int pm, pn, k0, nkt, role, slab, src2; };
struct Gemm { const bf16_t* A; const bf16_t* Bt; int M, N, K; };

struct StaticOrder {
    int nM, nN, nwg, G, c;
    __host__ __device__ void init(int M, int N, int G_, int c_) { nM = M / BM; nN = N / BM; nwg = nM * nN; G = G_; c = c_; }
    static constexpr bool SPLITK = false, HANDOFF = false;
    __host__ __device__ __forceinline__ bool next(int i, Unit& u) const {
        const long L = (long)i * G + c; if (L >= nwg) return false;
        map((int)L, u); return true;
    }
    __host__ __device__ __forceinline__ void map(int L, Unit& u) const {
        int wgid = L; { const int q = nwg / NXCD, r = nwg % NXCD, xcd = wgid % NXCD, off = wgid / NXCD; wgid = (xcd < r ? xcd * (q + 1) : r * (q + 1) + (xcd - r) * q) + off; }
        map2(wgid, u);
    }
    __host__ __device__ __forceinline__ void map2(int wgid, Unit& u) const {
        const int nig = WGM * nN, gid = wgid / nig, fm = gid * WGM, gsz = (nM - fm) < WGM ? (nM - fm) : WGM;
        u.pm = fm + ((wgid % nig) % gsz); u.pn = (wgid % nig) / gsz;
    }
    __device__ __forceinline__ void a_ready(const Unit&) const {}
    __device__ __forceinline__ void done(const Unit&) const {}
};

__device__ __forceinline__ unsigned cvt_pk_bf16(float lo, float hi) { unsigned r; asm volatile("v_cvt_pk_bf16_f32 %0, %1, %2" : "=v"(r) : "v"(lo), "v"(hi)); return r; }
template <class Epi, class Sched, bool ALIGN_EPI = false, bool SP2 = false>
__device__ __forceinline__ void gemm_phase(PG8_LAS unsigned char* lds, const Gemm g, const Sched& S, const Epi& E, int tid_) {
    const int tid = tid_, wid = __builtin_amdgcn_readfirstlane(tid >> 6), lane = tid & 63, wr = wid >> 2, wc = wid & 3, fr = lane & 15, fq = lane >> 4;
    int K_ = g.K; asm volatile("" : "+s"(K_));
    const int K = K_; int nt = K / BK;
    unsigned voffA[2], voffB[2];
#pragma unroll
    for (int i = 0; i < 2; ++i) { int R, C; stage_rc(tid * 16 + i * 8192, R, C); const int Rb = Epi::PERM ? ((R & ~31) + perm32(R & 31)) : R;
        voffA[i] = (unsigned)(R * K + C) * 2u; voffB[i] = (unsigned)(Rb * K + C) * 2u; }
    const size_t kstep = (size_t)(BK * 2);
    const size_t hstep = (size_t)HALF * K * 2;
    const size_t tstep = 2 * hstep;
    const unsigned ldsw = (unsigned)wid * 1024u;
    const int aoff = lds_byte(wr * 64 + fr, fq * 8), boff = lds_byte(wc * 32 + fr, fq * 8);
#define PG8_SA(b, h) (((b) * 2 + (h)) * HTB)
#define PG8_SB(b, h) ((4 + (b) * 2 + (h)) * HTB)
#define PG8_STAGE(bufoff, gbase, voff) do { _Pragma("unroll") for (int _i = 0; _i < 2; ++_i) \
        __builtin_amdgcn_global_load_lds((const unsigned*)((const char*)(gbase) + (voff)[_i]), (PG8_LAS unsigned*)(lds + (bufoff) + ldsw + _i * 8192), 16, 0, 0); } while (0)
#define PG8_LDA(dst, b, h) do { _Pragma("unroll") for (int m = 0; m < 4; ++m) _Pragma("unroll") for (int k = 0; k < 2; ++k) dst[m][k] = *(const PG8_LAS bf16x8*)(lds + PG8_SA(b, h) + aoff + m * 2048 + k * 1024); } while (0)
#define PG8_LDB(dst, b, h) do { _Pragma("unroll") for (int n = 0; n < 2; ++n) _Pragma("unroll") for (int k = 0; k < 2; ++k) dst[n][k] = *(const PG8_LAS bf16x8*)(lds + PG8_SB(b, h) + boff + n * 2048 + k * 1024); } while (0)
#define PG8_MMA(ai, bj, At, Bt) do { __builtin_amdgcn_s_setprio(1); _Pragma("unroll") for (int m = 0; m < 4; ++m) _Pragma("unroll") for (int n = 0; n < 2; ++n) _Pragma("unroll") for (int k = 0; k < 2; ++k) \
        acc[ai][bj][m][n] = __builtin_amdgcn_mfma_f32_16x16x32_bf16(Bt[n][k], At[m][k], acc[ai][bj][m][n], 0, 0, 0); __builtin_amdgcn_s_setprio(0); } while (0)
#define PG8_WAIT_V(n) asm volatile("s_waitcnt vmcnt(" #n ")" ::: "memory")
#define PG8_WAIT_L(n) asm volatile("s_waitcnt lgkmcnt(" #n ")" ::: "memory")
#define PG8_BAR __builtin_amdgcn_s_barrier()
#define PG8_SCHED __builtin_amdgcn_sched_barrier(0)
    Unit cur, nxt; int ui = 0;
    if (!S.next(0, cur)) return;
    f32x4 acc[2][2][4][2];
#pragma unroll
    for (int a = 0; a < 2; ++a)
#pragma unroll
        for (int b = 0; b < 2; ++b)
#pragma unroll
            for (int m = 0; m < 4; ++m)
#pragma unroll
                for (int n = 0; n < 2; ++n) acc[a][b][m][n] = (f32x4){0.f, 0.f, 0.f, 0.f};
    bf16x8 At[4][2], B0[2][2], B1[2][2];
    const char* cA = (const char*)g.A + (size_t)cur.pm * tstep; const char* cB = (const char*)g.Bt + (size_t)cur.pn * tstep;
    if constexpr (Sched::SPLITK) { nt = cur.nkt; cA += (size_t)cur.k0 * kstep; cB += (size_t)cur.k0 * kstep; }
    S.a_ready(cur);
    if constexpr (SP2) {
        PG8_STAGE(PG8_SB(0, 0), cB, voffB); PG8_STAGE(PG8_SB(0, 1), cB + hstep, voffB); PG8_STAGE(PG8_SA(0, 0), cA, voffA); PG8_STAGE(PG8_SA(0, 1), cA + hstep, voffA);
        if (wr == 1) PG8_BAR;
        PG8_WAIT_V(2); PG8_BAR;
        PG8_STAGE(PG8_SB(1, 0), cB + kstep, voffB); PG8_STAGE(PG8_SA(1, 0), cA + kstep, voffA); PG8_STAGE(PG8_SB(1, 1), cB + hstep + kstep, voffB);
        PG8_WAIT_V(6); PG8_BAR;
    } else {
        PG8_STAGE(PG8_SB(0, 0), cB, voffB); PG8_STAGE(PG8_SA(0, 0), cA, voffA); PG8_STAGE(PG8_SB(0, 1), cB + hstep, voffB); PG8_STAGE(PG8_SA(0, 1), cA + hstep, voffA);
        if (wr == 1) PG8_BAR;
        PG8_WAIT_V(4); PG8_BAR;
        PG8_STAGE(PG8_SB(1, 0), cB + kstep, voffB); PG8_STAGE(PG8_SA(1, 0), cA + kstep, voffA); PG8_STAGE(PG8_SB(1, 1), cB + hstep + kstep, voffB);
        PG8_WAIT_V(6); PG8_BAR;
    }
    for (;;) {
        const bool has_next = S.next(ui + 1, nxt);
        const char* nA = has_next ? (const char*)g.A + (size_t)nxt.pm * tstep : cA; const char* nB = has_next ? (const char*)g.Bt + (size_t)nxt.pn * tstep : cB;
        if constexpr (Sched::SPLITK) { if (has_next) { nA += (size_t)nxt.k0 * kstep; nB += (size_t)nxt.k0 * kstep; } }
        for (int t = 0; t < nt; t += 2) {
            const bool last = (t == nt - 2);
            const char* a1 = cA + (size_t)(t + 1) * kstep;
            const char* a2 = last ? nA : cA + (size_t)(t + 2) * kstep; const char* b2 = last ? nB : cB + (size_t)(t + 2) * kstep;
            const char* a3 = a2 + kstep; const char* b3 = b2 + kstep;
            if (last && has_next) S.a_ready(nxt);
            if constexpr (SP2) {
            PG8_LDB(B0, 0, 0); PG8_LDB(B1, 0, 1); PG8_SCHED; PG8_LDA(At, 0, 0); PG8_STAGE(PG8_SA(1, 1), a1 + hstep, voffA);
            PG8_WAIT_V(8); PG8_WAIT_L(0); PG8_BAR; PG8_MMA(0, 0, At, B0); PG8_MMA(0, 1, At, B1); PG8_BAR; PG8_SCHED;
            PG8_LDA(At, 0, 1); PG8_STAGE(PG8_SB(0, 0), b2, voffB); PG8_STAGE(PG8_SB(0, 1), b2 + hstep, voffB); PG8_STAGE(PG8_SA(0, 0), a2, voffA);
            PG8_WAIT_V(8); PG8_WAIT_L(0); PG8_BAR; PG8_MMA(1, 0, At, B0); PG8_MMA(1, 1, At, B1); PG8_BAR; PG8_SCHED;
            PG8_LDB(B0, 1, 0); PG8_LDB(B1, 1, 1); PG8_SCHED; PG8_LDA(At, 1, 0); PG8_STAGE(PG8_SA(0, 1), a2 + hstep, voffA);
            PG8_WAIT_V(8); PG8_WAIT_L(0); PG8_BAR; PG8_MMA(0, 0, At, B0); PG8_MMA(0, 1, At, B1); PG8_BAR; PG8_SCHED;
            PG8_LDA(At, 1, 1); PG8_STAGE(PG8_SB(1, 0), b3, voffB); PG8_STAGE(PG8_SB(1, 1), b3 + hstep, voffB); PG8_STAGE(PG8_SA(1, 0), a3, voffA);
            PG8_WAIT_V(8); PG8_WAIT_L(0); PG8_BAR; PG8_MMA(1, 0, At, B0); PG8_MMA(1, 1, At, B1); PG8_BAR; PG8_SCHED;
            } else {
            PG8_LDB(B0, 0, 0); PG8_SCHED; PG8_LDA(At, 0, 0); PG8_STAGE(PG8_SA(1, 1), a1 + hstep, voffA);
            PG8_WAIT_L(8); PG8_BAR; PG8_WAIT_L(0); PG8_MMA(0, 0, At, B0); PG8_BAR; PG8_SCHED;
            PG8_LDB(B1, 0, 1); PG8_STAGE(PG8_SB(0, 0), b2, voffB);
            PG8_BAR; PG8_WAIT_L(0); PG8_MMA(0, 1, At, B1); PG8_BAR;
            PG8_LDA(At, 0, 1); PG8_STAGE(PG8_SA(0, 0), a2, voffA);
            PG8_BAR; PG8_WAIT_L(0); PG8_MMA(1, 0, At, B0); PG8_BAR; PG8_SCHED;
            PG8_STAGE(PG8_SB(0, 1), b2 + hstep, voffB);
            PG8_WAIT_V(6); PG8_BAR; PG8_MMA(1, 1, At, B1); PG8_BAR;
            PG8_LDB(B0, 1, 0); PG8_SCHED; PG8_LDA(At, 1, 0); PG8_STAGE(PG8_SA(0, 1), a2 + hstep, voffA);
            PG8_WAIT_L(8); PG8_BAR; PG8_WAIT_L(0); PG8_MMA(0, 0, At, B0); PG8_BAR; PG8_SCHED;
            PG8_LDB(B1, 1, 1); PG8_STAGE(PG8_SB(1, 0), b3, voffB);
            PG8_BAR; PG8_WAIT_L(0); PG8_MMA(0, 1, At, B1); PG8_BAR;
            PG8_LDA(At, 1, 1); PG8_STAGE(PG8_SA(1, 0), a3, voffA);
            PG8_BAR; PG8_WAIT_L(0); PG8_MMA(1, 0, At, B0); PG8_BAR; PG8_SCHED;
            PG8_STAGE(PG8_SB(1, 1), b3 + hstep, voffB);
            PG8_WAIT_V(6); PG8_BAR; PG8_MMA(1, 1, At, B1); PG8_BAR;
            }
        }
        if constexpr (ALIGN_EPI) { if (wr == 0) PG8_BAR; }
        if constexpr (Sched::SPLITK) {
            int ln; asm volatile("v_mbcnt_lo_u32_b32 %0, -1, 0\n\tv_mbcnt_hi_u32_b32 %0, -1, %0" : "=v"(ln));
            if constexpr (!Sched::HANDOFF) { E(acc, cur, wr, wc, ln & 15, ln >> 4); S.done(cur); } else {
            const __amdgpu_buffer_rsrc_t rs = __builtin_amdgcn_make_buffer_rsrc((void*)S.slab, 0, 256 * 131072, 0x00020000);
            if (cur.role == 2) {
                const unsigned so = ((unsigned)cur.slab * 32768u + (unsigned)wid * 4096u + (unsigned)ln * 4u) * 4u;
#pragma unroll
                for (int a = 0; a < 2; ++a)
#pragma unroll
                    for (int b = 0; b < 2; ++b)
#pragma unroll
                        for (int m = 0; m < 4; ++m) {
                            const f32x4 p0 = acc[a][b][m][0], p1 = acc[a][b][m][1];
                            const u32x4 pk = {cvt_pk_bf16(p0[0], p0[1]), cvt_pk_bf16(p0[2], p0[3]), cvt_pk_bf16(p1[0], p1[1]), cvt_pk_bf16(p1[2], p1[3])};
                            __builtin_amdgcn_raw_buffer_store_b128(pk, rs, so + (unsigned)(((a * 2 + b) * 4 + m) * 1024), 0, 16);
                        }
                asm volatile("s_waitcnt vmcnt(0)" ::: "memory");
                unsigned ep = S.epoch; asm volatile("" : "+s"(ep));
                if (ln == 0) __hip_atomic_store(S.flags + cur.slab * 8 + wid, ep, __ATOMIC_RELAXED, __HIP_MEMORY_SCOPE_AGENT);
            } else {
                if (cur.role == 1) {
                    for (int src = cur.slab, pass = 0; pass < 2 && src >= 0; src = cur.src2, ++pass) {
                        const unsigned* fl = S.flags + src * 8 + wid;
                        for (int sp = 0; sp < (1 << 20) && __hip_atomic_load(fl, __ATOMIC_RELAXED, __HIP_MEMORY_SCOPE_AGENT) != S.epoch; ++sp) __builtin_amdgcn_s_sleep(1);
                        const unsigned so = ((unsigned)src * 32768u + (unsigned)wid * 4096u + (unsigned)ln * 4u) * 4u;
                        u32x4 pv[2][2][4];
#pragma unroll
                        for (int a = 0; a < 2; ++a)
#pragma unroll
                            for (int b = 0; b < 2; ++b)
#pragma unroll
                                for (int m = 0; m < 4; ++m) pv[a][b][m] = __builtin_amdgcn_raw_buffer_load_b128(rs, so + (unsigned)(((a * 2 + b) * 4 + m) * 1024), 0, 16);
#pragma unroll
                        for (int a = 0; a < 2; ++a)
#pragma unroll
                            for (int b = 0; b < 2; ++b)
#pragma unroll
                                for (int m = 0; m < 4; ++m) { const u32x4 w = pv[a][b][m];
                                    acc[a][b][m][0] += (f32x4){__builtin_bit_cast(float, w[0] << 16), __builtin_bit_cast(float, w[0] & 0xffff0000u), __builtin_bit_cast(float, w[1] << 16), __builtin_bit_cast(float, w[1] & 0xffff0000u)};
                                    acc[a][b][m][1] += (f32x4){__builtin_bit_cast(float, w[2] << 16), __builtin_bit_cast(float, w[2] & 0xffff0000u), __builtin_bit_cast(float, w[3] << 16), __builtin_bit_cast(float, w[3] & 0xffff0000u)}; }
                    }
                }
                E(acc, cur, wr, wc, ln & 15, ln >> 4); S.done(cur);
            }
            }
        } else
        if constexpr (!Epi::AFTER_DRAIN) { int ln_; asm volatile("v_mbcnt_lo_u32_b32 %0, -1, 0\n\tv_mbcnt_hi_u32_b32 %0, -1, %0" : "=v"(ln_)); E(acc, cur, wr, wc, ln_ & 15, ln_ >> 4); S.done(cur); }
        if (!has_next) break;
#pragma unroll
        for (int a = 0; a < 2; ++a)
#pragma unroll
            for (int b = 0; b < 2; ++b)
#pragma unroll
                for (int m = 0; m < 4; ++m)
#pragma unroll
                    for (int n = 0; n < 2; ++n) acc[a][b][m][n] = (f32x4){0.f, 0.f, 0.f, 0.f};
        cur = nxt; cA = nA; cB = nB; ++ui;
        if constexpr (Sched::SPLITK) nt = cur.nkt;
        if constexpr (ALIGN_EPI) { if (wr == 1) PG8_BAR; }
    }
    PG8_WAIT_V(0);
    if constexpr (!ALIGN_EPI) { if (wr == 0) PG8_BAR; }
    PG8_BAR;
    if constexpr (Epi::AFTER_DRAIN) { E.fused(acc, cur, wr, wc, fr, fq, lds, wid, lane); S.done(cur); }
#undef PG8_SA
#undef PG8_SB
#undef PG8_STAGE
#undef PG8_LDA
#undef PG8_LDB
#undef PG8_MMA
#undef PG8_WAIT_V
#undef PG8_WAIT_L
#undef PG8_BAR
#undef PG8_SCHED
}
}
#define GAS __attribute__((address_space(1)))
#define LAS __attribute__((address_space(3)))
typedef unsigned short bf16;
typedef unsigned v4u __attribute__((ext_vector_type(4)));
typedef float f32x4 __attribute__((ext_vector_type(4)));
typedef short bf16x8 __attribute__((ext_vector_type(8)));
typedef GAS unsigned gu32;
typedef GAS unsigned long long gu64;
#define RLX_AGENT __ATOMIC_RELAXED, __HIP_MEMORY_SCOPE_AGENT
#define LDS_WAIT() asm volatile("s_waitcnt lgkmcnt(0)" ::: "memory")
#define VM_WAIT() asm volatile("s_waitcnt vmcnt(0)" ::: "memory")
__device__ __forceinline__ unsigned long long rt() { return __builtin_amdgcn_s_memrealtime(); }
__device__ __forceinline__ unsigned f2bf(float f) { unsigned u = __builtin_bit_cast(unsigned, f); return (u + 0x7fffu + ((u >> 16) & 1u)) >> 16; }
__device__ __forceinline__ unsigned pk2(float lo, float hi) { return f2bf(lo) | (f2bf(hi) << 16); }

#define XB_TMO      128
#define XB_XCNT(j)  (256  + 64 * (j))
#define XB_XSUB(j)  (1280 + 64 * (j))
#define XB_XGEN(j)  (2304 + 64 * (j))
#define XB_TOP      3328
#define XB_TOPGEN   3392
#define XCD_BAR_WORDS 3456
#define XB_SPIN_CAP (1u << 18)

__device__ __forceinline__ unsigned xb_ld(unsigned* p)              { return __hip_atomic_load(p, __ATOMIC_RELAXED, __HIP_MEMORY_SCOPE_AGENT); }
__device__ __forceinline__ unsigned xb_add(unsigned* p, unsigned v) { return __hip_atomic_fetch_add(p, v, __ATOMIC_RELAXED, __HIP_MEMORY_SCOPE_AGENT); }
__device__ __forceinline__ unsigned xb_xcc_id() { return (unsigned)__builtin_amdgcn_s_getreg((3 << 11) | 20) & 0xFu; }
#define XB_SPIN(cond, bar) do { unsigned _sp = 0; while (cond) { __builtin_amdgcn_s_sleep(1); \
    if ((++_sp & 255u) == 0u) { if (xb_ld(&(bar)[XB_TMO])) break; if (_sp > XB_SPIN_CAP) { atomicAdd(&(bar)[XB_TMO], 1u); break; } } } } while (0)

struct XcdBarrier {
    unsigned* bar; unsigned x;
    volatile LAS unsigned* st;
};

__device__ __forceinline__ XcdBarrier xcd_barrier_post(unsigned* bar, volatile LAS unsigned* st, int tid) {
    XcdBarrier b; b.bar = bar; b.x = xb_xcc_id(); b.st = st;
    if (tid == 0) (void)xb_add(&bar[XB_XCNT(b.x)], 1u);
    return b;
}
__device__ __forceinline__ void xcd_barrier_complete(unsigned* bar, unsigned x, unsigned& nloc, unsigned& nx) {
    const unsigned G = gridDim.x * gridDim.y * gridDim.z;
    unsigned sum, cnt, mine, sp = 0u;
    for (;;) {
        sum = 0u; cnt = 0u; mine = 0u;
#pragma unroll
        for (unsigned j = 0; j < 16; ++j) { const unsigned c = xb_ld(&bar[XB_XCNT(j)]); sum += c; cnt += (c > 0u) ? 1u : 0u; mine = (j == x) ? c : mine; }
        if (sum == G) break;
        __builtin_amdgcn_s_sleep(1);
        if ((++sp & 255u) == 0u) { if (xb_ld(&bar[XB_TMO])) break; if (sp > XB_SPIN_CAP) { atomicAdd(&bar[XB_TMO], 1u); break; } }
    }
    nloc = mine > 0u ? mine : 1u; nx = cnt > 0u ? cnt : 1u;
}

__device__ __forceinline__ void xcd_barrier(const XcdBarrier& b, int tid) {
    asm volatile("s_waitcnt vmcnt(0)" ::: "memory");
    __syncthreads();
    if (tid == 0) {
        unsigned* bar = b.bar;
        __builtin_amdgcn_s_waitcnt(0);
        unsigned nloc = b.st[0], nx = b.st[1];
        if (nloc == 0u) { xcd_barrier_complete(bar, b.x, nloc, nx); b.st[0] = nloc; b.st[1] = nx; }
        const unsigned old = xb_add(&bar[XB_XSUB(b.x)], 1u);
        const unsigned gen = old / nloc;
        if (old + 1u == (gen + 1u) * nloc) {
            __builtin_amdgcn_fence(__ATOMIC_RELEASE, "agent");
            asm volatile("s_waitcnt vmcnt(0)" ::: "memory");
            const unsigned og = xb_add(&bar[XB_TOP], 1u);
            const unsigned tg = og / nx;
            if (og + 1u == (tg + 1u) * nx) xb_add(&bar[XB_TOPGEN], 1u);
            else XB_SPIN(xb_ld(&bar[XB_TOPGEN]) == tg, bar);
            __builtin_amdgcn_fence(__ATOMIC_ACQUIRE, "agent");
            xb_add(&bar[XB_XGEN(b.x)], 1u);
            asm volatile("s_waitcnt vmcnt(0)" ::: "memory");
        } else {
            XB_SPIN(xb_ld(&bar[XB_XGEN(b.x)]) == gen, bar);
            __builtin_amdgcn_fence(__ATOMIC_ACQUIRE, "agent");
            asm volatile("s_waitcnt vmcnt(0)" ::: "memory");
        }
    }
    __syncthreads();
}

constexpr int NWAVES = 8;
constexpr int M_TOK = 10240, M_CTX = 8192, M_KV = 10752, DM = 1024;
constexpr int N_IN = 2560, N_Q = 768, N_KV = 1024, N_FI = 5632, D_FFN = 2816;
constexpr float EPSF = 1e-6f;
constexpr float QSCALE = 0.10206207261596575f * 1.4426950408889634f;

#ifndef MK_PER_PHASE
#define MK_PER_PHASE 0
#endif
#ifndef PHASE_MASK
#define PHASE_MASK 0x1ff
#endif
#define PH_EN(k) (((PHASE_MASK) >> (k)) & 1)
#ifndef REP_MASK
#define REP_MASK 0
#endif
#define REPS(k) (1 + (((REP_MASK) >> (k)) & 1))
constexpr int N_PHASES = 17;

constexpr size_t OUT_Y = 0, OUT_CKV = 10485760, OUT_KROPE = 12582912, OUT_SF = 13107200, OUT_SB = 15204352, OUT_TOTAL = 17301504;

constexpr size_t MiB = 1u << 20;
constexpr size_t WS_CTL = 0, CTL_ZERO_BYTES = 1 * MiB;
constexpr int CW_BAR = 4096;
constexpr int CW_SPLIT = 8192;
constexpr int CW_SS = 16384;
constexpr size_t WS_MOD = 1 * MiB;
constexpr size_t WS_TAB = WS_MOD + 256 * 1024;
constexpr size_t WS_BIAS = WS_MOD + 512 * 1024;
constexpr int BIAS_LD = 8192;
constexpr size_t WS_W = 2 * MiB;
constexpr size_t W_IN_OFF = 0, W_QB_OFF = (size_t)N_IN * 1024 * 2, W_KVB_OFF = W_QB_OFF + (size_t)N_Q * 256 * 2, W_O_OFF = W_KVB_OFF + (size_t)N_KV * 256 * 2,
                 W_FI_OFF = W_O_OFF + (size_t)1024 * 1024 * 2, W_FO_OFF = W_FI_OFF + (size_t)N_FI * 1024 * 2, LAYER_W = W_FO_OFF + (size_t)1024 * D_FFN * 2;
constexpr size_t WS_H = WS_W + 2 * LAYER_W;
constexpr size_t WS_RQ = WS_H + (size_t)M_TOK * 1024 * 2;
constexpr size_t WS_RK = WS_RQ + (size_t)M_TOK * 512 * 2;
constexpr size_t WS_RKT = WS_RK + (size_t)M_TOK * 512 * 2;
constexpr size_t WS_RVT = WS_RKT + (size_t)512 * M_CTX * 2;
constexpr size_t WS_RG = WS_RVT + (size_t)512 * M_TOK * 2;
constexpr size_t WS_QA = WS_RG + (size_t)M_TOK * 512 * 2;
constexpr size_t WS_KVA = WS_QA + (size_t)M_TOK * 256 * 2;
constexpr size_t WS_KR = WS_KVA + (size_t)M_KV * 256 * 2;
constexpr size_t WS_Q = WS_KR + (size_t)M_KV * 32 * 2;
constexpr size_t WS_KN = WS_Q + (size_t)M_TOK * 768 * 2;
constexpr size_t WS_VT = WS_KN + (size_t)M_KV * 512 * 2;
constexpr size_t WS_MIX = WS_VT + (size_t)512 * M_KV * 2;
constexpr size_t WS_ACT = WS_MIX + (size_t)M_TOK * 1024 * 2;
constexpr size_t WS_END = WS_ACT + (size_t)M_TOK * D_FFN * 2;
static_assert(WS_END <= 256 * MiB, "d_ws map exceeds 256 MiB");
static_assert((CW_SS + 7 * M_TOK) * 4 <= (int)CTL_ZERO_BYTES && (CW_BAR + XCD_BAR_WORDS) <= CW_SS, "CTL words");
static_assert(W_QB_OFF % 16 == 0 && W_KVB_OFF % 16 == 0 && W_O_OFF % 16 == 0 && W_FI_OFF % 16 == 0 && W_FO_OFF % 16 == 0 && LAYER_W % 16 == 0, "weight alignment");

constexpr int RING_OFF = 0, RING_BYTES = 131072;
constexpr int LDSCTL_OFF = RING_BYTES, MISC_OFF = LDSCTL_OFF + 320;
constexpr int LDS_BYTES = 147456;

typedef float f32x16 __attribute__((ext_vector_type(16)));
typedef float f32x2_t __attribute__((ext_vector_type(2)));
typedef __bf16 bf16x2_t __attribute__((ext_vector_type(2)));
typedef unsigned u32x2 __attribute__((ext_vector_type(2)));
__device__ __forceinline__ unsigned cvtpk(float lo, float hi) { f32x2_t v = {lo, hi}; bf16x2_t b = __builtin_convertvector(v, bf16x2_t); return __builtin_bit_cast(unsigned, b); }
#if defined(__HIP_DEVICE_COMPILE__)
#define ASSUME_GLOBAL(p) __builtin_assume(!__builtin_amdgcn_is_shared((const __attribute__((address_space(0))) void*)(p)) && !__builtin_amdgcn_is_private((const __attribute__((address_space(0))) void*)(p)))
#else
#define ASSUME_GLOBAL(p) ((void)0)
#endif
template <int K> __device__ __forceinline__ float shx(float v) { static_assert(K >= 1 && K <= 16, "shx"); return __builtin_bit_cast(float, __builtin_amdgcn_ds_swizzle(__builtin_bit_cast(int, v), (K << 10) | 0x1f)); }
__device__ __forceinline__ float sum32(float v) { const unsigned b = __builtin_bit_cast(unsigned, v); auto rr = __builtin_amdgcn_permlane32_swap(b, b, false, false); return __builtin_bit_cast(float, (unsigned)rr[0]) + __builtin_bit_cast(float, (unsigned)rr[1]); }
__device__ __forceinline__ float partner32(float v, bool upper_half) { const unsigned b = __builtin_bit_cast(unsigned, v); auto rr = __builtin_amdgcn_permlane32_swap(b, b, false, false); return __builtin_bit_cast(float, (unsigned)(upper_half ? rr[0] : rr[1])); }
__device__ __forceinline__ bf16 f2b(float x) { return (bf16)(cvtpk(x, 0.f) & 0xffffu); }
__device__ __forceinline__ float b2f(unsigned short b) { return __builtin_bit_cast(float, (unsigned)b << 16); }
__device__ __forceinline__ float siluf(float x) { return x * __builtin_amdgcn_rcpf(1.0f + __builtin_amdgcn_exp2f(-1.4426950408889634f * x)); }
__device__ __forceinline__ v4u pack8(const float (&v)[8]) { v4u w; w.x = cvtpk(v[0], v[1]); w.y = cvtpk(v[2], v[3]); w.z = cvtpk(v[4], v[5]); w.w = cvtpk(v[6], v[7]); return w; }
__device__ __forceinline__ void ld8(const pg8::f32x4 (&a)[2], float (&v)[8]) { v[0] = a[0][0]; v[1] = a[0][1]; v[2] = a[0][2]; v[3] = a[0][3]; v[4] = a[1][0]; v[5] = a[1][1]; v[6] = a[1][2]; v[7] = a[1][3]; }

struct Params {
    const float* in[28];
    float* out;
    unsigned char* ws;
    int ph_lo, ph_hi;
};


struct EpiG1 {
    static constexpr bool PERM = true, AFTER_DRAIN = false;
    unsigned char* ws_; const float* gin[3]; float* out_; int layer; int no_atomics; int rs_idx; LAS float* lss;
    __device__ __forceinline__ void operator()(const pg8::f32x4 (&acc)[2][2][4][2], const pg8::Unit& u, int wr, int wc, int fr, int fq) const {
        asm volatile("" : "+v"(fr), "+v"(fq));
        unsigned long long zo_ = 0ull; asm volatile("" : "+s"(zo_)); unsigned char* ws = ws_ + zo_;
        bf16* const RQ = (bf16*)(ws + WS_RQ); bf16* const RK = (bf16*)(ws + WS_RK); bf16* const RKT = (bf16*)(ws + WS_RKT); bf16* const RVT = (bf16*)(ws + WS_RVT); bf16* const RG = (bf16*)(ws + WS_RG);
        bf16* const QA = (bf16*)(ws + WS_QA); bf16* const KVA = (bf16*)(ws + WS_KVA); bf16* const KR = (bf16*)(ws + WS_KR);
        float* const ssq = (float*)(ws + WS_CTL + 4 * CW_SS) + (size_t)(layer * 2) * M_TOK; float* const sskv = ssq + M_TOK;
        const float2* const tab64 = (const float2*)(ws + WS_TAB); const float2* const tab32 = tab64 + 64 * 16;
        const float* const g_q_a = gin[0]; const float* const g_kv_a = gin[1]; const float* const g_kr = gin[2]; float* const out_krope = out_ + OUT_KROPE;
        const int pn = u.pn; const bool lat = u.pm >= 32;
        const bool rs_on = rs_idx >= 0;
        const float* const rsp = (const float*)(ws + WS_CTL + 4 * CW_SS) + (size_t)(rs_on ? rs_idx : 0) * M_TOK;
        float bz[2][8];
        { const int cond = (u.pm < 32) ? 0 : 1 + ((u.pm - 32) >> 2); const float* bp = (const float*)(ws + WS_BIAS) + (size_t)(layer * 3 + cond) * BIAS_LD + pn * 256 + wc * 32 + fq * 8;
#pragma unroll
          for (int bj = 0; bj < 2; ++bj) {
              pg8::f32x4 b0 = {0.f, 0.f, 0.f, 0.f}, b1 = b0; if (rs_on) { b0 = *(const pg8::f32x4*)(bp + bj * 128); b1 = *(const pg8::f32x4*)(bp + bj * 128 + 4); }
#pragma unroll
              for (int e = 0; e < 4; ++e) { bz[bj][e] = b0[e]; bz[bj][4 + e] = b1[e]; } } }
        float rsv[2][4];
#pragma unroll
        for (int ai = 0; ai < 2; ++ai)
#pragma unroll
            for (int m = 0; m < 4; ++m) rsv[ai][m] = rs_on ? rsp[u.pm * 256 + ai * 128 + wr * 64 + m * 16 + fr] : 0.f;
#define G1_LD(bj_, v_) do { ld8(acc[ai][bj_][m], v_); if (rs_on) { _Pragma("unroll") for (int e_ = 0; e_ < 8; ++e_) v_[e_] = v_[e_] * rs + bz[bj_][e_]; } } while (0)
        if (pn < 4) {
            bf16* dst = (pn < 2) ? RQ : RK; const int cb = (pn & 1) * 256;
#pragma unroll
            for (int ai = 0; ai < 2; ++ai)
#pragma unroll
                for (int m = 0; m < 4; ++m) {
                    asm volatile("" ::: "memory"); const int r = u.pm * 256 + ai * 128 + wr * 64 + m * 16 + fr; const float rs = rs_on ? 1.0f / sqrtf(rsv[ai][m] * (1.0f / 1024.0f) + EPSF) : 1.0f;
                    const int n = (r - M_CTX) & 1023, prow = n >> 6, pcol = n & 63;
#pragma unroll
                    for (int bj = 0; bj < 2; ++bj) {
                        float v[8]; G1_LD(bj, v);
                        const int c = cb + bj * 128 + wc * 32 + fq * 8;
                        if (lat) {
                            const int pos = (wc & 1) ? pcol : prow;
                            const float2* tb = tab64 + pos * 16 + (fq & 1) * 8;
#pragma unroll
                            for (int e = 0; e < 8; ++e) { const float pv = partner32(v[e], fq >= 2); const float2 cs = tb[e]; v[e] = (fq < 2) ? (v[e] * cs.x - pv * cs.y) : (pv * cs.y + v[e] * cs.x); }
                        }
                        *(v4u*)(dst + (size_t)r * 512 + c) = pack8(v);
                        if (pn >= 2 && !lat) {
#pragma unroll
                            for (int e = 0; e < 8; ++e) RKT[(size_t)(c + e) * M_CTX + r] = f2b(v[e]);
                        }
                    }
                }
        } else if (pn < 6) {
            const int cb = (pn - 4) * 256;
#pragma unroll
            for (int ai = 0; ai < 2; ++ai)
#pragma unroll
                for (int m = 0; m < 4; ++m) {
                    asm volatile("" ::: "memory"); const int r = u.pm * 256 + ai * 128 + wr * 64 + m * 16 + fr; const float rs = rs_on ? 1.0f / sqrtf(rsv[ai][m] * (1.0f / 1024.0f) + EPSF) : 1.0f;
#pragma unroll
                    for (int bj = 0; bj < 2; ++bj) {
                        float v[8]; G1_LD(bj, v);
                        const int c = cb + bj * 128 + wc * 32 + fq * 8;
#pragma unroll
                        for (int e = 0; e < 8; ++e) RVT[(size_t)(c + e) * M_TOK + r] = f2b(v[e]);
                    }
                }
        } else if (pn < 8) {
            const int cb = (pn - 6) * 256;
#pragma unroll
            for (int ai = 0; ai < 2; ++ai)
#pragma unroll
                for (int m = 0; m < 4; ++m) {
                    asm volatile("" ::: "memory"); const int r = u.pm * 256 + ai * 128 + wr * 64 + m * 16 + fr; const float rs = rs_on ? 1.0f / sqrtf(rsv[ai][m] * (1.0f / 1024.0f) + EPSF) : 1.0f;
#pragma unroll
                    for (int bj = 0; bj < 2; ++bj) {
                        float v[8]; G1_LD(bj, v);
#pragma unroll
                        for (int e = 0; e < 8; ++e) v[e] = siluf(v[e]);
                        *(v4u*)(RG + (size_t)r * 512 + cb + bj * 128 + wc * 32 + fq * 8) = pack8(v);
                    }
                }
        } else if (pn == 8) {
#pragma unroll
            for (int ai = 0; ai < 2; ++ai)
#pragma unroll
                for (int m = 0; m < 4; ++m) {
                    asm volatile("" ::: "memory"); const int r = u.pm * 256 + ai * 128 + wr * 64 + m * 16 + fr; const float rs = rs_on ? 1.0f / sqrtf(rsv[ai][m] * (1.0f / 1024.0f) + EPSF) : 1.0f;
                    float part = 0.f;
#pragma unroll
                    for (int bj = 0; bj < 2; ++bj) {
                        float v[8]; G1_LD(bj, v);
                        const int c = bj * 128 + wc * 32 + fq * 8;
                        const pg8::f32x4 g0 = *(const pg8::f32x4*)(g_q_a + c), g1 = *(const pg8::f32x4*)(g_q_a + c + 4);
#pragma unroll
                        for (int e = 0; e < 8; ++e) { part += v[e] * v[e]; v[e] *= (e < 4 ? g0[e & 3] : g1[e & 3]); }
                        *(v4u*)(QA + (size_t)r * 256 + c) = pack8(v);
                    }
                    part += shx<16>(part); part = sum32(part);
                    if (fq == 0) { if (lss) lss[wc * 256 + ai * 128 + wr * 64 + m * 16 + fr] = part; else if (!no_atomics) atomicAdd(ssq + r, part); }
                }
        } else {
#pragma unroll
            for (int ai = 0; ai < 2; ++ai)
#pragma unroll
                for (int m = 0; m < 4; ++m) {
                    asm volatile("" ::: "memory"); const int r = u.pm * 256 + ai * 128 + wr * 64 + m * 16 + fr; const float rs = rs_on ? 1.0f / sqrtf(rsv[ai][m] * (1.0f / 1024.0f) + EPSF) : 1.0f;
                    {
                        float v[8]; G1_LD(0, v);
                        const int c = wc * 32 + fq * 8;
                        const pg8::f32x4 g0 = *(const pg8::f32x4*)(g_kv_a + c), g1 = *(const pg8::f32x4*)(g_kv_a + c + 4);
                        float part = 0.f;
#pragma unroll
                        for (int e = 0; e < 8; ++e) { part += v[e] * v[e]; v[e] *= (e < 4 ? g0[e & 3] : g1[e & 3]); }
                        *(v4u*)(KVA + (size_t)r * 256 + c) = pack8(v);
                        part += shx<16>(part); part = sum32(part);
                        if (fq == 0) { if (lss) lss[wc * 256 + ai * 128 + wr * 64 + m * 16 + fr] = part; else if (!no_atomics) atomicAdd(sskv + r, part); }
                    }
                    if (wc == 0) {
                        float v[8]; G1_LD(1, v);
                        float ss = 0.f;
#pragma unroll
                        for (int e = 0; e < 8; ++e) ss += v[e] * v[e];
                        ss += shx<16>(ss); ss = sum32(ss);
                        const float rstd = 1.0f / sqrtf(ss * (1.0f / 32.0f) + EPSF);
                        const pg8::f32x4 g0 = *(const pg8::f32x4*)(g_kr + fq * 8), g1 = *(const pg8::f32x4*)(g_kr + fq * 8 + 4);
#pragma unroll
                        for (int e = 0; e < 8; ++e) v[e] *= rstd * (e < 4 ? g0[e & 3] : g1[e & 3]);
                        if (!lat) {
                            float* o = out_krope + ((size_t)((r >> 8) * 2 + layer) * 256 + (r & 255)) * 32 + fq * 8;
                            __builtin_nontemporal_store((pg8::f32x4){v[0], v[1], v[2], v[3]}, (pg8::f32x4*)o); __builtin_nontemporal_store((pg8::f32x4){v[4], v[5], v[6], v[7]}, (pg8::f32x4*)(o + 4));
                        } else {
                            const int n = (r - M_CTX) & 1023, pos = (fq < 2) ? (n >> 6) : (n & 63);
                            const float2* tb = tab32 + pos * 8;
#pragma unroll
                            for (int e = 0; e < 8; ++e) { const float pv = shx<16>(v[e]); const float2 cs = tb[e]; v[e] = ((fq & 1) == 0) ? (v[e] * cs.x - pv * cs.y) : (pv * cs.y + v[e] * cs.x); }
                        }
                        *(v4u*)(KR + (size_t)r * 32 + fq * 8) = pack8(v);
                    }
                }
        }
    }
#undef G1_LD
};

struct EpiQ {
    static constexpr bool PERM = true, AFTER_DRAIN = false;
    unsigned char* ws_; const float *g_qn, *g_qr; int layer;
    __device__ __forceinline__ void operator()(const pg8::f32x4 (&acc)[2][2][4][2], const pg8::Unit& u, int wr, int wc, int fr, int fq) const {
        asm volatile("" : "+v"(fr), "+v"(fq));
        unsigned long long zo_ = 0ull; asm volatile("" : "+s"(zo_)); unsigned char* ws = ws_ + zo_;
        bf16* const Q = (bf16*)(ws + WS_Q); const float* const ssq = (const float*)(ws + WS_CTL + 4 * CW_SS) + (size_t)(layer * 2) * M_TOK; const float2* const tab32 = (const float2*)(ws + WS_TAB) + 64 * 16;
        const int pn = u.pn; const bool lat = u.pm >= 32;
        float ssv[2][4];
#pragma unroll
        for (int ai = 0; ai < 2; ++ai)
#pragma unroll
            for (int m = 0; m < 4; ++m) ssv[ai][m] = ssq[u.pm * 256 + ai * 128 + wr * 64 + m * 16 + fr];
#pragma unroll
        for (int ai = 0; ai < 2; ++ai)
#pragma unroll
            for (int m = 0; m < 4; ++m) {
                asm volatile("" ::: "memory"); const int r = u.pm * 256 + ai * 128 + wr * 64 + m * 16 + fr;
                const float al = __builtin_amdgcn_rsqf(ssv[ai][m] * (1.0f / 256.0f) + EPSF), a2 = al * al;
                if (pn < 2) {
                    float ss = 0.f;
#pragma unroll
                    for (int bj = 0; bj < 2; ++bj)
#pragma unroll
                        for (int n = 0; n < 2; ++n) { const pg8::f32x4 x = acc[ai][bj][m][n]; ss += (x[0] * x[0] + x[1] * x[1]) + (x[2] * x[2] + x[3] * x[3]); }
                    ss += shx<16>(ss); ss = sum32(ss);
                    const float f = al * __builtin_amdgcn_rsqf(a2 * ss * (1.0f / 64.0f) + EPSF) * QSCALE;
                    const int h = 4 * pn + wc;
                    bf16* o = Q + (size_t)r * 768 + h * 96 + fq * 8;
#pragma unroll
                    for (int bj = 0; bj < 2; ++bj) {
                        float v[8]; ld8(acc[ai][bj][m], v);
                        const pg8::f32x4 ga = *(const pg8::f32x4*)(g_qn + 32 * bj + fq * 8), gb = *(const pg8::f32x4*)(g_qn + 32 * bj + fq * 8 + 4);
#pragma unroll
                        for (int e = 0; e < 8; ++e) v[e] *= f * (e < 4 ? ga[e & 3] : gb[e & 3]);
                        *(v4u*)(o + 32 * bj) = pack8(v);
                    }
                } else {
                    const int n = (r - M_CTX) & 1023, pos = (fq < 2) ? (n >> 6) : (n & 63);
                    const float2* tb = tab32 + pos * 8;
                    const pg8::f32x4 g0 = *(const pg8::f32x4*)(g_qr + fq * 8), g1 = *(const pg8::f32x4*)(g_qr + fq * 8 + 4);
#pragma unroll
                    for (int bj = 0; bj < 2; ++bj) {
                        float v[8]; ld8(acc[ai][bj][m], v);
                        float ss = 0.f;
#pragma unroll
                        for (int e = 0; e < 8; ++e) ss += v[e] * v[e];
                        ss += shx<16>(ss); ss = sum32(ss);
                        const float f = al * __builtin_amdgcn_rsqf(a2 * ss * (1.0f / 32.0f) + EPSF) * QSCALE;
#pragma unroll
                        for (int e = 0; e < 8; ++e) v[e] *= f * (e < 4 ? g0[e & 3] : g1[e & 3]);
                        if (lat) {
#pragma unroll
                            for (int e = 0; e < 8; ++e) { const float pv = shx<16>(v[e]); const float2 cs = tb[e]; v[e] = ((fq & 1) == 0) ? (v[e] * cs.x - pv * cs.y) : (pv * cs.y + v[e] * cs.x); }
                        }
                        const int h = 4 * bj + wc;
                        *(v4u*)(Q + (size_t)r * 768 + h * 96 + 64 + fq * 8) = pack8(v);
                    }
                }
            }
    }
};

struct EpiKV {
    static constexpr bool PERM = true, AFTER_DRAIN = false;
    unsigned char* ws_; const float* g_kn; int layer;
    __device__ __forceinline__ void operator()(const pg8::f32x4 (&acc)[2][2][4][2], const pg8::Unit& u, int wr, int wc, int fr, int fq) const {
        asm volatile("" : "+v"(fr), "+v"(fq));
        unsigned long long zo_ = 0ull; asm volatile("" : "+s"(zo_)); unsigned char* ws = ws_ + zo_;
        bf16* const KN = (bf16*)(ws + WS_KN); bf16* const VT = (bf16*)(ws + WS_VT); const float* const sskv = (const float*)(ws + WS_CTL + 4 * CW_SS) + (size_t)(layer * 2 + 1) * M_TOK;
        const int pn = u.pn;
        float ssv[2][4];
#pragma unroll
        for (int ai = 0; ai < 2; ++ai)
#pragma unroll
            for (int m = 0; m < 4; ++m) { const int r_ = u.pm * 256 + ai * 128 + wr * 64 + m * 16 + fr; ssv[ai][m] = sskv[r_ < M_TOK ? r_ : 0]; }
#pragma unroll
        for (int ai = 0; ai < 2; ++ai)
#pragma unroll
            for (int m = 0; m < 4; ++m) {
                asm volatile("" ::: "memory"); const int r = u.pm * 256 + ai * 128 + wr * 64 + m * 16 + fr;
                const float al = (r < M_TOK) ? __builtin_amdgcn_rsqf(ssv[ai][m] * (1.0f / 128.0f) + EPSF) : 1.0f, a2 = al * al;
                if (pn < 2) {
                    float ss = 0.f;
#pragma unroll
                    for (int bj = 0; bj < 2; ++bj)
#pragma unroll
                        for (int n = 0; n < 2; ++n) { const pg8::f32x4 x = acc[ai][bj][m][n]; ss += (x[0] * x[0] + x[1] * x[1]) + (x[2] * x[2] + x[3] * x[3]); }
                    ss += shx<16>(ss); ss = sum32(ss);
                    const float f = al * __builtin_amdgcn_rsqf(a2 * ss * (1.0f / 64.0f) + EPSF);
                    const int h = 4 * pn + wc;
                    bf16* o = KN + (size_t)r * 512 + h * 64 + fq * 8;
#pragma unroll
                    for (int bj = 0; bj < 2; ++bj) {
                        float v[8]; ld8(acc[ai][bj][m], v);
                        const pg8::f32x4 ga = *(const pg8::f32x4*)(g_kn + 32 * bj + fq * 8), gb = *(const pg8::f32x4*)(g_kn + 32 * bj + fq * 8 + 4);
#pragma unroll
                        for (int e = 0; e < 8; ++e) v[e] *= f * (e < 4 ? ga[e & 3] : gb[e & 3]);
                        *(v4u*)(o + 32 * bj) = pack8(v);
                    }
                } else {
                    const int h = 4 * (pn - 2) + wc;
#pragma unroll
                    for (int bj = 0; bj < 2; ++bj) {
                        float v[8]; ld8(acc[ai][bj][m], v);
#pragma unroll
                        for (int e = 0; e < 8; ++e) VT[(size_t)(h * 64 + bj * 32 + fq * 8 + e) * M_KV + r] = f2b(v[e] * al);
                    }
                }
            }
    }
};

template <bool SRC16, bool DST16>
struct EpiResT {
    static constexpr bool PERM = false, AFTER_DRAIN = false;
    const float *xs0, *xs1;
    float* out; const float* gate;
    bf16* H; const float* nn_g; const float* nn_sc; float* rowss; int final_out;
    bf16* xb_dst; const bf16* xb_src;
    __device__ __forceinline__ void operator()(const pg8::f32x4 (&acc_)[2][2][4][2], const pg8::Unit& u, int wr, int wc, int fr, int fq) const {
        asm volatile("" : "+v"(fr), "+v"(fq));
        pg8::f32x4 (&acc)[2][2][4][2] = const_cast<pg8::f32x4 (&)[2][2][4][2]>(acc_);
        const int cond = (u.pm < 32) ? 0 : 1 + ((u.pm - 32) >> 2);
        const float* gp = gate + cond * 6144;
        const int col0 = u.pn * 256 + wc * 32 + 4 * fq;
        const bool nn = nn_g != nullptr;
        pg8::f32x4 gv[2][2], gg[2][2]; float ssv[2][4];
#pragma unroll
        for (int bj = 0; bj < 2; ++bj)
#pragma unroll
            for (int n = 0; n < 2; ++n) { const int c = col0 + bj * 128 + n * 16; gv[bj][n] = *(const pg8::f32x4*)(gp + c);
                if (nn) { const pg8::f32x4 g0 = *(const pg8::f32x4*)(nn_g + c), s0 = *(const pg8::f32x4*)(nn_sc + cond * 6144 + c); gg[bj][n] = g0 * (s0 + 1.0f); } else gg[bj][n] = (pg8::f32x4){0.f, 0.f, 0.f, 0.f}; }
#pragma unroll
        for (int ai = 0; ai < 2; ++ai)
#pragma unroll
            for (int bj = 0; bj < 2; ++bj)
#pragma unroll
                for (int m = 0; m < 4; ++m)
#pragma unroll
                    for (int n = 0; n < 2; ++n) acc[ai][bj][m][n] *= gv[bj][n];
        asm volatile("" ::: "memory");
        const int r0 = u.pm * 256 + wr * 64 + fr;
        const float* src0 = (r0 < M_CTX) ? xs0 + (size_t)r0 * 1024 : xs1 + (size_t)(r0 - M_CTX) * 1024;
        pg8::f32x4 x[2][2][2];
#define RES_LOAD(q_) do { _Pragma("unroll") for (int mm = 0; mm < 2; ++mm) _Pragma("unroll") for (int bj = 0; bj < 2; ++bj) _Pragma("unroll") for (int n = 0; n < 2; ++n) \
            x[mm][bj][n] = *(const pg8::f32x4*)(src0 + (size_t)(((q_) >> 1) * 128 + (((q_) & 1) * 2 + mm) * 16) * 1024 + col0 + bj * 128 + n * 16); } while (0)
#define RES_MATH(q_) do { _Pragma("unroll") for (int mm = 0; mm < 2; ++mm) { float ss = 0.f; _Pragma("unroll") for (int bj = 0; bj < 2; ++bj) _Pragma("unroll") for (int n = 0; n < 2; ++n) { \
            const pg8::f32x4 o = x[mm][bj][n] + acc[(q_) >> 1][bj][((q_) & 1) * 2 + mm][n]; acc[(q_) >> 1][bj][((q_) & 1) * 2 + mm][n] = o; ss += (o[0] * o[0] + o[1] * o[1]) + (o[2] * o[2] + o[3] * o[3]); } \
            ssv[(q_) >> 1][((q_) & 1) * 2 + mm] = ss; } } while (0)
#define RES_STORE(q_) do { _Pragma("unroll") for (int mm = 0; mm < 2; ++mm) { const size_t ro = (size_t)(r0 + ((q_) >> 1) * 128 + (((q_) & 1) * 2 + mm) * 16) * 1024; _Pragma("unroll") for (int bj = 0; bj < 2; ++bj) _Pragma("unroll") for (int n = 0; n < 2; ++n) { \
            const int c = col0 + bj * 128 + n * 16; const pg8::f32x4 o = acc[(q_) >> 1][bj][((q_) & 1) * 2 + mm][n]; if constexpr (DST16) *(u32x2*)(xb_dst + ro + c) = (u32x2){cvtpk(o[0], o[1]), cvtpk(o[2], o[3])}; else if (final_out) __builtin_nontemporal_store(o, (pg8::f32x4*)(out + ro + c)); else *(pg8::f32x4*)(out + ro + c) = o; \
            if (nn) { const pg8::f32x4 y = o * gg[bj][n]; *(u32x2*)(H + ro + c) = (u32x2){cvtpk(y[0], y[1]), cvtpk(y[2], y[3])}; } } } } while (0)
#define RES_FENCE() asm volatile("" ::: "memory")
        if constexpr (SRC16) {
            const bf16* sb0 = xb_src + (size_t)r0 * 1024;
            u32x2 xh[2][2][2][2];
#define HALF_LOAD(h_) do { _Pragma("unroll") for (int qq = 0; qq < 2; ++qq) _Pragma("unroll") for (int mm = 0; mm < 2; ++mm) _Pragma("unroll") for (int bj = 0; bj < 2; ++bj) _Pragma("unroll") for (int n = 0; n < 2; ++n) \
                xh[qq][mm][bj][n] = *(const u32x2*)(sb0 + (size_t)((h_) * 128 + (qq * 2 + mm) * 16) * 1024 + col0 + bj * 128 + n * 16); } while (0)
#define HALF_CVT(qq_) do { _Pragma("unroll") for (int mm = 0; mm < 2; ++mm) _Pragma("unroll") for (int bj = 0; bj < 2; ++bj) _Pragma("unroll") for (int n = 0; n < 2; ++n) { const u32x2 w = xh[qq_][mm][bj][n]; \
                x[mm][bj][n] = (pg8::f32x4){__builtin_bit_cast(float, w.x << 16), __builtin_bit_cast(float, w.x & 0xffff0000u), __builtin_bit_cast(float, w.y << 16), __builtin_bit_cast(float, w.y & 0xffff0000u)}; } } while (0)
            HALF_LOAD(0); HALF_CVT(0); RES_MATH(0); HALF_CVT(1); RES_MATH(1); RES_FENCE();
            HALF_LOAD(1); RES_FENCE(); RES_STORE(0); RES_STORE(1); HALF_CVT(0); RES_MATH(2); HALF_CVT(1); RES_MATH(3); RES_FENCE();
            RES_STORE(2); RES_STORE(3);
#undef HALF_LOAD
#undef HALF_CVT
        } else {
        RES_LOAD(0); RES_MATH(0); RES_FENCE();
        RES_LOAD(1); RES_FENCE(); RES_STORE(0); RES_MATH(1); RES_FENCE();
        RES_LOAD(2); RES_FENCE(); RES_STORE(1); RES_MATH(2); RES_FENCE();
        RES_LOAD(3); RES_FENCE(); RES_STORE(2); RES_MATH(3); RES_FENCE();
        RES_STORE(3);
        }
#undef RES_FENCE
#undef RES_LOAD
#undef RES_MATH
#undef RES_STORE
        if (nn) {
#pragma unroll
            for (int ai = 0; ai < 2; ++ai)
#pragma unroll
                for (int m = 0; m < 4; ++m) { float ss = ssv[ai][m]; ss += shx<16>(ss); ss = sum32(ss);
                    if (fq == 0) atomicAdd(rowss + r0 + ai * 128 + m * 16, ss); }
        }
    }
};
template <bool SRC16, bool DST16>
struct EpiResW {
    static constexpr bool PERM = true, AFTER_DRAIN = false;
    const float *xs0, *xs1;
    float* out; const float* gate;
    bf16* H; const float* nn_g; const float* nn_sc; float* rowss; int final_out;
    bf16* xb_dst; const bf16* xb_src;
    __device__ __forceinline__ void operator()(const pg8::f32x4 (&acc_)[2][2][4][2], const pg8::Unit& u, int wr, int wc, int fr, int fq) const {
        asm volatile("" : "+v"(fr), "+v"(fq));
        pg8::f32x4 (&acc)[2][2][4][2] = const_cast<pg8::f32x4 (&)[2][2][4][2]>(acc_);
        const int cond = (u.pm < 32) ? 0 : 1 + ((u.pm - 32) >> 2);
        const float* gp = gate + cond * 6144;
        const int col0 = u.pn * 256 + wc * 32 + 8 * fq;
        const bool nn = nn_g != nullptr;
        pg8::f32x4 gv[2][2], gg[2][2]; float ssv[2][4];
#pragma unroll
        for (int bj = 0; bj < 2; ++bj)
#pragma unroll
            for (int n = 0; n < 2; ++n) { const int c = col0 + bj * 128 + n * 4; gv[bj][n] = *(const pg8::f32x4*)(gp + c);
                if (nn) { const pg8::f32x4 g0 = *(const pg8::f32x4*)(nn_g + c), s0 = *(const pg8::f32x4*)(nn_sc + cond * 6144 + c); gg[bj][n] = g0 * (s0 + 1.0f); } else gg[bj][n] = (pg8::f32x4){0.f, 0.f, 0.f, 0.f}; }
#pragma unroll
        for (int ai = 0; ai < 2; ++ai)
#pragma unroll
            for (int bj = 0; bj < 2; ++bj)
#pragma unroll
                for (int m = 0; m < 4; ++m)
#pragma unroll
                    for (int n = 0; n < 2; ++n) acc[ai][bj][m][n] *= gv[bj][n];
        asm volatile("" ::: "memory");
        const int r0 = u.pm * 256 + wr * 64 + fr;
        const float* src0 = (r0 < M_CTX) ? xs0 + (size_t)r0 * 1024 : xs1 + (size_t)(r0 - M_CTX) * 1024;
        pg8::f32x4 x[2][2][2];
#define RES_LOAD(q_) do { _Pragma("unroll") for (int mm = 0; mm < 2; ++mm) _Pragma("unroll") for (int bj = 0; bj < 2; ++bj) _Pragma("unroll") for (int n = 0; n < 2; ++n) \
            x[mm][bj][n] = *(const pg8::f32x4*)(src0 + (size_t)(((q_) >> 1) * 128 + (((q_) & 1) * 2 + mm) * 16) * 1024 + col0 + bj * 128 + n * 4); } while (0)
#define RES_MATH(q_) do { _Pragma("unroll") for (int mm = 0; mm < 2; ++mm) { float ss = 0.f; _Pragma("unroll") for (int bj = 0; bj < 2; ++bj) _Pragma("unroll") for (int n = 0; n < 2; ++n) { \
            const pg8::f32x4 o = x[mm][bj][n] + acc[(q_) >> 1][bj][((q_) & 1) * 2 + mm][n]; acc[(q_) >> 1][bj][((q_) & 1) * 2 + mm][n] = o; ss += (o[0] * o[0] + o[1] * o[1]) + (o[2] * o[2] + o[3] * o[3]); } \
            ssv[(q_) >> 1][((q_) & 1) * 2 + mm] = ss; } } while (0)
#define RES_STORE(q_) do { _Pragma("unroll") for (int mm = 0; mm < 2; ++mm) { const size_t ro = (size_t)(r0 + ((q_) >> 1) * 128 + (((q_) & 1) * 2 + mm) * 16) * 1024; _Pragma("unroll") for (int bj = 0; bj < 2; ++bj) { \
            const int c = col0 + bj * 128; const pg8::f32x4 o0 = acc[(q_) >> 1][bj][((q_) & 1) * 2 + mm][0], o1 = acc[(q_) >> 1][bj][((q_) & 1) * 2 + mm][1]; \
            if constexpr (DST16) *(v4u*)(xb_dst + ro + c) = (v4u){cvtpk(o0[0], o0[1]), cvtpk(o0[2], o0[3]), cvtpk(o1[0], o1[1]), cvtpk(o1[2], o1[3])}; \
            else if (final_out) { __builtin_nontemporal_store(o0, (pg8::f32x4*)(out + ro + c)); __builtin_nontemporal_store(o1, (pg8::f32x4*)(out + ro + c + 4)); } else { *(pg8::f32x4*)(out + ro + c) = o0; *(pg8::f32x4*)(out + ro + c + 4) = o1; } \
            if (nn) { const pg8::f32x4 y0 = o0 * gg[bj][0], y1 = o1 * gg[bj][1]; *(v4u*)(H + ro + c) = (v4u){cvtpk(y0[0], y0[1]), cvtpk(y0[2], y0[3]), cvtpk(y1[0], y1[1]), cvtpk(y1[2], y1[3])}; } } } } while (0)
#define RES_FENCE() asm volatile("" ::: "memory")
        if constexpr (SRC16) {
            const bf16* sb0 = xb_src + (size_t)r0 * 1024;
            v4u xh[2][2][2];
#define HALF_LOAD(h_) do { _Pragma("unroll") for (int qq = 0; qq < 2; ++qq) _Pragma("unroll") for (int mm = 0; mm < 2; ++mm) _Pragma("unroll") for (int bj = 0; bj < 2; ++bj) \
                xh[qq][mm][bj] = *(const v4u*)(sb0 + (size_t)((h_) * 128 + (qq * 2 + mm) * 16) * 1024 + col0 + bj * 128); } while (0)
#define HALF_CVT(qq_) do { _Pragma("unroll") for (int mm = 0; mm < 2; ++mm) _Pragma("unroll") for (int bj = 0; bj < 2; ++bj) { const v4u w = xh[qq_][mm][bj]; \
                x[mm][bj][0] = (pg8::f32x4){__builtin_bit_cast(float, w.x << 16), __builtin_bit_cast(float, w.x & 0xffff0000u), __builtin_bit_cast(float, w.y << 16), __builtin_bit_cast(float, w.y & 0xffff0000u)}; \
                x[mm][bj][1] = (pg8::f32x4){__builtin_bit_cast(float, w.z << 16), __builtin_bit_cast(float, w.z & 0xffff0000u), __builtin_bit_cast(float, w.w << 16), __builtin_bit_cast(float, w.w & 0xffff0000u)}; } } while (0)
            HALF_LOAD(0); HALF_CVT(0); RES_MATH(0); HALF_CVT(1); RES_MATH(1); RES_FENCE();
            HALF_LOAD(1); RES_FENCE(); RES_STORE(0); RES_STORE(1); HALF_CVT(0); RES_MATH(2); HALF_CVT(1); RES_MATH(3); RES_FENCE();
            RES_STORE(2); RES_STORE(3);
#undef HALF_LOAD
#undef HALF_CVT
        } else {
        RES_LOAD(0); RES_MATH(0); RES_FENCE();
        RES_LOAD(1); RES_FENCE(); RES_STORE(0); RES_MATH(1); RES_FENCE();
        RES_LOAD(2); RES_FENCE(); RES_STORE(1); RES_MATH(2); RES_FENCE();
        RES_LOAD(3); RES_FENCE(); RES_STORE(2); RES_MATH(3); RES_FENCE();
        RES_STORE(3);
        }
#undef RES_FENCE
#undef RES_LOAD
#undef RES_MATH
#undef RES_STORE
        if (nn) {
            int lq_; asm volatile("v_mbcnt_lo_u32_b32 %0, -1, 0\n\tv_mbcnt_hi_u32_b32 %0, -1, %0" : "=v"(lq_)); lq_ >>= 4;
#pragma unroll
            for (int ai = 0; ai < 2; ++ai)
#pragma unroll
                for (int m = 0; m < 4; ++m) { float ss = ssv[ai][m]; ss += shx<16>(ss); ss = sum32(ss);
                    if (lq_ == 0) atomicAdd(rowss + r0 + ai * 128 + m * 16, ss); }
        }
    }
};

struct EpiFfn {
    static constexpr bool PERM = true, AFTER_DRAIN = false;
    bf16* ACT_; const float* rowss; const float* bias;
    __device__ __forceinline__ void operator()(const pg8::f32x4 (&acc)[2][2][4][2], const pg8::Unit& u, int wr, int wc, int fr, int fq) const {
        asm volatile("" : "+v"(fr), "+v"(fq));
        unsigned long long zo_ = 0ull; asm volatile("" : "+s"(zo_)); bf16* ACT = ACT_ + zo_;
        const int cond = (u.pm < 32) ? 0 : 1 + ((u.pm - 32) >> 2);
        const float* bp = bias + (size_t)cond * BIAS_LD + u.pn * 256 + wc * 32 + fq * 8;
        float bg[8], bu[8];
        { const pg8::f32x4 b0 = *(const pg8::f32x4*)bp, b1 = *(const pg8::f32x4*)(bp + 4), b2 = *(const pg8::f32x4*)(bp + 128), b3 = *(const pg8::f32x4*)(bp + 132);
#pragma unroll
          for (int e = 0; e < 4; ++e) { bg[e] = b0[e]; bg[4 + e] = b1[e]; bu[e] = b2[e]; bu[4 + e] = b3[e]; } }
        float rsv[2][4];
#pragma unroll
        for (int ai = 0; ai < 2; ++ai)
#pragma unroll
            for (int m = 0; m < 4; ++m) rsv[ai][m] = rowss[u.pm * 256 + ai * 128 + wr * 64 + m * 16 + fr];
#pragma unroll
        for (int ai = 0; ai < 2; ++ai)
#pragma unroll
            for (int m = 0; m < 4; ++m) {
                asm volatile("" ::: "memory"); const int r = u.pm * 256 + ai * 128 + wr * 64 + m * 16 + fr;
                const float rs = 1.0f / sqrtf(rsv[ai][m] * (1.0f / 1024.0f) + EPSF);
                float g[8], up[8]; ld8(acc[ai][0][m], g); ld8(acc[ai][1][m], up);
#pragma unroll
                for (int e = 0; e < 8; ++e) g[e] = siluf(g[e] * rs + bg[e]) * (up[e] * rs + bu[e]);
                *(v4u*)(ACT + (size_t)r * D_FFN + u.pn * 128 + wc * 32 + fq * 8) = pack8(g);
            }
    }
};

struct RevOrder : pg8::StaticOrder {
    __device__ __forceinline__ bool next(int i, pg8::Unit& u) const { if (!pg8::StaticOrder::next(i, u)) return false; u.pm = nM - 1 - u.pm; return true; }
};

#ifndef CHAIN_QREP
#define CHAIN_QREP 1
#endif
#ifndef CHAIN_KVREP
#define CHAIN_KVREP 1
#endif
struct WinOrder : pg8::StaticOrder {
    bool sp;
    __device__ __forceinline__ bool next(int i, pg8::Unit& u) const {
        if (!sp) { if (!pg8::StaticOrder::next(i, u)) return false; u.pm = nM - 1 - u.pm; return true; }
        const int x = c & 7, k = c >> 3;
        if (k < 10) { if (i > 0) return false; u.pm = 39 - (5 * x + (k >> 1)); u.pn = 8 + (k & 1); return true; }
        const int j = (k - 10) + 22 * i; if (i > 1 || j >= 40) return false;
        u.pm = 39 - (5 * x + j % 5); u.pn = j / 5; return true;
    }
};
struct QOrder : pg8::StaticOrder {
    int cpm;
    __device__ __forceinline__ bool next(int i, pg8::Unit& u) const {
        if (cpm < 0) { if (!pg8::StaticOrder::next(i, u)) return false; u.pm = nM - 1 - u.pm; return true; }
        if (i >= nN * CHAIN_QREP) return false; u.pm = cpm; u.pn = i % nN; return true;
    }
};

struct KvOrder : pg8::StaticOrder {
    static constexpr bool SPLITK = true, HANDOFF = false;
    int cpm, cn0, cn1;
    __device__ __forceinline__ bool next(int i, pg8::Unit& u) const {
        u.k0 = 0; u.nkt = 2; u.role = 0; u.slab = -1; u.src2 = -1;
        if (cpm >= 0) { if (i >= (cn1 - cn0) * CHAIN_KVREP) return false; u.pm = cpm; u.pn = cn0 + i % (cn1 - cn0); return true; }
        if (G != 256) return pg8::StaticOrder::next(i, u);
        if (c < 120 || i > 1) return false;
        const int L = i * 136 + (c - 120); if (L >= nwg) return false;
        map(L, u); return true;
    }
};

struct PanelOrder : pg8::StaticOrder {
    __device__ __forceinline__ bool next(int i, pg8::Unit& u) const {
        if (G != 256 || nwg != 160) return pg8::StaticOrder::next(i, u);
        if (i > 0 || c >= 160) return false;
        const int x = c & 7, t = c >> 3; u.pm = 5 * x + t % 5; u.pn = t / 5; return true;
    }
};

#ifndef FO_NMAIN
#define FO_NMAIN 32
#endif
template <int NMAIN, int NTOT>
struct SplitOrder : pg8::StaticOrder {
    static constexpr bool SPLITK = true, HANDOFF = true;
    float* slab; unsigned* flags; unsigned epoch;
    __device__ __forceinline__ bool next(int i, pg8::Unit& u) const {
        u.src2 = -1;
        if (G != 256) { if (!pg8::StaticOrder::next(i, u)) return false; u.k0 = 0; u.nkt = NTOT; u.role = 0; u.slab = -1; return true; }
        if (c < 160) { if (i > 0) return false; pmap(c, u); u.k0 = 0; u.nkt = NMAIN; u.role = 1; u.slab = c; return true; }
        const int L = (i == 0) ? c - 160 : c - 64; if (i > 1 || L >= 160) return false;
        pmap(L, u); u.k0 = NMAIN; u.nkt = NTOT - NMAIN; u.role = 2; u.slab = L; return true;
    }
    __device__ __forceinline__ void pmap(int L, pg8::Unit& u) const { const int x = L & 7, t = L >> 3; u.pm = 5 * x + t % 5; u.pn = t / 5;
    }
};

template <int P, bool REV>
struct StreamKOrder : pg8::StaticOrder {
    static constexpr bool SPLITK = true, HANDOFF = true;
    float* slab; unsigned* flags; unsigned epoch;
    __device__ __forceinline__ bool next(int i, pg8::Unit& u) const {
        if (G != 256 || (nwg & 7)) { if (!pg8::StaticOrder::next(i, u)) return false; if (REV) u.pm = nM - 1 - u.pm; u.k0 = 0; u.nkt = 2 * P; u.role = 0; u.slab = -1; u.src2 = -1; return true; }
        const int x = c & 7, k = c >> 3, TX = nwg >> 3, R = TX * P;
        const int s = (k * R) >> 5, e = ((k + 1) * R) >> 5;
        const int ta = s / P, oa = s - ta * P, tb = (e - 1) / P, ob = e - tb * P, nseg = tb - ta + 1;
        if (i >= nseg) return false;
        const bool dl = ob < P;
        const int j = dl ? (i == 0 ? nseg - 1 : i - 1) : i;
        const int t = ta + j, lo = (j == 0) ? oa : 0, hi = (j == nseg - 1) ? ob : P;
        map2(x * TX + t, u); if (REV) u.pm = nM - 1 - u.pm;
        u.k0 = 2 * lo; u.nkt = 2 * (hi - lo); u.slab = -1; u.src2 = -1;
        if (hi < P) { u.role = 2; u.slab = c; }
        else if (lo == 0) u.role = 0;
        else { u.role = 1; u.slab = c - 8; const int sp = ((k - 1) * R) >> 5; if (sp > t * P) u.src2 = c - 16; }
        return true;
    }
};

struct Frame {
    LAS unsigned char* lds;
    volatile LAS unsigned* MISC;
    gu32* ctl;
    int tid, lane, wave, G, bx;
};

__device__ __forceinline__ int fresh_tid(int wave) { int lane; asm volatile("v_mbcnt_lo_u32_b32 %0, -1, 0\n\tv_mbcnt_hi_u32_b32 %0, -1, %0" : "=v"(lane)); return (wave << 6) | lane; }
__device__ __forceinline__ void frame_refresh(Frame& F) { const int t = fresh_tid(F.wave); F.tid = t; F.lane = t & 63; }
__device__ __forceinline__ float wave_sum(float v) {
    v += shx<1>(v); v += shx<2>(v); v += shx<4>(v); v += shx<8>(v); v += shx<16>(v); v = sum32(v);
    return v;
}

__device__ __forceinline__ void transpose_item(const float* W, int Nsrc, int Ksrc, bf16* WT, int Kdst, int k0, int n0dst, int sc0, float scale, LAS float* scr, int lane) {
    const bool zero = (sc0 < 0) || (k0 >= Ksrc);
    if (!zero) {
        float tv[32];
#pragma unroll
        for (int i = 0; i < 32; ++i) tv[i] = __builtin_nontemporal_load(&W[(size_t)(k0 + 2 * i + (lane >> 5)) * Nsrc + sc0 + (lane & 31)]);
#pragma unroll
        for (int i = 0; i < 32; ++i) scr[(2 * i + (lane >> 5)) * 33 + (lane & 31)] = tv[i] * scale;
    }
    LDS_WAIT(); asm volatile("" ::: "memory");
    const int c = lane & 7;
#pragma unroll
    for (int j = 0; j < 4; ++j) { const int n = (lane >> 3) + 8 * j; const LAS float* s = scr + (8 * c) * 33 + n;
        v4u o; if (zero) { o = (v4u){0u, 0u, 0u, 0u}; } else { o.x = cvtpk(s[0 * 33], s[1 * 33]); o.y = cvtpk(s[2 * 33], s[3 * 33]); o.z = cvtpk(s[4 * 33], s[5 * 33]); o.w = cvtpk(s[6 * 33], s[7 * 33]); }
        *(GAS v4u*)(WT + (size_t)(n0dst + n) * Kdst + k0 + 8 * c) = o; }
    LDS_WAIT(); asm volatile("" ::: "memory");
}
__device__ __forceinline__ int map_win(int nb) { return nb < 77 ? nb * 32 : -1; }
__device__ __forceinline__ int map_wqb(int nb) { const int c = nb * 32; if (c < 512) { const int pn = c >> 8, bj = (c >> 7) & 1, wc = (c >> 5) & 3; return (4 * pn + wc) * 96 + 32 * bj; } const int cc = c - 512, bj = cc >> 7, wc = (cc >> 5) & 3; return (4 * bj + wc) * 96 + 64; }
__device__ __forceinline__ int map_wkvb(int nb) { const int c = nb * 32, pn = c >> 8, bj = (c >> 7) & 1, wc = (c >> 5) & 3; return pn < 2 ? (4 * pn + wc) * 128 + 32 * bj : (4 * (pn - 2) + wc) * 128 + 64 + 32 * bj; }
__device__ __forceinline__ int map_wfi(int nb) { const int c = nb * 32, pn = c >> 8, bj = (c >> 7) & 1, j = c & 127; return bj * D_FFN + 128 * pn + j; }

__device__ __forceinline__ void p0_prologue(Frame& F, const Params& P) {
    unsigned char* ws = P.ws;
    if (F.bx < 192) {
        const int l = F.bx / 96, n0 = (F.bx % 96) * 64;
        LAS float* sil = (LAS float*)(F.lds);
        LAS float* red = (LAS float*)(F.lds + 12288);
        for (int i = F.tid; i < 3072; i += 512) { const int cd = i >> 10, k = i & 1023; const float x = (cd == 0) ? P.in[7][k] : P.in[6][(cd - 1) * 1024 + k]; sil[i] = siluf(x); }
        __syncthreads();
        const float* W = P.in[8] + (size_t)l * 1024 * 6144 + n0 + F.lane;
        float a0 = 0.f, a1 = 0.f, a2 = 0.f;
        const int kb = F.wave * 128;
#pragma unroll 16
        for (int k = 0; k < 128; ++k) { const float w = __builtin_nontemporal_load(&W[(size_t)(kb + k) * 6144]); a0 += sil[kb + k] * w; a1 += sil[1024 + kb + k] * w; a2 += sil[2048 + kb + k] * w; }
        red[(F.wave * 3 + 0) * 64 + F.lane] = a0; red[(F.wave * 3 + 1) * 64 + F.lane] = a1; red[(F.wave * 3 + 2) * 64 + F.lane] = a2;
        __syncthreads();
        if (F.tid < 192) { const int cd = F.tid >> 6, cl = F.tid & 63; float s = P.in[9][l * 6144 + n0 + cl];
#pragma unroll
            for (int w = 0; w < 8; ++w) s += red[(w * 3 + cd) * 64 + cl];
            ((float*)(ws + WS_MOD))[(l * 3 + cd) * 6144 + n0 + cl] = s; }
        __syncthreads();
    }
    if (F.bx == F.G - 1) {
        if (F.tid < 32) { const int l_ = F.tid >> 4, d_ = (F.tid >> 3) & 1, h_ = F.tid & 7; const float p_ = (d_ ? P.in[22] : P.in[21])[l_ * 8 + h_];
            ((float*)(ws + WS_TAB + 16384))[F.tid] = log1pf(-exp2f(-p_)) * 1.4426950408889634f; }
        float2* t64 = (float2*)(ws + WS_TAB); float2* t32 = t64 + 64 * 16;
        for (int i = F.tid; i < 64 * 16; i += 512) { const int pos = i >> 4, j = i & 15; const float inv = powf(10000.0f, -(float)j / 16.0f); const float ang = (float)pos * inv; float s, c; sincosf(ang, &s, &c); t64[i] = make_float2(c, s); }
        for (int i = F.tid; i < 64 * 8; i += 512) { const int pos = i >> 3, j = i & 7; const float inv = powf(10000.0f, -(float)j / 8.0f); const float ang = (float)pos * inv; float s, c; sincosf(ang, &s, &c); t32[i] = make_float2(c, s); }
    }
    {
        LAS float* scr = (LAS float*)(F.lds + RING_OFF + F.wave * 16384);
        const int gw = F.bx * NWAVES + F.wave, NGW = F.G * NWAVES;
        constexpr int I_IN = 16 * 80, I_QB = 4 * 24, I_KVB = 4 * 32, I_O = 16 * 32, I_FI = 16 * 176, I_FO = 44 * 32, I_L = I_IN + I_QB + I_KVB + I_O + I_FI + I_FO;
        for (int it = gw; it < 2 * I_L; it += NGW) {
            const int l = it / I_L; int r = it % I_L;
            unsigned char* wl = ws + WS_W + (size_t)l * LAYER_W;
            if (r < I_IN) { const int kb = r / 80, nb = r % 80; const int sc = map_win(nb); transpose_item(P.in[12] + (size_t)l * 1024 * 2464, 2464, 1024, (bf16*)(wl + W_IN_OFF), 1024, 64 * kb, 32 * nb, sc, (nb >= 16 && nb < 32) ? 0.125f : 1.0f, scr, F.lane); continue; } r -= I_IN;
            if (r < I_QB) { const int kb = r / 24, nb = r % 24; transpose_item(P.in[14] + (size_t)l * 256 * 768, 768, 256, (bf16*)(wl + W_QB_OFF), 256, 64 * kb, 32 * nb, map_wqb(nb), 1.0f, scr, F.lane); continue; } r -= I_QB;
            if (r < I_KVB) { const int kb = r / 32, nb = r % 32; transpose_item(P.in[16] + (size_t)l * 128 * 1024, 1024, 128, (bf16*)(wl + W_KVB_OFF), 256, 64 * kb, 32 * nb, map_wkvb(nb), 1.0f, scr, F.lane); continue; } r -= I_KVB;
            if (r < I_O) { const int kb = r / 32, nb = r % 32; transpose_item(P.in[25] + (size_t)l * 1024 * 1024, 1024, 1024, (bf16*)(wl + W_O_OFF), 1024, 64 * kb, 32 * nb, 32 * nb, 1.0f, scr, F.lane); continue; } r -= I_O;
            if (r < I_FI) { const int kb = r / 176, nb = r % 176; transpose_item(P.in[26] + (size_t)l * 1024 * N_FI, N_FI, 1024, (bf16*)(wl + W_FI_OFF), 1024, 64 * kb, 32 * nb, map_wfi(nb), 1.0f, scr, F.lane); continue; } r -= I_FI;
            { const int kb = r / 32, nb = r % 32; transpose_item(P.in[27] + (size_t)l * D_FFN * 1024, 1024, D_FFN, (bf16*)(wl + W_FO_OFF), D_FFN, 64 * kb, 32 * nb, 32 * nb, 1.0f, scr, F.lane); }
        }
    }
}

__device__ __forceinline__ void norm_phase(Frame& F, const Params& P, int layer, int which) {
    unsigned char* ws = P.ws;
    const int gw = F.bx * NWAVES + F.wave, NGW = F.G * NWAVES;
    const float* g = P.in[which == 0 ? 10 : 11] + layer * 1024;
    const float* mod = (const float*)(ws + WS_MOD) + (size_t)layer * 3 * 6144;
    bf16* H = (bf16*)(ws + WS_H);
    for (int m = gw; m < M_TOK; m += NGW) {
        const float* xrow;
        if (which == 0 && layer == 0) xrow = (m < M_CTX) ? P.in[0] + (size_t)m * 1024 : P.in[1] + (size_t)(m - M_CTX) * 1024;
        else xrow = P.out + (size_t)m * 1024;
        const int cond = (m < M_CTX) ? 0 : 1 + ((m - M_CTX) >> 10);
        const float* sh = mod + cond * 6144 + (which == 0 ? 0 : 3) * 1024;
        const float* sc = sh + 1024;
        const GAS f32x4* xr = (const GAS f32x4*)xrow + F.lane;
        f32x4 v[4]; float s = 0.f;
#pragma unroll
        for (int j = 0; j < 4; ++j) { v[j] = __builtin_nontemporal_load(xr + 64 * j); s += (v[j].x * v[j].x + v[j].y * v[j].y) + (v[j].z * v[j].z + v[j].w * v[j].w); }
        const float rstd = 1.0f / sqrtf(wave_sum(s) * (1.0f / 1024.0f) + EPSF);
        GAS unsigned long long* o8 = (GAS unsigned long long*)(H + (size_t)m * 1024) + F.lane;
#pragma unroll
        for (int j = 0; j < 4; ++j) {
            const f32x4 gg = *((const f32x4*)g + F.lane + 64 * j), s1 = *((const f32x4*)sc + F.lane + 64 * j), h1 = *((const f32x4*)sh + F.lane + 64 * j);
            const f32x4 y = v[j] * rstd * gg * (s1 + 1.0f) + h1;
            o8[64 * j] = (unsigned long long)cvtpk(y.x, y.y) | ((unsigned long long)cvtpk(y.z, y.w) << 32);
        }
    }
}
__device__ __forceinline__ void cache_rows_job(Frame& F, const Params& P, int layer) {
    unsigned char* ws = P.ws;
    const int gw = F.bx * NWAVES + F.wave, NGW = F.G * NWAVES;
    bf16* KVA = (bf16*)(ws + WS_KVA); bf16* KR = (bf16*)(ws + WS_KR);
    for (int cr = gw; cr < M_KV - M_TOK; cr += NGW) {
        const int m = M_TOK + cr, b = cr >> 8, n = cr & 255;
        const float* ck = P.in[2] + ((size_t)(b * 2 + layer) * 256 + n) * 128;
        const float* kr = P.in[3] + ((size_t)(b * 2 + layer) * 256 + n) * 32;
        const f32x2_t a = *((const f32x2_t*)ck + F.lane);
        *((unsigned*)(KVA + (size_t)m * 256) + F.lane) = cvtpk(a.x, a.y);
        if (F.lane < 16) { const f32x2_t k2 = *((const f32x2_t*)kr + F.lane); *((unsigned*)(KR + (size_t)m * 32) + F.lane) = cvtpk(k2.x, k2.y); }
    }
}
__device__ __forceinline__ void bias_job(Frame& F, const Params& P, int gw, int NGW) {
    unsigned char* ws = P.ws;
    for (int it = gw; it < 2 * (BIAS_LD / 8); it += NGW) {
        const int l = it / (BIAS_LD / 8), cc0 = (it % (BIAS_LD / 8)) * 8;
        const bf16* wrow = (cc0 < 2560) ? (const bf16*)(ws + WS_W + (size_t)l * LAYER_W + W_IN_OFF) + (size_t)cc0 * 1024 : (const bf16*)(ws + WS_W + (size_t)l * LAYER_W + W_FI_OFF) + (size_t)(cc0 - 2560) * 1024;
        const float* shb = (const float*)(ws + WS_MOD) + (size_t)l * 3 * 6144 + (cc0 < 2560 ? 0 : 3) * 1024 + F.lane * 16;
        f32x4 sh[3][4];
#pragma unroll
        for (int cd = 0; cd < 3; ++cd)
#pragma unroll
            for (int q = 0; q < 4; ++q) sh[cd][q] = *(const f32x4*)(shb + cd * 6144 + 4 * q);
        float res[3] = {0.f, 0.f, 0.f};
#pragma unroll
        for (int jb = 0; jb < 2; ++jb) {
        v4u wv[4][2];
#pragma unroll
        for (int j = 0; j < 4; ++j) { wv[j][0] = *(const v4u*)(wrow + (size_t)(4 * jb + j) * 1024 + F.lane * 16); wv[j][1] = *(const v4u*)(wrow + (size_t)(4 * jb + j) * 1024 + F.lane * 16 + 8); }
#pragma unroll
        for (int j = 0; j < 4; ++j) {
            float wf[16];
#pragma unroll
            for (int h = 0; h < 2; ++h) { const v4u x = wv[j][h];
                wf[8 * h + 0] = b2f((unsigned short)(x.x & 0xffffu)); wf[8 * h + 1] = b2f((unsigned short)(x.x >> 16)); wf[8 * h + 2] = b2f((unsigned short)(x.y & 0xffffu)); wf[8 * h + 3] = b2f((unsigned short)(x.y >> 16));
                wf[8 * h + 4] = b2f((unsigned short)(x.z & 0xffffu)); wf[8 * h + 5] = b2f((unsigned short)(x.z >> 16)); wf[8 * h + 6] = b2f((unsigned short)(x.w & 0xffffu)); wf[8 * h + 7] = b2f((unsigned short)(x.w >> 16)); }
#pragma unroll
            for (int cd = 0; cd < 3; ++cd) { float a = 0.f;
#pragma unroll
                for (int e = 0; e < 16; ++e) a += wf[e] * sh[cd][e >> 2][e & 3];
                a = wave_sum(a);
                res[cd] = (F.lane == 4 * jb + j) ? a : res[cd]; }
        }
        }
        if (F.lane < 8) { float* bo = (float*)(ws + WS_BIAS) + (size_t)l * 3 * BIAS_LD + cc0 + F.lane; bo[0] = res[0]; bo[BIAS_LD] = res[1]; bo[2 * BIAS_LD] = res[2]; }
    }
}

struct MixP {
    const bf16 *Q, *KN, *KR, *VT, *RQ, *RK, *RKT, *RVT, *RG;
    bf16* MIX;
    const float *s_f0, *s_b0;
    const float *p_f, *p_b;
    const float *g_gn, *b_gn;
    float *out_sf, *out_sb;
    int layer;
    const float* lgtab;
    int defer_states;
};
constexpr int MIX_KBYTES = 128 * 208, MIX_VSTR = 272, MIX_VBYTES = 64 * MIX_VSTR, MIX_BUF = MIX_KBYTES + MIX_VBYTES;

#ifndef MIX_DEFER
#define MIX_DEFER 1
#endif
__device__ __forceinline__ int mix_code(int v, int G, bool att, int i) {
    if (G == 256 && MIX_DEFER) {
        if (att) { if (v < 64) return i == 0 ? v : (i == 1 ? 384 + v : -1); return i == 0 ? 384 + v : -1; }
        if (v < 64) return -1;
        if (v < 128) return i == 0 ? v : -1;
        return i < 2 ? 128 + 2 * (v - 128) + i : -1;
    }
    if (G == 256) {
        if (att) { if (v < 64) return i == 0 ? v : (i <= 2 ? 384 + 2 * v + (i - 1) : -1); if (v < 128) return i < 2 ? 384 + 2 * v + i : -1; return -1; }
        if (v < 64) return -1;
        if (v < 128) return i == 0 ? v : -1;
        return i < 2 ? 128 + 2 * (v - 128) + i : -1;
    }
    if (att) { const int j = v + i * G; return j < 64 ? j : (j < 320 ? 384 + (j - 64) : -1); }
    const int j = v + i * G; return j < 320 ? 64 + j : -1;
}

template <bool ATT>
__device__ __forceinline__ void mix_run(const MixP& P, LAS unsigned char* lds, int v, int G, int tid) {
    constexpr int DK = ATT ? 96 : 64, NKS = DK / 16, KSTR = DK * 2 + 16, KCH = DK / 8, NKL = ATT ? 3 : 2;
    int code = mix_code(v, G, ATT, 0);
    if (code < 0) return;
    asm volatile("" : "+v"(tid));
    const int lane = tid & 63, w = __builtin_amdgcn_readfirstlane(tid >> 6), c = lane & 31, hh = lane >> 5;
    int krow[NKL], kch[NKL];
#pragma unroll
    for (int i = 0; i < NKL; ++i) { const int cid = tid + 512 * i; krow[i] = ATT ? cid / KCH : cid >> 3; kch[i] = ATT ? cid % KCH : cid & 7; }
    const int vrow0 = tid >> 4, vch = tid & 15;
    v4u rk0[NKL], rk1[NKL], rv0[2], rv1[2];
    pg8::bf16x8 qf[NKS];
    LAS unsigned char* const kb0 = lds, * const vb0 = lds + MIX_KBYTES, * const kb1 = lds + MIX_BUF, * const vb1 = lds + MIX_BUF + MIX_KBYTES;
#define MIX_DECODE(code_, lat_, b_, h_, qb_) const bool lat_ = (code_) < 128; const int uu_##b_ = lat_ ? ((code_) & 63) : (((code_) - 128) & 255); \
        const int b_ = lat_ ? (uu_##b_ >> 5) : (uu_##b_ >> 3), h_ = lat_ ? ((uu_##b_ >> 2) & 7) : (uu_##b_ & 7), qb_ = lat_ ? (uu_##b_ & 3) : 0
#define MIX_KROW(lat_, b_, ci) ((lat_) ? (((ci) < 8) ? M_CTX + (b_) * 1024 + 128 * (ci) : M_TOK + (b_) * 256 + 128 * ((ci) - 8)) : (b_) * 256 + 128 * (ci))
#define MIX_LDNT(p) __builtin_nontemporal_load((const v4u*)(p))
#define MIX_ISSUE(SK_, SV_, lat_, b_, h_, ci) do { const int kr_ = MIX_KROW(lat_, b_, ci); \
        _Pragma("unroll") for (int i_ = 0; i_ < NKL; ++i_) { \
            if (ATT) SK_[i_] = (kch[i_] < 8) ? MIX_LDNT(P.KN + (size_t)(kr_ + krow[i_]) * 512 + (h_) * 64 + kch[i_] * 8) : MIX_LDNT(P.KR + (size_t)(kr_ + krow[i_]) * 32 + (kch[i_] - 8) * 8); \
            else SK_[i_] = MIX_LDNT(P.RK + (size_t)(kr_ + krow[i_]) * 512 + (h_) * 64 + kch[i_] * 8); } \
        _Pragma("unroll") for (int i_ = 0; i_ < 2; ++i_) { \
            if (ATT) SV_[i_] = MIX_LDNT(P.VT + (size_t)((h_) * 64 + vrow0 + 32 * i_) * M_KV + kr_ + vch * 8); \
            else SV_[i_] = MIX_LDNT(P.RVT + (size_t)((h_) * 64 + vrow0 + 32 * i_) * M_TOK + kr_ + vch * 8); } } while (0)
#define MIX_STORE(SK_, SV_, kb_, vb_) do { \
        _Pragma("unroll") for (int i_ = 0; i_ < NKL; ++i_) *(LAS v4u*)((kb_) + krow[i_] * KSTR + kch[i_] * 16) = SK_[i_]; \
        _Pragma("unroll") for (int i_ = 0; i_ < 2; ++i_) { LAS unsigned char* p_ = (vb_) + (vrow0 + 32 * i_) * MIX_VSTR + (vch >> 1) * 32 + (vch & 1) * 8; \
            *(LAS u32x2*)p_ = (u32x2){SV_[i_].x, SV_[i_].y}; *(LAS u32x2*)(p_ + 16) = (u32x2){SV_[i_].z, SV_[i_].w}; } } while (0)
#define MIX_LOADQ(QF_, lat_, b_, h_, qb_) do { const int qr_ = ((lat_) ? M_CTX + (b_) * 1024 : (b_) * 256) + (qb_) * 256 + w * 32 + c; \
        const bf16* qp_ = ATT ? P.Q + (size_t)qr_ * 768 + (h_) * 96 : P.RQ + (size_t)qr_ * 512 + (h_) * 64; \
        _Pragma("unroll") for (int ks_ = 0; ks_ < NKS; ++ks_) QF_[ks_] = *(const pg8::bf16x8*)(qp_ + 16 * ks_ + 8 * hh); } while (0)
#define MIX_DECAY(SX_, kblk_, kb0_) do { \
        if ((kblk_) == qblk) { \
            _Pragma("unroll") for (int r = 0; r < 16; ++r) { const float d_ = (float)(qpos - ((kb0_) + (r & 3) + 8 * (r >> 2))); \
                const float e_ = d_ > 0.f ? d_ * lgf2 : -d_ * lgb2; float w_ = __builtin_amdgcn_exp2f(e_); w_ = (d_ == 0.f) ? 2.0f : w_; SX_[r] *= w_; } \
        } else { const bool fw_ = (kblk_) < qblk; const float lg_ = fw_ ? lgf2 : -lgb2; const float eq_ = __builtin_amdgcn_exp2f((float)(qpos - (kb0_)) * lg_); \
              \
            const float c0_ = eq_, c1_ = eq_ * (fw_ ? tf8[0] : tb8[0]), c2_ = eq_ * (fw_ ? tf8[1] : tb8[1]), c3_ = eq_ * (fw_ ? tf8[2] : tb8[2]); \
            const float u1_ = fw_ ? tf1[0] : tb1[0], u2_ = fw_ ? tf1[1] : tb1[1], u3_ = fw_ ? tf1[2] : tb1[2]; \
            SX_[0] *= c0_; SX_[1] *= c0_ * u1_; SX_[2] *= c0_ * u2_; SX_[3] *= c0_ * u3_; \
            SX_[4] *= c1_; SX_[5] *= c1_ * u1_; SX_[6] *= c1_ * u2_; SX_[7] *= c1_ * u3_; \
            SX_[8] *= c2_; SX_[9] *= c2_ * u1_; SX_[10] *= c2_ * u2_; SX_[11] *= c2_ * u3_; \
            SX_[12] *= c3_; SX_[13] *= c3_ * u1_; SX_[14] *= c3_ * u2_; SX_[15] *= c3_ * u3_; } } while (0)
#define MIX_QK(SA_, SB_, kt_) do { \
        _Pragma("unroll") \
        for (int ks = 0; ks < NKS; ++ks) { \
            const pg8::bf16x8 a0 = *(const LAS pg8::bf16x8*)((kt_) + c * KSTR + (16 * ks + 8 * hh) * 2); \
            const pg8::bf16x8 a1 = *(const LAS pg8::bf16x8*)((kt_) + (32 + c) * KSTR + (16 * ks + 8 * hh) * 2); \
            SA_ = __builtin_amdgcn_mfma_f32_32x32x16_bf16(a0, qf[ks], SA_, 0, 0, 0); \
            SB_ = __builtin_amdgcn_mfma_f32_32x32x16_bf16(a1, qf[ks], SB_, 0, 0, 0); \
        } } while (0)
#define MIX_EW(SA_, SB_, ci, sub, STATE_) do { \
        if (ATT) { \
            _Pragma("unroll") \
            for (int r = 0; r < 16; ++r) { SA_[r] = __builtin_amdgcn_exp2f(SA_[r]); SB_[r] = __builtin_amdgcn_exp2f(SB_[r]); lsum += SA_[r] + SB_[r]; } \
        } else if (!(STATE_)) { \
            const int kblk0_ = 4 * (ci) + 2 * (sub), kpos0_ = 128 * (ci) + 64 * (sub) + 4 * hh; \
            MIX_DECAY(SA_, kblk0_, kpos0_); MIX_DECAY(SB_, kblk0_ + 1, kpos0_ + 32); \
        } else { \
            const float wq = ((sub) == 0) ? __builtin_amdgcn_exp2f((float)(qpos + 1) * lgf2) : __builtin_amdgcn_exp2f((float)(1024 - qpos) * lgb2); \
            _Pragma("unroll") \
            for (int r = 0; r < 16; ++r) { SA_[r] *= wq; SB_[r] *= wq; } \
        } } while (0)
#define MIX_PV(SA_, SB_, vb, sub) do { \
        pg8::bf16x8 pf[2][2]; \
        { v4u t0, t1, t2, t3; \
          t0 = (v4u){cvtpk(SA_[0], SA_[1]), cvtpk(SA_[2], SA_[3]), cvtpk(SA_[4], SA_[5]), cvtpk(SA_[6], SA_[7])}; \
          t1 = (v4u){cvtpk(SA_[8], SA_[9]), cvtpk(SA_[10], SA_[11]), cvtpk(SA_[12], SA_[13]), cvtpk(SA_[14], SA_[15])}; \
          t2 = (v4u){cvtpk(SB_[0], SB_[1]), cvtpk(SB_[2], SB_[3]), cvtpk(SB_[4], SB_[5]), cvtpk(SB_[6], SB_[7])}; \
          t3 = (v4u){cvtpk(SB_[8], SB_[9]), cvtpk(SB_[10], SB_[11]), cvtpk(SB_[12], SB_[13]), cvtpk(SB_[14], SB_[15])}; \
          pf[0][0] = __builtin_bit_cast(pg8::bf16x8, t0); pf[0][1] = __builtin_bit_cast(pg8::bf16x8, t1); pf[1][0] = __builtin_bit_cast(pg8::bf16x8, t2); pf[1][1] = __builtin_bit_cast(pg8::bf16x8, t3); } \
        _Pragma("unroll") \
        for (int kt = 0; kt < 2; ++kt) \
            _Pragma("unroll") \
            for (int s = 0; s < 2; ++s) { \
                const int koff = (64 * (sub) + 32 * kt + 16 * s) * 2 + 16 * hh; \
                const pg8::bf16x8 vf0 = *(const LAS pg8::bf16x8*)((vb) + c * MIX_VSTR + koff); \
                const pg8::bf16x8 vf1 = *(const LAS pg8::bf16x8*)((vb) + (32 + c) * MIX_VSTR + koff); \
                o0 = __builtin_amdgcn_mfma_f32_32x32x16_bf16(vf0, pf[kt][s], o0, 0, 0, 0); \
                o1 = __builtin_amdgcn_mfma_f32_32x32x16_bf16(vf1, pf[kt][s], o1, 0, 0, 0); \
            } } while (0)
#define MIX_COMPUTE(kb, vb, ci, STATE_) do { \
        f32x16 sa0 = {}, sb0 = {}, sa1 = {}, sb1 = {}; \
        MIX_QK(sa0, sb0, (kb)); \
        MIX_QK(sa1, sb1, (kb) + 64 * KSTR); \
        MIX_EW(sa0, sb0, ci, 0, STATE_); \
        MIX_PV(sa0, sb0, vb, 0); \
        MIX_EW(sa1, sb1, ci, 1, STATE_); \
        MIX_PV(sa1, sb1, vb, 1); \
        } while (0)
    {
        MIX_DECODE(code, lat0, b0, h0, qb0);
        MIX_LOADQ(qf, lat0, b0, h0, qb0);
        MIX_ISSUE(rk0, rv0, lat0, b0, h0, 0);
        MIX_ISSUE(rk1, rv1, lat0, b0, h0, 1);
    }
    for (int ui = 0; code >= 0; ++ui) {
        const int ncode = mix_code(v, G, ATT, ui + 1);
        const int pcode = ncode >= 0 ? ncode : code;
        MIX_DECODE(code, lat, b, h, qb);
        MIX_DECODE(pcode, nlat, nb, nh, nqb);
        const int nld = lat ? (ATT ? 10 : 8) : 2;
        const int qpos = qb * 256 + w * 32 + c;
        const int qblk = qb * 8 + w;
        const int qrow = (lat ? M_CTX + b * 1024 : b * 256) + qpos;
        float lgf2 = 0.f, lgb2 = 0.f;
        float tf1[3] = {1.f, 1.f, 1.f}, tf8[3] = {1.f, 1.f, 1.f}, tb1[3] = {1.f, 1.f, 1.f}, tb8[3] = {1.f, 1.f, 1.f};
        if (!ATT) { lgf2 = P.lgtab[h]; lgb2 = P.lgtab[8 + h];
#pragma unroll
            for (int i = 0; i < 3; ++i) { tf1[i] = __builtin_amdgcn_exp2f(-(float)(i + 1) * lgf2); tf8[i] = __builtin_amdgcn_exp2f(-(float)(8 * (i + 1)) * lgf2);
                                          tb1[i] = __builtin_amdgcn_exp2f((float)(i + 1) * lgb2); tb8[i] = __builtin_amdgcn_exp2f((float)(8 * (i + 1)) * lgb2); } }

        f32x16 o0 = {}, o1 = {};
        float lsum = 0.f;
        for (int c2 = 0; c2 < nld; c2 += 2) {
            const bool lastp = (c2 + 2 >= nld);
            const bool ilat = lastp ? nlat : lat; const int ib = lastp ? nb : b, ih = lastp ? nh : h, ic = lastp ? 0 : c2 + 2;
            MIX_STORE(rk0, rv0, kb0, vb0);
            __syncthreads();
            MIX_ISSUE(rk0, rv0, ilat, ib, ih, ic);
            MIX_COMPUTE(kb0, vb0, c2, 0);
            MIX_STORE(rk1, rv1, kb1, vb1);
            __syncthreads();
            MIX_ISSUE(rk1, rv1, ilat, ib, ih, ic + 1);
            MIX_COMPUTE(kb1, vb1, c2 + 1, 0);
        }
        if (!ATT && lat) {
#pragma unroll
            for (int i = 0; i < NKL; ++i) { unsigned wd[4];
#pragma unroll
                for (int q = 0; q < 4; ++q) { const int d0 = kch[i] * 8 + 2 * q, rr = krow[i] & 63; wd[q] = (d0 == rr ? 0x3F80u : 0u) | (d0 + 1 == rr ? 0x3F800000u : 0u); }
                *(LAS v4u*)(kb0 + krow[i] * KSTR + kch[i] * 16) = (v4u){wd[0], wd[1], wd[2], wd[3]}; }
            const float* Sf = P.s_f0 + ((size_t)(b * 2 + P.layer) * 8 + h) * 4096; const float* Sb = P.s_b0 + ((size_t)(b * 2 + P.layer) * 8 + h) * 4096;
#pragma unroll
            for (int i = 0; i < 8; ++i) { const int e = tid + 512 * i, dk = e >> 6, dv = e & 63;
                const int dkp = (dk & ~15) | ((dk & 4) << 1) | ((dk & 8) >> 1) | (dk & 3);
                *(LAS bf16*)(vb0 + dv * MIX_VSTR + dkp * 2) = f2b(Sf[e]); *(LAS bf16*)(vb0 + dv * MIX_VSTR + (64 + dkp) * 2) = f2b(Sb[e]); }
            __syncthreads();
            MIX_COMPUTE(kb0, vb0, 0, 1);
            __syncthreads();
        }
        MIX_LOADQ(qf, nlat, nb, nh, nqb);
        int lane_e = lane; asm volatile("" : "+v"(lane_e));
        const int c_e = lane_e & 31, hh_e = lane_e >> 5; const int qrow_e = (lat ? M_CTX + b * 1024 : b * 256) + qb * 256 + w * 32 + c_e;
        if (ATT) {
            lsum = sum32(lsum);
            const float inv = 1.0f / lsum;
            bf16* op = P.MIX + (size_t)qrow_e * 1024 + 512 + h * 64 + 8 * hh_e;
#pragma unroll
            for (int dvt = 0; dvt < 2; ++dvt)
#pragma unroll
                for (int g = 0; g < 4; g += 2) {
                    unsigned ax, ay, bx, by;
                    if (dvt == 0) { ax = cvtpk(o0[4 * g] * inv, o0[4 * g + 1] * inv); ay = cvtpk(o0[4 * g + 2] * inv, o0[4 * g + 3] * inv); bx = cvtpk(o0[4 * g + 4] * inv, o0[4 * g + 5] * inv); by = cvtpk(o0[4 * g + 6] * inv, o0[4 * g + 7] * inv); }
                    else          { ax = cvtpk(o1[4 * g] * inv, o1[4 * g + 1] * inv); ay = cvtpk(o1[4 * g + 2] * inv, o1[4 * g + 3] * inv); bx = cvtpk(o1[4 * g + 4] * inv, o1[4 * g + 5] * inv); by = cvtpk(o1[4 * g + 6] * inv, o1[4 * g + 7] * inv); }
                    { auto r_ = __builtin_amdgcn_permlane32_swap(ax, bx, false, false); ax = r_[0]; bx = r_[1]; }
                    { auto r_ = __builtin_amdgcn_permlane32_swap(ay, by, false, false); ay = r_[0]; by = r_[1]; }
                    *(v4u*)(op + 32 * dvt + 8 * g) = (v4u){ax, ay, bx, by};
                }
        } else {
            float sum = 0.f;
#pragma unroll
            for (int r = 0; r < 16; ++r) sum += o0[r] + o1[r];
            sum = sum32(sum);
            const float mu = sum * (1.0f / 64.0f);
            float var = 0.f;
#pragma unroll
            for (int r = 0; r < 16; ++r) { const float a = o0[r] - mu, bq = o1[r] - mu; var += a * a + bq * bq; }
            var = sum32(var);
            const float rstd = 1.0f / sqrtf(var * (1.0f / 64.0f) + EPSF);
            const int cbase = h * 64 + 4 * hh_e;
            bf16* op = P.MIX + (size_t)qrow_e * 1024 + h * 64 + 8 * hh_e;
            const bf16* rgp = P.RG + (size_t)qrow_e * 512 + cbase;
#pragma unroll
            for (int dvt = 0; dvt < 2; ++dvt)
#pragma unroll
                for (int g = 0; g < 4; g += 2) {
                    unsigned pk[2][2];
#pragma unroll
                    for (int gi = 0; gi < 2; ++gi) {
                        const int cc = 32 * dvt + 8 * (g + gi);
                        const f32x4 gg = *(const f32x4*)(P.g_gn + cbase + cc), bb = *(const f32x4*)(P.b_gn + cbase + cc);
                        const u32x2 rg2 = *(const u32x2*)(rgp + cc);
                        float y[4];
#pragma unroll
                        for (int i = 0; i < 4; ++i) { const float ov = dvt ? o1[4 * (g + gi) + i] : o0[4 * (g + gi) + i]; y[i] = (ov - mu) * rstd * gg[i] + bb[i]; }
                        y[0] *= b2f((unsigned short)(rg2.x & 0xffffu)); y[1] *= b2f((unsigned short)(rg2.x >> 16)); y[2] *= b2f((unsigned short)(rg2.y & 0xffffu)); y[3] *= b2f((unsigned short)(rg2.y >> 16));
                        pk[gi][0] = cvtpk(y[0], y[1]); pk[gi][1] = cvtpk(y[2], y[3]);
                    }
                    { auto r_ = __builtin_amdgcn_permlane32_swap(pk[0][0], pk[1][0], false, false); pk[0][0] = r_[0]; pk[1][0] = r_[1]; }
                    { auto r_ = __builtin_amdgcn_permlane32_swap(pk[0][1], pk[1][1], false, false); pk[0][1] = r_[0]; pk[1][1] = r_[1]; }
                    *(v4u*)(op + 32 * dvt + 8 * g) = (v4u){pk[0][0], pk[0][1], pk[1][0], pk[1][1]};
                }
            if (!lat && !P.defer_states) {
                const int st = w >> 2, dkt = (w >> 1) & 1, dvt = w & 1;
                const float lg = st ? lgb2 : lgf2;
                float stj[8];
#pragma unroll
                for (int j = 0; j < 8; ++j) stj[j] = __builtin_amdgcn_exp2f((st ? (float)j : -(float)j) * lg);
                const bf16* kp = P.RKT + (size_t)(h * 64 + 32 * dkt + c_e) * M_CTX + b * 256 + 8 * hh_e;
                const bf16* vp = P.RVT + (size_t)(h * 64 + 32 * dvt + c_e) * M_TOK + b * 256 + 8 * hh_e;
                f32x16 acc = {};
                v4u kra[4], krb[4]; pg8::bf16x8 vra[4], vrb[4];
#define ST_LOAD(KR_, VR_, bt_) do { _Pragma("unroll") for (int i = 0; i < 4; ++i) { KR_[i] = *(const v4u*)(kp + 16 * (4 * (bt_) + i)); VR_[i] = *(const pg8::bf16x8*)(vp + 16 * (4 * (bt_) + i)); } } while (0)
#define ST_COMP(KR_, VR_, bt_) do { _Pragma("unroll") for (int i = 0; i < 4; ++i) { \
                    const int tok0 = 16 * (4 * (bt_) + i) + 8 * hh_e; float kv[8]; \
                    kv[0] = b2f((unsigned short)(KR_[i].x & 0xffffu)); kv[1] = b2f((unsigned short)(KR_[i].x >> 16)); kv[2] = b2f((unsigned short)(KR_[i].y & 0xffffu)); kv[3] = b2f((unsigned short)(KR_[i].y >> 16)); \
                    kv[4] = b2f((unsigned short)(KR_[i].z & 0xffffu)); kv[5] = b2f((unsigned short)(KR_[i].z >> 16)); kv[6] = b2f((unsigned short)(KR_[i].w & 0xffffu)); kv[7] = b2f((unsigned short)(KR_[i].w >> 16)); \
                    const float wb_ = __builtin_amdgcn_exp2f((st ? (float)tok0 : (float)(255 - tok0)) * lg); _Pragma("unroll") for (int j = 0; j < 8; ++j) kv[j] *= wb_ * stj[j]; \
                    const pg8::bf16x8 kfr = __builtin_bit_cast(pg8::bf16x8, pack8(kv)); \
                    acc = __builtin_amdgcn_mfma_f32_32x32x16_bf16(kfr, VR_[i], acc, 0, 0, 0); } } while (0)
                ST_LOAD(kra, vra, 0); ST_LOAD(krb, vrb, 1);
                ST_COMP(kra, vra, 0); ST_LOAD(kra, vra, 2);
                ST_COMP(krb, vrb, 1); ST_LOAD(krb, vrb, 3);
                ST_COMP(kra, vra, 2); ST_COMP(krb, vrb, 3);
#undef ST_LOAD
#undef ST_COMP
                float* so = (st ? P.out_sb : P.out_sf) + ((size_t)(b * 2 + P.layer) * 8 + h) * 4096 + 32 * dvt + c_e;
#pragma unroll
                for (int r = 0; r < 16; ++r) { const int dk = 32 * dkt + (r & 3) + 8 * (r >> 2) + 4 * hh_e; __builtin_nontemporal_store(acc[r], so + dk * 64); }
            }
        }
        code = ncode;
    }
#undef MIX_DECODE
#undef MIX_KROW
#undef MIX_ISSUE
#undef MIX_STORE
#undef MIX_LOADQ
#undef MIX_DECAY
#undef MIX_COMPUTE
#undef MIX_QK
#undef MIX_EW
#undef MIX_PV
}

__device__ __forceinline__ void ret_state_job(const MixP& P, int b, int h, int w, int lane) {
    const float lgf2 = P.lgtab[h], lgb2 = P.lgtab[8 + h];
    int lane_e = lane; asm volatile("" : "+v"(lane_e));
    const int c_e = lane_e & 31, hh_e = lane_e >> 5;
    const int st = w >> 2, dkt = (w >> 1) & 1, dvt = w & 1;
    const float lg = st ? lgb2 : lgf2;
    const bf16* kp = P.RKT + (size_t)(h * 64 + 32 * dkt + c_e) * M_CTX + b * 256 + 8 * hh_e;
    const bf16* vp = P.RVT + (size_t)(h * 64 + 32 * dvt + c_e) * M_TOK + b * 256 + 8 * hh_e;
    f32x16 acc = {};
#pragma nounroll
    for (int bt = 0; bt < 4; ++bt) {
        v4u kr[4]; pg8::bf16x8 vr[4];
#pragma unroll
        for (int i = 0; i < 4; ++i) { kr[i] = *(const v4u*)(kp + 16 * (4 * bt + i)); vr[i] = *(const pg8::bf16x8*)(vp + 16 * (4 * bt + i)); }
#pragma unroll
        for (int i = 0; i < 4; ++i) {
            const int tok0 = 16 * (4 * bt + i) + 8 * hh_e; float kv[8];
            kv[0] = b2f((unsigned short)(kr[i].x & 0xffffu)); kv[1] = b2f((unsigned short)(kr[i].x >> 16)); kv[2] = b2f((unsigned short)(kr[i].y & 0xffffu)); kv[3] = b2f((unsigned short)(kr[i].y >> 16));
            kv[4] = b2f((unsigned short)(kr[i].z & 0xffffu)); kv[5] = b2f((unsigned short)(kr[i].z >> 16)); kv[6] = b2f((unsigned short)(kr[i].w & 0xffffu)); kv[7] = b2f((unsigned short)(kr[i].w >> 16));
#pragma unroll
            for (int j = 0; j < 8; ++j) kv[j] *= __builtin_amdgcn_exp2f((st ? (float)(tok0 + j) : (float)(255 - tok0 - j)) * lg);
            const pg8::bf16x8 kfr = __builtin_bit_cast(pg8::bf16x8, pack8(kv));
            acc = __builtin_amdgcn_mfma_f32_32x32x16_bf16(kfr, vr[i], acc, 0, 0, 0);
        }
    }
    float* so = (st ? P.out_sb : P.out_sf) + ((size_t)(b * 2 + P.layer) * 8 + h) * 4096 + 32 * dvt + c_e;
#pragma unroll
    for (int r = 0; r < 16; ++r) { const int dk = 32 * dkt + (r & 3) + 8 * (r >> 2) + 4 * hh_e; __builtin_nontemporal_store(acc[r], so + dk * 64); }
}

__device__ __forceinline__ void mix_phase(Frame& F, const MixP& P) {
    mix_run<false>(P, F.lds, F.bx, F.G, F.tid);
    __syncthreads();
    mix_run<true>(P, F.lds, F.bx, F.G, F.tid);
}

__global__ void __launch_bounds__(NWAVES * 64, 2) mk_fwd(Params P) {
    extern __shared__ __attribute__((aligned(16))) unsigned char lds_raw[];
    Frame F;
    F.lds = (LAS unsigned char*)lds_raw;
    F.MISC = (volatile LAS unsigned*)(F.lds + MISC_OFF);
    F.wave = __builtin_amdgcn_readfirstlane((int)threadIdx.x >> 6); frame_refresh(F);
    F.G = gridDim.x; F.bx = blockIdx.x;
    unsigned char* ws = P.ws;
    F.ctl = (gu32*)(ws + WS_CTL);
    for (int u = F.tid; u < (LDS_BYTES - LDSCTL_OFF) / 4; u += NWAVES * 64) ((LAS unsigned*)(F.lds + LDSCTL_OFF))[u] = 0u;
    __syncthreads();
    XcdBarrier bar; bar.bar = (unsigned*)(F.ctl + CW_BAR); bar.x = 0; bar.st = nullptr;
    if (!MK_PER_PHASE) bar = xcd_barrier_post((unsigned*)(F.ctl + CW_BAR), F.MISC + 8, F.tid);
    const int lo = P.ph_lo, hi = P.ph_hi;
#define IN(k) (lo <= (k) && (k) < hi)
#define SEAM(k) do { if (IN(k) && IN((k) + 1)) { xcd_barrier(bar, fresh_tid(F.wave)); if (REPS(15) > 1) xcd_barrier(bar, fresh_tid(F.wave)); } } while (0)

    if (PH_EN(0) && IN(0)) { for (int rep = 0; rep < REPS(0); ++rep) { frame_refresh(F); p0_prologue(F, P); if (rep + 1 < REPS(0)) xcd_barrier(bar, fresh_tid(F.wave)); } SEAM(0); }

    const float2* tab64 = (const float2*)(ws + WS_TAB); const float2* tab32 = tab64 + 64 * 16;
    for (int l = 0; l < 2; ++l) {
        const int pb = 1 + 8 * l;
        const bool chain = F.G == 256 && !MK_PER_PHASE;
        unsigned char* wl = ws + WS_W + (size_t)l * LAYER_W;
        const float* mod = (const float*)(ws + WS_MOD) + (size_t)l * 3 * 6144;
        float* const ssb = (float*)(F.ctl + CW_SS);
        float* sskv = ssb + (size_t)(l * 2 + 1) * M_TOK;
        const float* bias = (const float*)(ws + WS_BIAS) + (size_t)l * 3 * BIAS_LD;
        if (l == 0 && PH_EN(1) && IN(pb + 0)) { for (int rep = 0; rep < REPS(1); ++rep) { frame_refresh(F); norm_phase(F, P, 0, 0); cache_rows_job(F, P, 0); if (F.G < 64) bias_job(F, P, F.bx * NWAVES + F.wave, F.G * NWAVES); if (rep + 1 < REPS(1)) xcd_barrier(bar, fresh_tid(F.wave)); } SEAM(pb + 0); }
        if (PH_EN(2) && IN(pb + 1)) {
            unsigned long long zz_ = 0ull; asm volatile("" : "+s"(zz_)); unsigned char* const ws = P.ws + zz_; (void)ws;
            unsigned char* const wl = ws + WS_W + (size_t)l * LAYER_W; (void)wl; const float* const mod = (const float*)(ws + WS_MOD) + (size_t)l * 3 * 6144; (void)mod;
            const float* const bias = (const float*)(ws + WS_BIAS) + (size_t)l * 3 * BIAS_LD; (void)bias; float* const ssb = (float*)(F.ctl + CW_SS); (void)ssb; float* const sskv = ssb + (size_t)(l * 2 + 1) * M_TOK; (void)sskv;
            {
                pg8::Gemm g{(const pg8::bf16_t*)(ws + WS_H), (const pg8::bf16_t*)(wl + W_IN_OFF), M_TOK, N_IN, 1024}; WinOrder S; S.init(M_TOK, N_IN, F.G, F.bx); S.sp = chain;
                EpiG1 E{ws, {P.in[13] + l * 256, P.in[15] + l * 128, P.in[20] + l * 32}, P.out, l, 0, l == 0 ? -1 : 5, chain ? (LAS float*)(F.lds + LDSCTL_OFF + 8192) : (LAS float*)nullptr};
                pg8::gemm_phase<EpiG1, WinOrder, true, true>(F.lds + RING_OFF, g, S, E, fresh_tid(F.wave));
            }
            if (chain) {
                frame_refresh(F);
                const int xk = F.bx >> 3, xx = F.bx & 7;
                if (xk < 10) {
                    const int cpm = 39 - (5 * xx + (xk >> 1));
                    if (F.tid < 256) { const LAS float* lp = (const LAS float*)(F.lds + LDSCTL_OFF + 8192) + F.tid;
                        (((xk & 1) == 0) ? ssb + (size_t)(l * 2) * M_TOK : sskv)[cpm * 256 + F.tid] = (lp[0] + lp[256]) + (lp[512] + lp[768]); }
                    asm volatile("s_waitcnt vmcnt(0)" ::: "memory"); __syncthreads();
                    __builtin_amdgcn_fence(__ATOMIC_ACQUIRE, "agent");
                    if ((xk & 1) == 0) {
                        pg8::Gemm g{(const pg8::bf16_t*)(ws + WS_QA), (const pg8::bf16_t*)(wl + W_QB_OFF), M_TOK, N_Q, 256}; QOrder S; S.init(M_TOK, N_Q, F.G, F.bx); S.cpm = cpm;
                        EpiQ E{ws, P.in[17] + l * 64, P.in[18] + l * 32, l};
                        pg8::gemm_phase<EpiQ, QOrder, true, true>(F.lds + RING_OFF, g, S, E, fresh_tid(F.wave));
                    } else {
                        pg8::Gemm g{(const pg8::bf16_t*)(ws + WS_KVA), (const pg8::bf16_t*)(wl + W_KVB_OFF), M_KV, N_KV, 256}; KvOrder S; S.init(M_KV, N_KV, F.G, F.bx); S.cpm = cpm; S.cn0 = 0; S.cn1 = 4;
                        EpiKV E{ws, P.in[19] + l * 64, l};
                        pg8::gemm_phase<EpiKV, KvOrder, true, true>(F.lds + RING_OFF, g, S, E, fresh_tid(F.wave));
                        if (cpm < 32) {
                            frame_refresh(F); const bf16* KVA = (const bf16*)(ws + WS_KVA);
                            for (int m = cpm * 256 + F.wave; m < cpm * 256 + 256; m += NWAVES) {
                                const float rstd = 1.0f / sqrtf(sskv[m] * (1.0f / 128.0f) + EPSF);
                                const unsigned pk = *((const unsigned*)(KVA + (size_t)m * 256) + F.lane);
                                float* o = P.out + OUT_CKV + ((size_t)((m >> 8) * 2 + l) * 256 + (m & 255)) * 128 + 2 * F.lane;
                                __builtin_nontemporal_store((f32x2_t){b2f((unsigned short)(pk & 0xffffu)) * rstd, b2f((unsigned short)(pk >> 16)) * rstd}, (f32x2_t*)o);
                            }
                        }
                    }
                } else if (xk >= 28) {
                    if (xk == 28) {
                        pg8::Gemm g{(const pg8::bf16_t*)(ws + WS_KVA), (const pg8::bf16_t*)(wl + W_KVB_OFF), M_KV, N_KV, 256}; KvOrder S; S.init(M_KV, N_KV, F.G, F.bx); S.cpm = 40 + (xx >> 2); S.cn0 = xx & 3; S.cn1 = S.cn0 + 1;
                        EpiKV E{ws, P.in[19] + l * 64, l};
                        pg8::gemm_phase<EpiKV, KvOrder, true, true>(F.lds + RING_OFF, g, S, E, fresh_tid(F.wave));
                    }
                }
                SEAM(pb + 2);
            } else SEAM(pb + 1);
        }
        if (PH_EN(3) && IN(pb + 2) && !chain) {
            unsigned long long zz_ = 0ull; asm volatile("" : "+s"(zz_)); unsigned char* const ws = P.ws + zz_; (void)ws;
            unsigned char* const wl = ws + WS_W + (size_t)l * LAYER_W; (void)wl; const float* const mod = (const float*)(ws + WS_MOD) + (size_t)l * 3 * 6144; (void)mod;
            const float* const bias = (const float*)(ws + WS_BIAS) + (size_t)l * 3 * BIAS_LD; (void)bias; float* const ssb = (float*)(F.ctl + CW_SS); (void)ssb; float* const sskv = ssb + (size_t)(l * 2 + 1) * M_TOK; (void)sskv;
            {
                pg8::Gemm g{(const pg8::bf16_t*)(ws + WS_QA), (const pg8::bf16_t*)(wl + W_QB_OFF), M_TOK, N_Q, 256}; QOrder S; S.init(M_TOK, N_Q, F.G, F.bx); S.cpm = -1;
                EpiQ E{ws, P.in[17] + l * 64, P.in[18] + l * 32, l};
                pg8::gemm_phase<EpiQ, QOrder, true, true>(F.lds + RING_OFF, g, S, E, fresh_tid(F.wave));
            }
            {
                pg8::Gemm g{(const pg8::bf16_t*)(ws + WS_KVA), (const pg8::bf16_t*)(wl + W_KVB_OFF), M_KV, N_KV, 256}; KvOrder S; S.init(M_KV, N_KV, F.G, F.G == 256 ? F.bx : (F.bx + 136) % F.G); S.cpm = -1; S.cn0 = 0; S.cn1 = 0;
                EpiKV E{ws, P.in[19] + l * 64, l};
                pg8::gemm_phase<EpiKV, KvOrder, true, true>(F.lds + RING_OFF, g, S, E, fresh_tid(F.wave));
            }
            {
                frame_refresh(F); const bool sl = F.G == 256;
                const int gw = (sl ? F.bx - 152 : F.bx) * NWAVES + F.wave, NGW = (sl ? 104 : F.G) * NWAVES;
                const bf16* KVA = (const bf16*)(ws + WS_KVA);
                for (int m = gw < 0 ? M_CTX : gw; m < M_CTX; m += NGW) {
                    const float rstd = 1.0f / sqrtf(sskv[m] * (1.0f / 128.0f) + EPSF);
                    const unsigned pk = *((const unsigned*)(KVA + (size_t)m * 256) + F.lane);
                    float* o = P.out + OUT_CKV + ((size_t)((m >> 8) * 2 + l) * 256 + (m & 255)) * 128 + 2 * F.lane;
                    __builtin_nontemporal_store((f32x2_t){b2f((unsigned short)(pk & 0xffffu)) * rstd, b2f((unsigned short)(pk >> 16)) * rstd}, (f32x2_t*)o);
                }
            }
            if (l == 0 && F.G >= 256) { frame_refresh(F); if (F.bx < 120 || F.bx >= 152) bias_job(F, P, (F.bx < 120 ? F.bx : F.bx - 32) * NWAVES + F.wave, (F.G - 32) * NWAVES); }
            else if (l == 0) { frame_refresh(F); bias_job(F, P, F.bx * NWAVES + F.wave, F.G * NWAVES); }
            SEAM(pb + 2);
        }
        if (PH_EN(4) && IN(pb + 3)) {
            unsigned long long zz_ = 0ull; asm volatile("" : "+s"(zz_)); unsigned char* const ws = P.ws + zz_; (void)ws;
            unsigned char* const wl = ws + WS_W + (size_t)l * LAYER_W; (void)wl; const float* const mod = (const float*)(ws + WS_MOD) + (size_t)l * 3 * 6144; (void)mod;
            const float* const bias = (const float*)(ws + WS_BIAS) + (size_t)l * 3 * BIAS_LD; (void)bias; float* const ssb = (float*)(F.ctl + CW_SS); (void)ssb; float* const sskv = ssb + (size_t)(l * 2 + 1) * M_TOK; (void)sskv;
            MixP MP{(const bf16*)(ws + WS_Q), (const bf16*)(ws + WS_KN), (const bf16*)(ws + WS_KR), (const bf16*)(ws + WS_VT), (const bf16*)(ws + WS_RQ), (const bf16*)(ws + WS_RK),
                    (const bf16*)(ws + WS_RKT), (const bf16*)(ws + WS_RVT), (const bf16*)(ws + WS_RG), (bf16*)(ws + WS_MIX), P.in[4], P.in[5], P.in[21] + l * 8, P.in[22] + l * 8,
                    P.in[23] + l * 512, P.in[24] + l * 512, P.out + OUT_SF, P.out + OUT_SB, l, (const float*)(ws + WS_TAB + 16384) + l * 16, (chain && MIX_DEFER) ? 1 : 0};
            for (int rep = 0; rep < REPS(4); ++rep) { frame_refresh(F); mix_phase(F, MP); if (rep + 1 < REPS(4)) xcd_barrier(bar, fresh_tid(F.wave)); }
            SEAM(pb + 3);
        }
        if (PH_EN(5) && IN(pb + 4)) {
            unsigned long long zz_ = 0ull; asm volatile("" : "+s"(zz_)); unsigned char* const ws = P.ws + zz_; (void)ws;
            unsigned char* const wl = ws + WS_W + (size_t)l * LAYER_W; (void)wl; const float* const mod = (const float*)(ws + WS_MOD) + (size_t)l * 3 * 6144; (void)mod;
            const float* const bias = (const float*)(ws + WS_BIAS) + (size_t)l * 3 * BIAS_LD; (void)bias; float* const ssb = (float*)(F.ctl + CW_SS); (void)ssb; float* const sskv = ssb + (size_t)(l * 2 + 1) * M_TOK; (void)sskv;
            pg8::Gemm g{(const pg8::bf16_t*)(ws + WS_MIX), (const pg8::bf16_t*)(wl + W_O_OFF), M_TOK, 1024, 1024}; PanelOrder S; S.init(M_TOK, 1024, F.G, F.bx);
            if (l == 0) { EpiResW<false, true> E{P.in[0], P.in[1], P.out, mod + 2 * 1024, (bf16*)(ws + WS_H), P.in[11] + l * 1024, mod + 4 * 1024, ssb + (size_t)4 * M_TOK, 0, (bf16*)(ws + WS_Q), nullptr};
                pg8::gemm_phase<EpiResW<false, true>, PanelOrder, true, true>(F.lds + RING_OFF, g, S, E, fresh_tid(F.wave)); }
            else { EpiResW<true, true> E{nullptr, nullptr, P.out, mod + 2 * 1024, (bf16*)(ws + WS_H), P.in[11] + l * 1024, mod + 4 * 1024, ssb + (size_t)6 * M_TOK, 0, (bf16*)(ws + WS_Q), (const bf16*)P.out};
                pg8::gemm_phase<EpiResW<true, true>, PanelOrder, true, true>(F.lds + RING_OFF, g, S, E, fresh_tid(F.wave)); }
            if (l == 0 && chain) { frame_refresh(F); if (F.bx >= 160) bias_job(F, P, (F.bx - 160) * NWAVES + F.wave, 96 * NWAVES); }
            SEAM(pb + 4);
        }
        if (PH_EN(7) && IN(pb + 6)) {
            unsigned long long zz_ = 0ull; asm volatile("" : "+s"(zz_)); unsigned char* const ws = P.ws + zz_; (void)ws;
            unsigned char* const wl = ws + WS_W + (size_t)l * LAYER_W; (void)wl; const float* const mod = (const float*)(ws + WS_MOD) + (size_t)l * 3 * 6144; (void)mod;
            const float* const bias = (const float*)(ws + WS_BIAS) + (size_t)l * 3 * BIAS_LD; (void)bias; float* const ssb = (float*)(F.ctl + CW_SS); (void)ssb; float* const sskv = ssb + (size_t)(l * 2 + 1) * M_TOK; (void)sskv;
            if (chain && MIX_DEFER && F.bx >= 112) {
                frame_refresh(F);
                unsigned long long zs_ = 0ull; asm volatile("" : "+s"(zs_)); unsigned char* const wsx = ws + zs_; float* const outx = P.out + zs_;
                MixP SP{nullptr, nullptr, nullptr, nullptr, nullptr, nullptr, (const bf16*)(wsx + WS_RKT), (const bf16*)(wsx + WS_RVT), nullptr, nullptr, nullptr, nullptr, nullptr, nullptr,
                        nullptr, nullptr, outx + OUT_SF, outx + OUT_SB, l, (const float*)(wsx + WS_TAB + 16384) + l * 16, 1};
                for (int uu = F.bx - 112; uu < 256; uu += 144) ret_state_job(SP, uu >> 3, uu & 7, F.wave, F.lane);
            }
            pg8::Gemm g{(const pg8::bf16_t*)(ws + WS_H), (const pg8::bf16_t*)(wl + W_FI_OFF), M_TOK, N_FI, 1024}; pg8::StaticOrder S; S.init(M_TOK, N_FI, F.G, F.bx);
            EpiFfn E{(bf16*)(ws + WS_ACT), ssb + (size_t)(l == 0 ? 4 : 6) * M_TOK, bias + 2560};
            for (int rep = 0; rep < REPS(7); ++rep) { pg8::gemm_phase<EpiFfn, pg8::StaticOrder, true, true>(F.lds + RING_OFF, g, S, E, fresh_tid(F.wave)); if (rep + 1 < REPS(7)) xcd_barrier(bar, fresh_tid(F.wave)); }
            SEAM(pb + 6);
        }
        if (PH_EN(8) && IN(pb + 7)) {
            unsigned long long zz_ = 0ull; asm volatile("" : "+s"(zz_)); unsigned char* const ws = P.ws + zz_; (void)ws;
            unsigned char* const wl = ws + WS_W + (size_t)l * LAYER_W; (void)wl; const float* const mod = (const float*)(ws + WS_MOD) + (size_t)l * 3 * 6144; (void)mod;
            const float* const bias = (const float*)(ws + WS_BIAS) + (size_t)l * 3 * BIAS_LD; (void)bias; float* const ssb = (float*)(F.ctl + CW_SS); (void)ssb; float* const sskv = ssb + (size_t)(l * 2 + 1) * M_TOK; (void)sskv;
            pg8::Gemm g{(const pg8::bf16_t*)(ws + WS_ACT), (const pg8::bf16_t*)(wl + W_FO_OFF), M_TOK, 1024, D_FFN}; SplitOrder<FO_NMAIN, D_FFN / 64> S; S.init(M_TOK, 1024, F.G, F.bx);
            S.slab = (float*)(ws + WS_RQ); S.flags = (unsigned*)(F.ctl + CW_SPLIT); S.epoch = (unsigned)(pb + 8);
            if (l == 0) { EpiResW<true, true> E{nullptr, nullptr, P.out, mod + 5 * 1024, (bf16*)(ws + WS_H), P.in[10] + 1024, (const float*)(ws + WS_MOD) + (size_t)3 * 6144 + 1 * 1024, ssb + (size_t)5 * M_TOK, 0, (bf16*)P.out, (const bf16*)(ws + WS_Q)};
                pg8::gemm_phase<EpiResW<true, true>, SplitOrder<FO_NMAIN, D_FFN / 64>, true, true>(F.lds + RING_OFF, g, S, E, fresh_tid(F.wave)); }
            else { EpiResW<true, false> E{nullptr, nullptr, P.out, mod + 5 * 1024, (bf16*)(ws + WS_H), nullptr, (const float*)(ws + WS_MOD) + (size_t)3 * 6144 + 1 * 1024, ssb + (size_t)5 * M_TOK, 1, nullptr, (const bf16*)(ws + WS_Q)};
                pg8::gemm_phase<EpiResW<true, false>, SplitOrder<FO_NMAIN, D_FFN / 64>, true, true>(F.lds + RING_OFF, g, S, E, fresh_tid(F.wave)); }
            if (l == 0) { frame_refresh(F); cache_rows_job(F, P, 1); SEAM(pb + 7); }
        }
    }
#undef IN
#undef SEAM
}

extern "C" void kernel_launch(void* const* d_in, const int* in_sizes, int n_in, void* d_out, int out_size, void* d_ws, size_t ws_size, hipStream_t stream) {
    static int grid = 0;
    if (grid == 0) {
        if (n_in != 28 || out_size != (int)OUT_TOTAL || ws_size < WS_END) { fprintf(stderr, "kernel_launch: unexpected shapes (n_in %d, out %d, ws %zu); nothing launched\n", n_in, out_size, ws_size); grid = -1; return; }
        int dev = 0, cus = 0, per_cu = 0;
        if (hipGetDevice(&dev) != hipSuccess || hipDeviceGetAttribute(&cus, hipDeviceAttributeMultiprocessorCount, dev) != hipSuccess) { grid = -1; return; }
        if (hipFuncSetAttribute((const void*)mk_fwd, hipFuncAttributeMaxDynamicSharedMemorySize, LDS_BYTES) != hipSuccess) { fprintf(stderr, "kernel_launch: hipFuncSetAttribute failed\n"); grid = -1; return; }
        if (hipOccupancyMaxActiveBlocksPerMultiprocessor(&per_cu, (const void*)mk_fwd, NWAVES * 64, LDS_BYTES) != hipSuccess || per_cu < 1) { fprintf(stderr, "kernel_launch: occupancy query reports %d blocks per CU\n", per_cu); }
        (void)hipGetLastError();
        grid = cus;
    }
    if (grid < 0) return;
    if (hipMemsetAsync((char*)d_ws + WS_CTL, 0, CTL_ZERO_BYTES, stream) != hipSuccess) { fprintf(stderr, "kernel_launch: memset failed\n"); return; }
    Params p{};
    for (int i = 0; i < 28; ++i) p.in[i] = (const float*)d_in[i];
    p.out = (float*)d_out; p.ws = (unsigned char*)d_ws;
#if MK_PER_PHASE
    for (int ph = 0; ph < N_PHASES; ++ph) { p.ph_lo = ph; p.ph_hi = ph + 1; hipLaunchKernelGGL(mk_fwd, dim3(grid), dim3(NWAVES * 64), LDS_BYTES, stream, p); }
#else
    p.ph_lo = 0; p.ph_hi = N_PHASES;
    hipLaunchKernelGGL(mk_fwd, dim3(grid), dim3(NWAVES * 64), LDS_BYTES, stream, p);
#endif
    const hipError_t le = hipPeekAtLastError();
    if (le != hipSuccess) fprintf(stderr, "kernel_launch: launch failed: %s\n", hipGetErrorName(le));
}
```

```cpp
#include <hip/hip_runtime.h>
#include <cstdio>
#include <cstdint>
namespace pg8 {
#define PG8_LAS __attribute__((address_space(3)))
typedef unsigned short bf16_t;
typedef short bf16x8 __attribute__((ext_vector_type(8)));
typedef float f32x4 __attribute__((ext_vector_type(4)));
typedef unsigned u32x4 __attribute__((ext_vector_type(4)));
constexpr int BM = 256, BK = 64, HALF = 128, HTB = HALF * BK * 2  , STAGE_BYTES = 8 * HTB, NXCD = 8, WGM = 8;

__host__ __device__ __forceinline__ int lds_byte(int r, int c) { const int st = (r >> 4) * 2 + (c >> 5), rr = r & 15, cc = c & 31, ob = rr * 64 + cc * 2; return st * 1024 + (ob ^ (((ob >> 9) & 1) << 5)); }
__host__ __device__ __forceinline__ void stage_rc(int b, int& R, int& C) { const int st = b / 1024, sb = b % 1024, swz = sb ^ (((sb >> 9) & 1) << 5); R = (st >> 1) * 16 + swz / 64; C = (st & 1) * 32 + (swz % 64) / 2; }
__host__ __device__ __forceinline__ int perm32(int rho) { const int n = rho >> 4, i = rho & 15; return 8 * (i >> 2) + 4 * n + (i & 3); }

struct Unit { int pm, pn, k0, nkt, role, slab, src2; };
struct Gemm { const bf16_t* A; const bf16_t* Bt; int M, N, K; };

struct StaticOrder {
    int nM, nN, nwg, G, c;
    __host__ __device__ void init(int M, int N, int G_, int c_) { nM = M / BM; nN = N / BM; nwg = nM * nN; G = G_; c = c_; }
    static constexpr bool SPLITK = false, HANDOFF = false;
    __host__ __device__ __forceinline__ bool next(int i, Unit& u) const {
        const long L = (long)i * G + c; if (L >= nwg) return false;
        map((int)L, u); return true;
    }
    __host__ __device__ __forceinline__ void map(int L, Unit& u) const {
        int wgid = L; { const int q = nwg / NXCD, r = nwg % NXCD, xcd = wgid % NXCD, off = wgid / NXCD; wgid = (xcd < r ? xcd * (q + 1) : r * (q + 1) + (xcd - r) * q) + off; }
        map2(wgid, u);
    }
    __host__ __device__ __forceinline__ void map2(int wgid, Unit& u) const {
        const int nig = WGM * nN, gid = wgid / nig, fm = gid * WGM, gsz = (nM - fm) < WGM ? (nM - fm) : WGM;
        u.pm = fm + ((wgid % nig) % gsz); u.pn = (wgid % nig) / gsz;
    }
    __device__ __forceinline__ void a_ready(const Unit&) const {}
    __device__ __forceinline__ void done(const Unit&) const {}
};

__device__ __forceinline__ unsigned cvt_pk_bf16(float lo, float hi) { unsigned r; asm volatile("v_cvt_pk_bf16_f32 %0, %1, %2" : "=v"(r) : "v"(lo), "v"(hi)); return r; }
template <class Epi, class Sched, bool ALIGN_EPI = false, bool SP2 = false>
__device__ __forceinline__ void gemm_phase(PG8_LAS unsigned char* lds, const Gemm g, const Sched& S, const Epi& E, int tid_) {
    const int tid = tid_, wid = __builtin_amdgcn_readfirstlane(tid >> 6), lane = tid & 63, wr = wid >> 2, wc = wid & 3, fr = lane & 15, fq = lane >> 4;
    int K_ = g.K; asm volatile("" : "+s"(K_));
    const int K = K_; int nt = K / BK;
    unsigned voffA[2], voffB[2];
#pragma unroll
    for (int i = 0; i < 2; ++i) { int R, C; stage_rc(tid * 16 + i * 8192, R, C); const int Rb = Epi::PERM ? ((R & ~31) + perm32(R & 31)) : R;
        voffA[i] = (unsigned)(R * K + C) * 2u; voffB[i] = (unsigned)(Rb * K + C) * 2u; }
    const size_t kstep = (size_t)(BK * 2);
    const size_t hstep = (size_t)HALF * K * 2;
    const size_t tstep = 2 * hstep;
    const unsigned ldsw = (unsigned)wid * 1024u;
    const int aoff = lds_byte(wr * 64 + fr, fq * 8), boff = lds_byte(wc * 32 + fr, fq * 8);
#define PG8_SA(b, h) (((b) * 2 + (h)) * HTB)
#define PG8_SB(b, h) ((4 + (b) * 2 + (h)) * HTB)
#define PG8_STAGE(bufoff, gbase, voff) do { _Pragma("unroll") for (int _i = 0; _i < 2; ++_i) \
        __builtin_amdgcn_global_load_lds((const unsigned*)((const char*)(gbase) + (voff)[_i]), (PG8_LAS unsigned*)(lds + (bufoff) + ldsw + _i * 8192), 16, 0, 0); } while (0)
#define PG8_LDA(dst, b, h) do { _Pragma("unroll") for (int m = 0; m < 4; ++m) _Pragma("unroll") for (int k = 0; k < 2; ++k) dst[m][k] = *(const PG8_LAS bf16x8*)(lds + PG8_SA(b, h) + aoff + m * 2048 + k * 1024); } while (0)
#define PG8_LDB(dst, b, h) do { _Pragma("unroll") for (int n = 0; n < 2; ++n) _Pragma("unroll") for (int k = 0; k < 2; ++k) dst[n][k] = *(const PG8_LAS bf16x8*)(lds + PG8_SB(b, h) + boff + n * 2048 + k * 1024); } while (0)
#define PG8_MMA(ai, bj, At, Bt) do { __builtin_amdgcn_s_setprio(1); _Pragma("unroll") for (int m = 0; m < 4; ++m) _Pragma("unroll") for (int n = 0; n < 2; ++n) _Pragma("unroll") for (int k = 0; k < 2; ++k) \
        acc[ai][bj][m][n] = __builtin_amdgcn_mfma_f32_16x16x32_bf16(Bt[n][k], At[m][k], acc[ai][bj][m][n], 0, 0, 0); __builtin_amdgcn_s_setprio(0); } while (0)
#define PG8_WAIT_V(n) asm volatile("s_waitcnt vmcnt(" #n ")" ::: "memory")
#define PG8_WAIT_L(n) asm volatile("s_waitcnt lgkmcnt(" #n ")" ::: "memory")
#define PG8_BAR __builtin_amdgcn_s_barrier()
#define PG8_SCHED __builtin_amdgcn_sched_barrier(0)
    Unit cur, nxt; int ui = 0;
    if (!S.next(0, cur)) return;
    f32x4 acc[2][2][4][2];
#pragma unroll
    for (int a = 0; a < 2; ++a)
#pragma unroll
        for (int b = 0; b < 2; ++b)
#pragma unroll
            for (int m = 0; m < 4; ++m)
#pragma unroll
                for (int n = 0; n < 2; ++n) acc[a][b][m][n] = (f32x4){0.f, 0.f, 0.f, 0.f};
    bf16x8 At[4][2], B0[2][2], B1[2][2];
    const char* cA = (const char*)g.A + (size_t)cur.pm * tstep; const char* cB = (const char*)g.Bt + (size_t)cur.pn * tstep;
    if constexpr (Sched::SPLITK) { nt = cur.nkt; cA += (size_t)cur.k0 * kstep; cB += (size_t)cur.k0 * kstep; }
    S.a_ready(cur);
    if constexpr (SP2) {
        PG8_STAGE(PG8_SB(0, 0), cB, voffB); PG8_STAGE(PG8_SB(0, 1), cB + hstep, voffB); PG8_STAGE(PG8_SA(0, 0), cA, voffA); PG8_STAGE(PG8_SA(0, 1), cA + hstep, voffA);
        if (wr == 1) PG8_BAR;
        PG8_WAIT_V(2); PG8_BAR;
        PG8_STAGE(PG8_SB(1, 0), cB + kstep, voffB); PG8_STAGE(PG8_SA(1, 0), cA + kstep, voffA); PG8_STAGE(PG8_SB(1, 1), cB + hstep + kstep, voffB);
        PG8_WAIT_V(6); PG8_BAR;
    } else {
        PG8_STAGE(PG8_SB(0, 0), cB, voffB); PG8_STAGE(PG8_SA(0, 0), cA, voffA); PG8_STAGE(PG8_SB(0, 1), cB + hstep, voffB); PG8_STAGE(PG8_SA(0, 1), cA + hstep, voffA);
        if (wr == 1) PG8_BAR;
        PG8_WAIT_V(4); PG8_BAR;
        PG8_STAGE(PG8_SB(1, 0), cB + kstep, voffB); PG8_STAGE(PG8_SA(1, 0), cA + kstep, voffA); PG8_STAGE(PG8_SB(1, 1), cB + hstep + kstep, voffB);
        PG8_WAIT_V(6); PG8_BAR;
    }
    for (;;) {
        const bool has_next = S.next(ui + 1, nxt);
        const char* nA = has_next ? (const char*)g.A + (size_t)nxt.pm * tstep : cA; const char* nB = has_next ? (const char*)g.Bt + (size_t)nxt.pn * tstep : cB;
        if constexpr (Sched::SPLITK) { if (has_next) { nA += (size_t)nxt.k0 * kstep; nB += (size_t)nxt.k0 * kstep; } }
        for (int t = 0; t < nt; t += 2) {
            const bool last = (t == nt - 2);
            const char* a1 = cA + (size_t)(t + 1) * kstep;
            const char* a2 = last ? nA : cA + (size_t)(t + 2) * kstep; const char* b2 = last ? nB : cB + (size_t)(t + 2) * kstep;
            const char* a3 = a2 + kstep; const char* b3 = b2 + kstep;
            if (last && has_next) S.a_ready(nxt);
            if constexpr (SP2) {
            PG8_LDB(B0, 0, 0); PG8_LDB(B1, 0, 1); PG8_SCHED; PG8_LDA(At, 0, 0); PG8_STAGE(PG8_SA(1, 1), a1 + hstep, voffA);
            PG8_WAIT_V(8); PG8_WAIT_L(0); PG8_BAR; PG8_MMA(0, 0, At, B0); PG8_MMA(0, 1, At, B1); PG8_BAR; PG8_SCHED;
            PG8_LDA(At, 0, 1); PG8_STAGE(PG8_SB(0, 0), b2, voffB); PG8_STAGE(PG8_SB(0, 1), b2 + hstep, voffB); PG8_STAGE(PG8_SA(0, 0), a2, voffA);
            PG8_WAIT_V(8); PG8_WAIT_L(0); PG8_BAR; PG8_MMA(1, 0, At, B0); PG8_MMA(1, 1, At, B1); PG8_BAR; PG8_SCHED;
            PG8_LDB(B0, 1, 0); PG8_LDB(B1, 1, 1); PG8_SCHED; PG8_LDA(At, 1, 0); PG8_STAGE(PG8_SA(0, 1), a2 + hstep, voffA);
            PG8_WAIT_V(8); PG8_WAIT_L(0); PG8_BAR; PG8_MMA(0, 0, At, B0); PG8_MMA(0, 1, At, B1); PG8_BAR; PG8_SCHED;
            PG8_LDA(At, 1, 1); PG8_STAGE(PG8_SB(1, 0), b3, voffB); PG8_STAGE(PG8_SB(1, 1), b3 + hstep, voffB); PG8_STAGE(PG8_SA(1, 0), a3, voffA);
            PG8_WAIT_V(8); PG8_WAIT_L(0); PG8_BAR; PG8_MMA(1, 0, At, B0); PG8_MMA(1, 1, At, B1); PG8_BAR; PG8_SCHED;
            } else {
            PG8_LDB(B0, 0, 0); PG8_SCHED; PG8_LDA(At, 0, 0); PG8_STAGE(PG8_SA(1, 1), a1 + hstep, voffA);
            PG8_WAIT_L(8); PG8_BAR; PG8_WAIT_L(0); PG8_MMA(0, 0, At, B0); PG8_BAR; PG8_SCHED;
            PG8_LDB(B1, 0, 1); PG8_STAGE(PG8_SB(0, 0), b2, voffB);
            PG8_BAR; PG8_WAIT_L(0); PG8_MMA(0, 1, At, B1); PG8_BAR;
            PG8_LDA(At, 0, 1); PG8_STAGE(PG8_SA(0, 0), a2, voffA);
            PG8_BAR; PG8_WAIT_L(0); PG8_MMA(1, 0, At, B0); PG8_BAR; PG8_SCHED;
            PG8_STAGE(PG8_SB(0, 1), b2 + hstep, voffB);
            PG8_WAIT_V(6); PG8_BAR; PG8_MMA(1, 1, At, B1); PG8_BAR;
            PG8_LDB(B0, 1, 0); PG8_SCHED; PG8_LDA(At, 1, 0); PG8_STAGE(PG8_SA(0, 1), a2 + hstep, voffA);
            PG8_WAIT_L(8); PG8_BAR; PG8_WAIT_L(0); PG8_MMA(0, 0, At, B0); PG8_BAR; PG8_SCHED;
            PG8_LDB(B1, 1, 1); PG8_STAGE(PG8_SB(1, 0), b3, voffB);
            PG8_BAR; PG8_WAIT_L(0); PG8_MMA(0, 1, At, B1); PG8_BAR;
            PG8_LDA(At, 1, 1); PG8_STAGE(PG8_SA(1, 0), a3, voffA);
            PG8_BAR; PG8_WAIT_L(0); PG8_MMA(1, 0, At, B0); PG8_BAR; PG8_SCHED;
            PG8_STAGE(PG8_SB(1, 1), b3 + hstep, voffB);
            PG8_WAIT_V(6); PG8_BAR; PG8_MMA(1, 1, At, B1); PG8_BAR;
            }
        }
        if constexpr (ALIGN_EPI) { if (wr == 0) PG8_BAR; }
        if constexpr (Sched::SPLITK) {
            int ln; asm volatile("v_mbcnt_lo_u32_b32 %0, -1, 0\n\tv_mbcnt_hi_u32_b32 %0, -1, %0" : "=v"(ln));
            if constexpr (!Sched::HANDOFF) { E(acc, cur, wr, wc, ln & 15, ln >> 4); S.done(cur); } else {
            const __amdgpu_buffer_rsrc_t rs = __builtin_amdgcn_make_buffer_rsrc((void*)S.slab, 0, 256 * 131072, 0x00020000);
            if (cur.role == 2) {
                const unsigned so = ((unsigned)cur.slab * 32768u + (unsigned)wid * 4096u + (unsigned)ln * 4u) * 4u;
#pragma unroll
                for (int a = 0; a < 2; ++a)
#pragma unroll
                    for (int b = 0; b < 2; ++b)
#pragma unroll
                        for (int m = 0; m < 4; ++m) {
                            const f32x4 p0 = acc[a][b][m][0], p1 = acc[a][b][m][1];
                            const u32x4 pk = {cvt_pk_bf16(p0[0], p0[1]), cvt_pk_bf16(p0[2], p0[3]), cvt_pk_bf16(p1[0], p1[1]), cvt_pk_bf16(p1[2], p1[3])};
                            __builtin_amdgcn_raw_buffer_store_b128(pk, rs, so + (unsigned)(((a * 2 + b) * 4 + m) * 1024), 0, 16);
                        }
                asm volatile("s_waitcnt vmcnt(0)" ::: "memory");
                unsigned ep = S.epoch; asm volatile("" : "+s"(ep));
                if (ln == 0) __hip_atomic_store(S.flags + cur.slab * 8 + wid, ep, __ATOMIC_RELAXED, __HIP_MEMORY_SCOPE_AGENT);
            } else {
                if (cur.role == 1) {
                    for (int src = cur.slab, pass = 0; pass < 2 && src >= 0; src = cur.src2, ++pass) {
                        const unsigned* fl = S.flags + src * 8 + wid;
                        for (int sp = 0; sp < (1 << 20) && __hip_atomic_load(fl, __ATOMIC_RELAXED, __HIP_MEMORY_SCOPE_AGENT) != S.epoch; ++sp) __builtin_amdgcn_s_sleep(1);
                        const unsigned so = ((unsigned)src * 32768u + (unsigned)wid * 4096u + (unsigned)ln * 4u) * 4u;
                        u32x4 pv[2][2][4];
#pragma unroll
                        for (int a = 0; a < 2; ++a)
#pragma unroll
                            for (int b = 0; b < 2; ++b)
#pragma unroll
                                for (int m = 0; m < 4; ++m) pv[a][b][m] = __builtin_amdgcn_raw_buffer_load_b128(rs, so + (unsigned)(((a * 2 + b) * 4 + m) * 1024), 0, 16);
#pragma unroll
                        for (int a = 0; a < 2; ++a)
#pragma unroll
                            for (int b = 0; b < 2; ++b)
#pragma unroll
                                for (int m = 0; m < 4; ++m) { const u32x4 w = pv[a][b][m];
                                    acc[a][b][m][0] += (f32x4){__builtin_bit_cast(float, w[0] << 16), __builtin_bit_cast(float, w[0] & 0xffff0000u), __builtin_bit_cast(float, w[1] << 16), __builtin_bit_cast(float, w[1] & 0xffff0000u)};
                                    acc[a][b][m][1] += (f32x4){__builtin_bit_cast(float, w[2] << 16), __builtin_bit_cast(float, w[2] & 0xffff0000u), __builtin_bit_cast(float, w[3] << 16), __builtin_bit_cast(float, w[3] & 0xffff0000u)}; }
                    }
                }
                E(acc, cur, wr, wc, ln & 15, ln >> 4); S.done(cur);
            }
            }
        } else
        if constexpr (!Epi::AFTER_DRAIN) { int ln_; asm volatile("v_mbcnt_lo_u32_b32 %0, -1, 0\n\tv_mbcnt_hi_u32_b32 %0, -1, %0" : "=v"(ln_)); E(acc, cur, wr, wc, ln_ & 15, ln_ >> 4); S.done(cur); }
        if (!has_next) break;
#pragma unroll
        for (int a = 0; a < 2; ++a)
#pragma unroll
            for (int b = 0; b < 2; ++b)
#pragma unroll
                for (int m = 0; m < 4; ++m)
#pragma unroll
                    for (int n = 0; n < 2; ++n) acc[a][b][m][n] = (f32x4){0.f, 0.f, 0.f, 0.f};
        cur = nxt; cA = nA; cB = nB; ++ui;
        if constexpr (Sched::SPLITK) nt = cur.nkt;
        if constexpr (ALIGN_EPI) { if (wr == 1) PG8_BAR; }
    }
    PG8_WAIT_V(0);
    if constexpr (!ALIGN_EPI) { if (wr == 0) PG8_BAR; }
    PG8_BAR;
    if constexpr (Epi::AFTER_DRAIN) { E.fused(acc, cur, wr, wc, fr, fq, lds, wid, lane); S.done(cur); }
#undef PG8_SA
#undef PG8_SB
#undef PG8_STAGE
#undef PG8_LDA
#undef PG8_LDB
#undef PG8_MMA
#undef PG8_WAIT_V
#undef PG8_WAIT_L
#undef PG8_BAR
#undef PG8_SCHED
}
}
#define GAS __attribute__((address_space(1)))
#define LAS __attribute__((address_space(3)))
typedef unsigned short bf16;
typedef unsigned v4u __attribute__((ext_vector_type(4)));
typedef float f32x4 __attribute__((ext_vector_type(4)));
typedef short bf16x8 __attribute__((ext_vector_type(8)));
typedef GAS unsigned gu32;
typedef GAS unsigned long long gu64;
#define RLX_AGENT __ATOMIC_RELAXED, __HIP_MEMORY_SCOPE_AGENT
#define LDS_WAIT() asm volatile("s_waitcnt lgkmcnt(0)" ::: "memory")
#define VM_WAIT() asm volatile("s_waitcnt vmcnt(0)" ::: "memory")
__device__ __forceinline__ unsigned long long rt() { return __builtin_amdgcn_s_memrealtime(); }
__device__ __forceinline__ unsigned f2bf(float f) { unsigned u = __builtin_bit_cast(unsigned, f); return (u + 0x7fffu + ((u >> 16) & 1u)) >> 16; }
__device__ __forceinline__ unsigned pk2(float lo, float hi) { return f2bf(lo) | (f2bf(hi) << 16); }

#define XB_TMO      128
#define XB_XCNT(j)  (256  + 64 * (j))
#define XB_XSUB(j)  (1280 + 64 * (j))
#define XB_XGEN(j)  (2304 + 64 * (j))
#define XB_TOP      3328
#define XB_TOPGEN   3392
#define XCD_BAR_WORDS 3456
#define XB_SPIN_CAP (1u << 18)

__device__ __forceinline__ unsigned xb_ld(unsigned* p)              { return __hip_atomic_load(p, __ATOMIC_RELAXED, __HIP_MEMORY_SCOPE_AGENT); }
__device__ __forceinline__ unsigned xb_add(unsigned* p, unsigned v) { return __hip_atomic_fetch_add(p, v, __ATOMIC_RELAXED, __HIP_MEMORY_SCOPE_AGENT); }
__device__ __forceinline__ unsigned xb_xcc_id() { return (unsigned)__builtin_amdgcn_s_getreg((3 << 11) | 20) & 0xFu; }
#define XB_SPIN(cond, bar) do { unsigned _sp = 0; while (cond) { __builtin_amdgcn_s_sleep(1); \
    if ((++_sp & 255u) == 0u) { if (xb_ld(&(bar)[XB_TMO])) break; if (_sp > XB_SPIN_CAP) { atomicAdd(&(bar)[XB_TMO], 1u); break; } } } } while (0)

struct XcdBarrier {
    unsigned* bar; unsigned x;
    volatile LAS unsigned* st;
};

__device__ __forceinline__ XcdBarrier xcd_barrier_post(unsigned* bar, volatile LAS unsigned* st, int tid) {
    XcdBarrier b; b.bar = bar; b.x = xb_xcc_id(); b.st = st;
    if (tid == 0) (void)xb_add(&bar[XB_XCNT(b.x)], 1u);
    return b;
}
__device__ __forceinline__ void xcd_barrier_complete(unsigned* bar, unsigned x, unsigned& nloc, unsigned& nx) {
    const unsigned G = gridDim.x * gridDim.y * gridDim.z;
    unsigned sum, cnt, mine, sp = 0u;
    for (;;) {
        sum = 0u; cnt = 0u; mine = 0u;
#pragma unroll
        for (unsigned j = 0; j < 16; ++j) { const unsigned c = xb_ld(&bar[XB_XCNT(j)]); sum += c; cnt += (c > 0u) ? 1u : 0u; mine = (j == x) ? c : mine; }
        if (sum == G) break;
        __builtin_amdgcn_s_sleep(1);
        if ((++sp & 255u) == 0u) { if (xb_ld(&bar[XB_TMO])) break; if (sp > XB_SPIN_CAP) { atomicAdd(&bar[XB_TMO], 1u); break; } }
    }
    nloc = mine > 0u ? mine : 1u; nx = cnt > 0u ? cnt : 1u;
}

__device__ __forceinline__ void xcd_barrier(const XcdBarrier& b, int tid) {
    asm volatile("s_waitcnt vmcnt(0)" ::: "memory");
    __syncthreads();
    if (tid == 0) {
        unsigned* bar = b.bar;
        __builtin_amdgcn_s_waitcnt(0);
        unsigned nloc = b.st[0], nx = b.st[1];
        if (nloc == 0u) { xcd_barrier_complete(bar, b.x, nloc, nx); b.st[0] = nloc; b.st[1] = nx; }
        const unsigned old = xb_add(&bar[XB_XSUB(b.x)], 1u);
        const unsigned gen = old / nloc;
        if (old + 1u == (gen + 1u) * nloc) {
            __builtin_amdgcn_fence(__ATOMIC_RELEASE, "agent");
            asm volatile("s_waitcnt vmcnt(0)" ::: "memory");
            const unsigned og = xb_add(&bar[XB_TOP], 1u);
            const unsigned tg = og / nx;
            if (og + 1u == (tg + 1u) * nx) xb_add(&bar[XB_TOPGEN], 1u);
            else XB_SPIN(xb_ld(&bar[XB_TOPGEN]) == tg, bar);
            __builtin_amdgcn_fence(__ATOMIC_ACQUIRE, "agent");
            xb_add(&bar[XB_XGEN(b.x)], 1u);
            asm volatile("s_waitcnt vmcnt(0)" ::: "memory");
        } else {
            XB_SPIN(xb_ld(&bar[XB_XGEN(b.x)]) == gen, bar);
            __builtin_amdgcn_fence(__ATOMIC_ACQUIRE, "agent");
            asm volatile("s_waitcnt vmcnt(0)" ::: "memory");
        }
    }
    __syncthreads();
}

constexpr int NWAVES = 8;
constexpr int M_TOK = 10240, M_CTX = 8192, M_KV = 10752, DM = 1024;
constexpr int N_IN = 2560, N_Q = 768, N_KV = 1024, N_FI = 5632, D_FFN = 2816;
constexpr float EPSF = 1e-6f;
constexpr float QSCALE = 0.10206207261596575f * 1.4426950408889634f;

#ifndef MK_PER_PHASE
#define MK_PER_PHASE 0
#endif
#ifndef PHASE_MASK
#define PHASE_MASK 0x1ff
#endif
#define PH_EN(k) (((PHASE_MASK) >> (k)) & 1)
#ifndef REP_MASK
#define REP_MASK 0
#endif
#define REPS(k) (1 + (((REP_MASK) >> (k)) & 1))
constexpr int N_PHASES = 17;

constexpr size_t OUT_Y = 0, OUT_CKV = 10485760, OUT_KROPE = 12582912, OUT_SF = 13107200, OUT_SB = 15204352, OUT_TOTAL = 17301504;

constexpr size_t MiB = 1u << 20;
constexpr size_t WS_CTL = 0, CTL_ZERO_BYTES = 1 * MiB;
constexpr int CW_BAR = 4096;
constexpr int CW_SPLIT = 8192;
constexpr int CW_SS = 16384;
constexpr size_t WS_MOD = 1 * MiB;
constexpr size_t WS_TAB = WS_MOD + 256 * 1024;
constexpr size_t WS_BIAS = WS_MOD + 512 * 1024;
constexpr int BIAS_LD = 8192;
constexpr size_t WS_W = 2 * MiB;
constexpr size_t W_IN_OFF = 0, W_QB_OFF = (size_t)N_IN * 1024 * 2, W_KVB_OFF = W_QB_OFF + (size_t)N_Q * 256 * 2, W_O_OFF = W_KVB_OFF + (size_t)N_KV * 256 * 2,
                 W_FI_OFF = W_O_OFF + (size_t)1024 * 1024 * 2, W_FO_OFF = W_FI_OFF + (size_t)N_FI * 1024 * 2, LAYER_W = W_FO_OFF + (size_t)1024 * D_FFN * 2;
constexpr size_t WS_H = WS_W + 2 * LAYER_W;
constexpr size_t WS_RQ = WS_H + (size_t)M_TOK * 1024 * 2;
constexpr size_t WS_RK = WS_RQ + (size_t)M_TOK * 512 * 2;
constexpr size_t WS_RKT = WS_RK + (size_t)M_TOK * 512 * 2;
constexpr size_t WS_RVT = WS_RKT + (size_t)512 * M_CTX * 2;
constexpr size_t WS_RG = WS_RVT + (size_t)512 * M_TOK * 2;
constexpr size_t WS_QA = WS_RG + (size_t)M_TOK * 512 * 2;
constexpr size_t WS_KVA = WS_QA + (size_t)M_TOK * 256 * 2;
constexpr size_t WS_KR = WS_KVA + (size_t)M_KV * 256 * 2;
constexpr size_t WS_Q = WS_KR + (size_t)M_KV * 32 * 2;
constexpr size_t WS_KN = WS_Q + (size_t)M_TOK * 768 * 2;
constexpr size_t WS_VT = WS_KN + (size_t)M_KV * 512 * 2;
constexpr size_t WS_MIX = WS_VT + (size_t)512 * M_KV * 2;
constexpr size_t WS_ACT = WS_MIX + (size_t)M_TOK * 1024 * 2;
constexpr size_t WS_END = WS_ACT + (size_t)M_TOK * D_FFN * 2;
static_assert(WS_END <= 256 * MiB, "d_ws map exceeds 256 MiB");
static_assert((CW_SS + 7 * M_TOK) * 4 <= (int)CTL_ZERO_BYTES && (CW_BAR + XCD_BAR_WORDS) <= CW_SS, "CTL words");
static_assert(W_QB_OFF % 16 == 0 && W_KVB_OFF % 16 == 0 && W_O_OFF % 16 == 0 && W_FI_OFF % 16 == 0 && W_FO_OFF % 16 == 0 && LAYER_W % 16 == 0, "weight alignment");

constexpr int RING_OFF = 0, RING_BYTES = 131072;
constexpr int LDSCTL_OFF = RING_BYTES, MISC_OFF = LDSCTL_OFF + 320;
constexpr int LDS_BYTES = 147456;

typedef float f32x16 __attribute__((ext_vector_type(16)));
typedef float f32x2_t __attribute__((ext_vector_type(2)));
typedef __bf16 bf16x2_t __attribute__((ext_vector_type(2)));
typedef unsigned u32x2 __attribute__((ext_vector_type(2)));
__device__ __forceinline__ unsigned cvtpk(float lo, float hi) { f32x2_t v = {lo, hi}; bf16x2_t b = __builtin_convertvector(v, bf16x2_t); return __builtin_bit_cast(unsigned, b); }
#if defined(__HIP_DEVICE_COMPILE__)
#define ASSUME_GLOBAL(p) __builtin_assume(!__builtin_amdgcn_is_shared((const __attribute__((address_space(0))) void*)(p)) && !__builtin_amdgcn_is_private((const __attribute__((address_space(0))) void*)(p)))
#else
#define ASSUME_GLOBAL(p) ((void)0)
#endif
template <int K> __device__ __forceinline__ float shx(float v) { static_assert(K >= 1 && K <= 16, "shx"); return __builtin_bit_cast(float, __builtin_amdgcn_ds_swizzle(__builtin_bit_cast(int, v), (K << 10) | 0x1f)); }
__device__ __forceinline__ float sum32(float v) { const unsigned b = __builtin_bit_cast(unsigned, v); auto rr = __builtin_amdgcn_permlane32_swap(b, b, false, false); return __builtin_bit_cast(float, (unsigned)rr[0]) + __builtin_bit_cast(float, (unsigned)rr[1]); }
__device__ __forceinline__ float sum16(float v) { const unsigned b = __builtin_bit_cast(unsigned, v); auto rr = __builtin_amdgcn_permlane16_swap(b, b, false, false); return __builtin_bit_cast(float, (unsigned)rr[0]) + __builtin_bit_cast(float, (unsigned)rr[1]); }
__device__ __forceinline__ float partner32(float v, bool upper_half) { const unsigned b = __builtin_bit_cast(unsigned, v); auto rr = __builtin_amdgcn_permlane32_swap(b, b, false, false); return __builtin_bit_cast(float, (unsigned)(upper_half ? rr[0] : rr[1])); }
__device__ __forceinline__ bf16 f2b(float x) { return (bf16)(cvtpk(x, 0.f) & 0xffffu); }
__device__ __forceinline__ float b2f(unsigned short b) { return __builtin_bit_cast(float, (unsigned)b << 16); }
__device__ __forceinline__ float siluf(float x) { return x * __builtin_amdgcn_rcpf(1.0f + __builtin_amdgcn_exp2f(-1.4426950408889634f * x)); }
__device__ __forceinline__ v4u pack8(const float (&v)[8]) { v4u w; w.x = cvtpk(v[0], v[1]); w.y = cvtpk(v[2], v[3]); w.z = cvtpk(v[4], v[5]); w.w = cvtpk(v[6], v[7]); return w; }
__device__ __forceinline__ void ld8(const pg8::f32x4 (&a)[2], float (&v)[8]) { v[0] = a[0][0]; v[1] = a[0][1]; v[2] = a[0][2]; v[3] = a[0][3]; v[4] = a[1][0]; v[5] = a[1][1]; v[6] = a[1][2]; v[7] = a[1][3]; }

struct Params {
    const float* in[28];
    float* out;
    unsigned char* ws;
    int ph_lo, ph_hi;
};


struct EpiG1 {
    static constexpr bool PERM = true, AFTER_DRAIN = false;
    unsigned char* ws_; const float* gin[3]; float* out_; int layer; int no_atomics; int rs_idx; LAS float* lss;
    __device__ __forceinline__ void operator()(const pg8::f32x4 (&acc)[2][2][4][2], const pg8::Unit& u, int wr, int wc, int fr, int fq) const {
        asm volatile("" : "+v"(fr), "+v"(fq));
        unsigned long long zo_ = 0ull; asm volatile("" : "+s"(zo_)); unsigned char* ws = ws_ + zo_;
        bf16* const RQ = (bf16*)(ws + WS_RQ); bf16* const RK = (bf16*)(ws + WS_RK); bf16* const RKT = (bf16*)(ws + WS_RKT); bf16* const RVT = (bf16*)(ws + WS_RVT); bf16* const RG = (bf16*)(ws + WS_RG);
        bf16* const QA = (bf16*)(ws + WS_QA); bf16* const KVA = (bf16*)(ws + WS_KVA); bf16* const KR = (bf16*)(ws + WS_KR);
        float* const ssq = (float*)(ws + WS_CTL + 4 * CW_SS) + (size_t)(layer * 2) * M_TOK; float* const sskv = ssq + M_TOK;
        const float2* const tab64 = (const float2*)(ws + WS_TAB); const float2* const tab32 = tab64 + 64 * 16;
        const float* const g_q_a = gin[0]; const float* const g_kv_a = gin[1]; const float* const g_kr = gin[2]; float* const out_krope = out_ + OUT_KROPE;
        const int pn = u.pn; const bool lat = u.pm >= 32;
        const bool rs_on = rs_idx >= 0;
        const float* const rsp = (const float*)(ws + WS_CTL + 4 * CW_SS) + (size_t)(rs_on ? rs_idx : 0) * M_TOK;
        float bz[2][8];
        { const int cond = (u.pm < 32) ? 0 : 1 + ((u.pm - 32) >> 2); const float* bp = (const float*)(ws + WS_BIAS) + (size_t)(layer * 3 + cond) * BIAS_LD + pn * 256 + wc * 32 + fq * 8;
#pragma unroll
          for (int bj = 0; bj < 2; ++bj) {
              pg8::f32x4 b0 = {0.f, 0.f, 0.f, 0.f}, b1 = b0; if (rs_on) { b0 = *(const pg8::f32x4*)(bp + bj * 128); b1 = *(const pg8::f32x4*)(bp + bj * 128 + 4); }
#pragma unroll
              for (int e = 0; e < 4; ++e) { bz[bj][e] = b0[e]; bz[bj][4 + e] = b1[e]; } } }
        float rsv[2][4];
#pragma unroll
        for (int ai = 0; ai < 2; ++ai)
#pragma unroll
            for (int m = 0; m < 4; ++m) rsv[ai][m] = rs_on ? rsp[u.pm * 256 + ai * 128 + wr * 64 + m * 16 + fr] : 0.f;
#define G1_LD(bj_, v_) do { ld8(acc[ai][bj_][m], v_); if (rs_on) { _Pragma("unroll") for (int e_ = 0; e_ < 8; ++e_) v_[e_] = v_[e_] * rs + bz[bj_][e_]; } } while (0)
        if (pn < 4) {
            bf16* dst = (pn < 2) ? RQ : RK; const int cb = (pn & 1) * 256;
#pragma unroll
            for (int ai = 0; ai < 2; ++ai)
#pragma unroll
                for (int m = 0; m < 4; ++m) {
                    asm volatile("" ::: "memory"); const int r = u.pm * 256 + ai * 128 + wr * 64 + m * 16 + fr; const float rs = rs_on ? __builtin_amdgcn_rsqf(rsv[ai][m] * (1.0f / 1024.0f) + EPSF) : 1.0f;
                    const int n = (r - M_CTX) & 1023, prow = n >> 6, pcol = n & 63;
#pragma unroll
                    for (int bj = 0; bj < 2; ++bj) {
                        float v[8]; G1_LD(bj, v);
                        const int c = cb + bj * 128 + wc * 32 + fq * 8;
                        if (lat) {
                            const int pos = (wc & 1) ? pcol : prow;
                            const float2* tb = tab64 + pos * 16 + (fq & 1) * 8;
#pragma unroll
                            for (int e = 0; e < 8; ++e) { const float pv = partner32(v[e], fq >= 2); const float2 cs = tb[e]; v[e] = (fq < 2) ? (v[e] * cs.x - pv * cs.y) : (pv * cs.y + v[e] * cs.x); }
                        }
                        *(v4u*)(dst + (size_t)r * 512 + c) = pack8(v);
                        if (pn >= 2 && !lat) {
#pragma unroll
                            for (int e = 0; e < 8; ++e) RKT[(size_t)(c + e) * M_CTX + r] = f2b(v[e]);
                        }
                    }
                }
        } else if (pn < 6) {
            const int cb = (pn - 4) * 256;
#pragma unroll
            for (int ai = 0; ai < 2; ++ai)
#pragma unroll
                for (int m = 0; m < 4; ++m) {
                    asm volatile("" ::: "memory"); const int r = u.pm * 256 + ai * 128 + wr * 64 + m * 16 + fr; const float rs = rs_on ? __builtin_amdgcn_rsqf(rsv[ai][m] * (1.0f / 1024.0f) + EPSF) : 1.0f;
#pragma unroll
                    for (int bj = 0; bj < 2; ++bj) {
                        float v[8]; G1_LD(bj, v);
                        const int c = cb + bj * 128 + wc * 32 + fq * 8;
#pragma unroll
                        for (int e = 0; e < 8; ++e) RVT[(size_t)(c + e) * M_TOK + r] = f2b(v[e]);
                    }
                }
        } else if (pn < 8) {
            const int cb = (pn - 6) * 256;
#pragma unroll
            for (int ai = 0; ai < 2; ++ai)
#pragma unroll
                for (int m = 0; m < 4; ++m) {
                    asm volatile("" ::: "memory"); const int r = u.pm * 256 + ai * 128 + wr * 64 + m * 16 + fr; const float rs = rs_on ? __builtin_amdgcn_rsqf(rsv[ai][m] * (1.0f / 1024.0f) + EPSF) : 1.0f;
#pragma unroll
                    for (int bj = 0; bj < 2; ++bj) {
                        float v[8]; G1_LD(bj, v);
#pragma unroll
                        for (int e = 0; e < 8; ++e) v[e] = siluf(v[e]);
                        *(v4u*)(RG + (size_t)r * 512 + cb + bj * 128 + wc * 32 + fq * 8) = pack8(v);
                    }
                }
        } else if (pn == 8) {
            pg8::f32x4 gqa[2][2];
#pragma unroll
            for (int bj = 0; bj < 2; ++bj) { const int c = bj * 128 + wc * 32 + fq * 8; gqa[bj][0] = *(const pg8::f32x4*)(g_q_a + c); gqa[bj][1] = *(const pg8::f32x4*)(g_q_a + c + 4); }
#pragma unroll
            for (int ai = 0; ai < 2; ++ai)
#pragma unroll
                for (int m = 0; m < 4; ++m) {
                    asm volatile("" ::: "memory"); const int r = u.pm * 256 + ai * 128 + wr * 64 + m * 16 + fr; const float rs = rs_on ? __builtin_amdgcn_rsqf(rsv[ai][m] * (1.0f / 1024.0f) + EPSF) : 1.0f;
                    float part = 0.f;
#pragma unroll
                    for (int bj = 0; bj < 2; ++bj) {
                        float v[8]; G1_LD(bj, v);
                        const int c = bj * 128 + wc * 32 + fq * 8;
#pragma unroll
                        for (int e = 0; e < 8; ++e) { part += v[e] * v[e]; v[e] *= (e < 4 ? gqa[bj][0][e & 3] : gqa[bj][1][e & 3]); }
                        *(v4u*)(QA + (size_t)r * 256 + c) = pack8(v);
                    }
                    part = sum16(part); part = sum32(part);
                    if (fq == 0) { if (lss) lss[wc * 256 + ai * 128 + wr * 64 + m * 16 + fr] = part; else if (!no_atomics) atomicAdd(ssq + r, part); }
                }
        } else {
            pg8::f32x4 gkv[2]; { const int c = wc * 32 + fq * 8; gkv[0] = *(const pg8::f32x4*)(g_kv_a + c); gkv[1] = *(const pg8::f32x4*)(g_kv_a + c + 4); }
#pragma unroll
            for (int ai = 0; ai < 2; ++ai)
#pragma unroll
                for (int m = 0; m < 4; ++m) {
                    asm volatile("" ::: "memory"); const int r = u.pm * 256 + ai * 128 + wr * 64 + m * 16 + fr; const float rs = rs_on ? __builtin_amdgcn_rsqf(rsv[ai][m] * (1.0f / 1024.0f) + EPSF) : 1.0f;
                    {
                        float v[8]; G1_LD(0, v);
                        const int c = wc * 32 + fq * 8;
                        float part = 0.f;
#pragma unroll
                        for (int e = 0; e < 8; ++e) { part += v[e] * v[e]; v[e] *= (e < 4 ? gkv[0][e & 3] : gkv[1][e & 3]); }
                        *(v4u*)(KVA + (size_t)r * 256 + c) = pack8(v);
                        part = sum16(part); part = sum32(part);
                        if (fq == 0) { if (lss) lss[wc * 256 + ai * 128 + wr * 64 + m * 16 + fr] = part; else if (!no_atomics) atomicAdd(sskv + r, part); }
                    }
                    if (wc == 0) {
                        float v[8]; G1_LD(1, v);
                        float ss = 0.f;
#pragma unroll
                        for (int e = 0; e < 8; ++e) ss += v[e] * v[e];
                        ss = sum16(ss); ss = sum32(ss);
                        const float rstd = __builtin_amdgcn_rsqf(ss * (1.0f / 32.0f) + EPSF);
                        const pg8::f32x4 g0 = *(const pg8::f32x4*)(g_kr + fq * 8), g1 = *(const pg8::f32x4*)(g_kr + fq * 8 + 4);
#pragma unroll
                        for (int e = 0; e < 8; ++e) v[e] *= rstd * (e < 4 ? g0[e & 3] : g1[e & 3]);
                        if (!lat) {
                            float* o = out_krope + ((size_t)((r >> 8) * 2 + layer) * 256 + (r & 255)) * 32 + fq * 8;
                            __builtin_nontemporal_store((pg8::f32x4){v[0], v[1], v[2], v[3]}, (pg8::f32x4*)o); __builtin_nontemporal_store((pg8::f32x4){v[4], v[5], v[6], v[7]}, (pg8::f32x4*)(o + 4));
                        } else {
                            const int n = (r - M_CTX) & 1023, pos = (fq < 2) ? (n >> 6) : (n & 63);
                            const float2* tb = tab32 + pos * 8;
#pragma unroll
                            for (int e = 0; e < 8; ++e) { const float pv = shx<16>(v[e]); const float2 cs = tb[e]; v[e] = ((fq & 1) == 0) ? (v[e] * cs.x - pv * cs.y) : (pv * cs.y + v[e] * cs.x); }
                        }
                        *(v4u*)(KR + (size_t)r * 32 + fq * 8) = pack8(v);
                    }
                }
        }
    }
#undef G1_LD
};

struct EpiQ {
    static constexpr bool PERM = true, AFTER_DRAIN = false;
    unsigned char* ws_; const float *g_qn, *g_qr; int layer;
    __device__ __forceinline__ void operator()(const pg8::f32x4 (&acc)[2][2][4][2], const pg8::Unit& u, int wr, int wc, int fr, int fq) const {
        asm volatile("" : "+v"(fr), "+v"(fq));
        unsigned long long zo_ = 0ull; asm volatile("" : "+s"(zo_)); unsigned char* ws = ws_ + zo_;
        bf16* const Q = (bf16*)(ws + WS_Q); const float* const ssq = (const float*)(ws + WS_CTL + 4 * CW_SS) + (size_t)(layer * 2) * M_TOK; const float2* const tab32 = (const float2*)(ws + WS_TAB) + 64 * 16;
        const int pn = u.pn; const bool lat = u.pm >= 32;
        float ssv[2][4];
        pg8::f32x4 gq[2][2];
#pragma unroll
        for (int bj = 0; bj < 2; ++bj) { const float* gp_ = (pn < 2) ? g_qn + 32 * bj + fq * 8 : g_qr + fq * 8; gq[bj][0] = *(const pg8::f32x4*)gp_; gq[bj][1] = *(const pg8::f32x4*)(gp_ + 4); }
#pragma unroll
        for (int ai = 0; ai < 2; ++ai)
#pragma unroll
            for (int m = 0; m < 4; ++m) ssv[ai][m] = ssq[u.pm * 256 + ai * 128 + wr * 64 + m * 16 + fr];
#pragma unroll
        for (int ai = 0; ai < 2; ++ai)
#pragma unroll
            for (int m = 0; m < 4; ++m) {
                asm volatile("" ::: "memory"); const int r = u.pm * 256 + ai * 128 + wr * 64 + m * 16 + fr;
                const float al = __builtin_amdgcn_rsqf(ssv[ai][m] * (1.0f / 256.0f) + EPSF), a2 = al * al;
                if (pn < 2) {
                    float ss = 0.f;
#pragma unroll
                    for (int bj = 0; bj < 2; ++bj)
#pragma unroll
                        for (int n = 0; n < 2; ++n) { const pg8::f32x4 x = acc[ai][bj][m][n]; ss += (x[0] * x[0] + x[1] * x[1]) + (x[2] * x[2] + x[3] * x[3]); }
                    ss = sum16(ss); ss = sum32(ss);
                    const float f = al * __builtin_amdgcn_rsqf(a2 * ss * (1.0f / 64.0f) + EPSF) * QSCALE;
                    const int h = 4 * pn + wc;
                    bf16* o = Q + (size_t)r * 768 + h * 96 + fq * 8;
#pragma unroll
                    for (int bj = 0; bj < 2; ++bj) {
                        float v[8]; ld8(acc[ai][bj][m], v);
#pragma unroll
                        for (int e = 0; e < 8; ++e) v[e] *= f * (e < 4 ? gq[bj][0][e & 3] : gq[bj][1][e & 3]);
                        *(v4u*)(o + 32 * bj) = pack8(v);
                    }
                } else {
                    const int n = (r - M_CTX) & 1023, pos = (fq < 2) ? (n >> 6) : (n & 63);
                    const float2* tb = tab32 + pos * 8;
#pragma unroll
                    for (int bj = 0; bj < 2; ++bj) {
                        float v[8]; ld8(acc[ai][bj][m], v);
                        float ss = 0.f;
#pragma unroll
                        for (int e = 0; e < 8; ++e) ss += v[e] * v[e];
                        ss = sum16(ss); ss = sum32(ss);
                        const float f = al * __builtin_amdgcn_rsqf(a2 * ss * (1.0f / 32.0f) + EPSF) * QSCALE;
#pragma unroll
                        for (int e = 0; e < 8; ++e) v[e] *= f * (e < 4 ? gq[bj][0][e & 3] : gq[bj][1][e & 3]);
                        if (lat) {
#pragma unroll
                            for (int e = 0; e < 8; ++e) { const float pv = shx<16>(v[e]); const float2 cs = tb[e]; v[e] = ((fq & 1) == 0) ? (v[e] * cs.x - pv * cs.y) : (pv * cs.y + v[e] * cs.x); }
                        }
                        const int h = 4 * bj + wc;
                        *(v4u*)(Q + (size_t)r * 768 + h * 96 + 64 + fq * 8) = pack8(v);
                    }
                }
            }
    }
};

struct EpiKV {
    static constexpr bool PERM = true, AFTER_DRAIN = false;
    unsigned char* ws_; const float* g_kn; int layer;
    __device__ __forceinline__ void operator()(const pg8::f32x4 (&acc)[2][2][4][2], const pg8::Unit& u, int wr, int wc, int fr, int fq) const {
        asm volatile("" : "+v"(fr), "+v"(fq));
        unsigned long long zo_ = 0ull; asm volatile("" : "+s"(zo_)); unsigned char* ws = ws_ + zo_;
        bf16* const KN = (bf16*)(ws + WS_KN); bf16* const VT = (bf16*)(ws + WS_VT); const float* const sskv = (const float*)(ws + WS_CTL + 4 * CW_SS) + (size_t)(layer * 2 + 1) * M_TOK;
        const int pn = u.pn;
        float ssv[2][4];
#pragma unroll
        for (int ai = 0; ai < 2; ++ai)
#pragma unroll
            for (int m = 0; m < 4; ++m) { const int r_ = u.pm * 256 + ai * 128 + wr * 64 + m * 16 + fr; ssv[ai][m] = sskv[r_ < M_TOK ? r_ : 0]; }
#pragma unroll
        for (int ai = 0; ai < 2; ++ai)
#pragma unroll
            for (int m = 0; m < 4; ++m) {
                asm volatile("" ::: "memory"); const int r = u.pm * 256 + ai * 128 + wr * 64 + m * 16 + fr;
                const float al = (r < M_TOK) ? __builtin_amdgcn_rsqf(ssv[ai][m] * (1.0f / 128.0f) + EPSF) : 1.0f, a2 = al * al;
                if (pn < 2) {
                    float ss = 0.f;
#pragma unroll
                    for (int bj = 0; bj < 2; ++bj)
#pragma unroll
                        for (int n = 0; n < 2; ++n) { const pg8::f32x4 x = acc[ai][bj][m][n]; ss += (x[0] * x[0] + x[1] * x[1]) + (x[2] * x[2] + x[3] * x[3]); }
                    ss = sum16(ss); ss = sum32(ss);
                    const float f = al * __builtin_amdgcn_rsqf(a2 * ss * (1.0f / 64.0f) + EPSF);
                    const int h = 4 * pn + wc;
                    bf16* o = KN + (size_t)r * 512 + h * 64 + fq * 8;
#pragma unroll
                    for (int bj = 0; bj < 2; ++bj) {
                        float v[8]; ld8(acc[ai][bj][m], v);
                        const pg8::f32x4 ga = *(const pg8::f32x4*)(g_kn + 32 * bj + fq * 8), gb = *(const pg8::f32x4*)(g_kn + 32 * bj + fq * 8 + 4);
#pragma unroll
                        for (int e = 0; e < 8; ++e) v[e] *= f * (e < 4 ? ga[e & 3] : gb[e & 3]);
                        *(v4u*)(o + 32 * bj) = pack8(v);
                    }
                } else {
                    const int h = 4 * (pn - 2) + wc;
#pragma unroll
                    for (int bj = 0; bj < 2; ++bj) {
                        float v[8]; ld8(acc[ai][bj][m], v);
#pragma unroll
                        for (int e = 0; e < 8; ++e) VT[(size_t)(h * 64 + bj * 32 + fq * 8 + e) * M_KV + r] = f2b(v[e] * al);
                    }
                }
            }
    }
};

template <bool SRC16, bool DST16>
struct EpiResT {
    static constexpr bool PERM = false, AFTER_DRAIN = false;
    const float *xs0, *xs1;
    float* out; const float* gate;
    bf16* H; const float* nn_g; const float* nn_sc; float* rowss; int final_out;
    bf16* xb_dst; const bf16* xb_src;
    __device__ __forceinline__ void operator()(const pg8::f32x4 (&acc_)[2][2][4][2], const pg8::Unit& u, int wr, int wc, int fr, int fq) const {
        asm volatile("" : "+v"(fr), "+v"(fq));
        pg8::f32x4 (&acc)[2][2][4][2] = const_cast<pg8::f32x4 (&)[2][2][4][2]>(acc_);
        const int cond = (u.pm < 32) ? 0 : 1 + ((u.pm - 32) >> 2);
        const float* gp = gate + cond * 6144;
        const int col0 = u.pn * 256 + wc * 32 + 4 * fq;
        const bool nn = nn_g != nullptr;
        pg8::f32x4 gv[2][2], gg[2][2]; float ssv[2][4];
#pragma unroll
        for (int bj = 0; bj < 2; ++bj)
#pragma unroll
            for (int n = 0; n < 2; ++n) { const int c = col0 + bj * 128 + n * 16; gv[bj][n] = *(const pg8::f32x4*)(gp + c);
                if (nn) { const pg8::f32x4 g0 = *(const pg8::f32x4*)(nn_g + c), s0 = *(const pg8::f32x4*)(nn_sc + cond * 6144 + c); gg[bj][n] = g0 * (s0 + 1.0f); } else gg[bj][n] = (pg8::f32x4){0.f, 0.f, 0.f, 0.f}; }
#pragma unroll
        for (int ai = 0; ai < 2; ++ai)
#pragma unroll
            for (int bj = 0; bj < 2; ++bj)
#pragma unroll
                for (int m = 0; m < 4; ++m)
#pragma unroll
                    for (int n = 0; n < 2; ++n) acc[ai][bj][m][n] *= gv[bj][n];
        asm volatile("" ::: "memory");
        const int r0 = u.pm * 256 + wr * 64 + fr;
        const float* src0 = (r0 < M_CTX) ? xs0 + (size_t)r0 * 1024 : xs1 + (size_t)(r0 - M_CTX) * 1024;
        pg8::f32x4 x[2][2][2];
#define RES_LOAD(q_) do { _Pragma("unroll") for (int mm = 0; mm < 2; ++mm) _Pragma("unroll") for (int bj = 0; bj < 2; ++bj) _Pragma("unroll") for (int n = 0; n < 2; ++n) \
            x[mm][bj][n] = *(const pg8::f32x4*)(src0 + (size_t)(((q_) >> 1) * 128 + (((q_) & 1) * 2 + mm) * 16) * 1024 + col0 + bj * 128 + n * 16); } while (0)
#define RES_MATH(q_) do { _Pragma("unroll") for (int mm = 0; mm < 2; ++mm) { float ss = 0.f; _Pragma("unroll") for (int bj = 0; bj < 2; ++bj) _Pragma("unroll") for (int n = 0; n < 2; ++n) { \
            const pg8::f32x4 o = x[mm][bj][n] + acc[(q_) >> 1][bj][((q_) & 1) * 2 + mm][n]; acc[(q_) >> 1][bj][((q_) & 1) * 2 + mm][n] = o; ss += (o[0] * o[0] + o[1] * o[1]) + (o[2] * o[2] + o[3] * o[3]); } \
            ssv[(q_) >> 1][((q_) & 1) * 2 + mm] = ss; } } while (0)
#define RES_STORE(q_) do { _Pragma("unroll") for (int mm = 0; mm < 2; ++mm) { const size_t ro = (size_t)(r0 + ((q_) >> 1) * 128 + (((q_) & 1) * 2 + mm) * 16) * 1024; _Pragma("unroll") for (int bj = 0; bj < 2; ++bj) _Pragma("unroll") for (int n = 0; n < 2; ++n) { \
            const int c = col0 + bj * 128 + n * 16; const pg8::f32x4 o = acc[(q_) >> 1][bj][((q_) & 1) * 2 + mm][n]; if constexpr (DST16) *(u32x2*)(xb_dst + ro + c) = (u32x2){cvtpk(o[0], o[1]), cvtpk(o[2], o[3])}; else if (final_out) __builtin_nontemporal_store(o, (pg8::f32x4*)(out + ro + c)); else *(pg8::f32x4*)(out + ro + c) = o; \
            if (nn) { const pg8::f32x4 y = o * gg[bj][n]; *(u32x2*)(H + ro + c) = (u32x2){cvtpk(y[0], y[1]), cvtpk(y[2], y[3])}; } } } } while (0)
#define RES_FENCE() asm volatile("" ::: "memory")
        if constexpr (SRC16) {
            const bf16* sb0 = xb_src + (size_t)r0 * 1024;
            u32x2 xh[2][2][2][2];
#define HALF_LOAD(h_) do { _Pragma("unroll") for (int qq = 0; qq < 2; ++qq) _Pragma("unroll") for (int mm = 0; mm < 2; ++mm) _Pragma("unroll") for (int bj = 0; bj < 2; ++bj) _Pragma("unroll") for (int n = 0; n < 2; ++n) \
                xh[qq][mm][bj][n] = *(const u32x2*)(sb0 + (size_t)((h_) * 128 + (qq * 2 + mm) * 16) * 1024 + col0 + bj * 128 + n * 16); } while (0)
#define HALF_CVT(qq_) do { _Pragma("unroll") for (int mm = 0; mm < 2; ++mm) _Pragma("unroll") for (int bj = 0; bj < 2; ++bj) _Pragma("unroll") for (int n = 0; n < 2; ++n) { const u32x2 w = xh[qq_][mm][bj][n]; \
                x[mm][bj][n] = (pg8::f32x4){__builtin_bit_cast(float, w.x << 16), __builtin_bit_cast(float, w.x & 0xffff0000u), __builtin_bit_cast(float, w.y << 16), __builtin_bit_cast(float, w.y & 0xffff0000u)}; } } while (0)
            HALF_LOAD(0); HALF_CVT(0); RES_MATH(0); HALF_CVT(1); RES_MATH(1); RES_FENCE();
            HALF_LOAD(1); RES_FENCE(); RES_STORE(0); RES_STORE(1); HALF_CVT(0); RES_MATH(2); HALF_CVT(1); RES_MATH(3); RES_FENCE();
            RES_STORE(2); RES_STORE(3);
#undef HALF_LOAD
#undef HALF_CVT
        } else {
        RES_LOAD(0); RES_MATH(0); RES_FENCE();
        RES_LOAD(1); RES_FENCE(); RES_STORE(0); RES_MATH(1); RES_FENCE();
        RES_LOAD(2); RES_FENCE(); RES_STORE(1); RES_MATH(2); RES_FENCE();
        RES_LOAD(3); RES_FENCE(); RES_STORE(2); RES_MATH(3); RES_FENCE();
        RES_STORE(3);
        }
#undef RES_FENCE
#undef RES_LOAD
#undef RES_MATH
#undef RES_STORE
        if (nn) {
#pragma unroll
            for (int ai = 0; ai < 2; ++ai)
#pragma unroll
                for (int m = 0; m < 4; ++m) { float ss = ssv[ai][m]; ss = sum16(ss); ss = sum32(ss);
                    if (fq == 0) atomicAdd(rowss + r0 + ai * 128 + m * 16, ss); }
        }
    }
};
template <bool SRC16, bool DST16>
struct EpiResW {
    static constexpr bool PERM = true, AFTER_DRAIN = false;
    const float *xs0, *xs1;
    float* out; const float* gate;
    bf16* H; const float* nn_g; const float* nn_sc; float* rowss; int final_out;
    bf16* xb_dst; const bf16* xb_src;
    __device__ __forceinline__ void operator()(const pg8::f32x4 (&acc_)[2][2][4][2], const pg8::Unit& u, int wr, int wc, int fr, int fq) const {
        asm volatile("" : "+v"(fr), "+v"(fq));
        pg8::f32x4 (&acc)[2][2][4][2] = const_cast<pg8::f32x4 (&)[2][2][4][2]>(acc_);
        const int cond = (u.pm < 32) ? 0 : 1 + ((u.pm - 32) >> 2);
        const float* gp = gate + cond * 6144;
        const int col0 = u.pn * 256 + wc * 32 + 8 * fq;
        const bool nn = nn_g != nullptr;
        pg8::f32x4 gv[2][2], gg[2][2]; float ssv[2][4];
#pragma unroll
        for (int bj = 0; bj < 2; ++bj)
#pragma unroll
            for (int n = 0; n < 2; ++n) { const int c = col0 + bj * 128 + n * 4; gv[bj][n] = *(const pg8::f32x4*)(gp + c);
                if (nn) { const pg8::f32x4 g0 = *(const pg8::f32x4*)(nn_g + c), s0 = *(const pg8::f32x4*)(nn_sc + cond * 6144 + c); gg[bj][n] = g0 * (s0 + 1.0f); } else gg[bj][n] = (pg8::f32x4){0.f, 0.f, 0.f, 0.f}; }
#pragma unroll
        for (int ai = 0; ai < 2; ++ai)
#pragma unroll
            for (int bj = 0; bj < 2; ++bj)
#pragma unroll
                for (int m = 0; m < 4; ++m)
#pragma unroll
                    for (int n = 0; n < 2; ++n) acc[ai][bj][m][n] *= gv[bj][n];
        asm volatile("" ::: "memory");
        const int r0 = u.pm * 256 + wr * 64 + fr;
        const float* src0 = (r0 < M_CTX) ? xs0 + (size_t)r0 * 1024 : xs1 + (size_t)(r0 - M_CTX) * 1024;
        pg8::f32x4 x[2][2][2];
#define RES_LOAD(q_) do { _Pragma("unroll") for (int mm = 0; mm < 2; ++mm) _Pragma("unroll") for (int bj = 0; bj < 2; ++bj) _Pragma("unroll") for (int n = 0; n < 2; ++n) \
            x[mm][bj][n] = *(const pg8::f32x4*)(src0 + (size_t)(((q_) >> 1) * 128 + (((q_) & 1) * 2 + mm) * 16) * 1024 + col0 + bj * 128 + n * 4); } while (0)
#define RES_MATH(q_) do { _Pragma("unroll") for (int mm = 0; mm < 2; ++mm) { float ss = 0.f; _Pragma("unroll") for (int bj = 0; bj < 2; ++bj) _Pragma("unroll") for (int n = 0; n < 2; ++n) { \
            const pg8::f32x4 o = x[mm][bj][n] + acc[(q_) >> 1][bj][((q_) & 1) * 2 + mm][n]; acc[(q_) >> 1][bj][((q_) & 1) * 2 + mm][n] = o; ss += (o[0] * o[0] + o[1] * o[1]) + (o[2] * o[2] + o[3] * o[3]); } \
            ssv[(q_) >> 1][((q_) & 1) * 2 + mm] = ss; } } while (0)
#define RES_STORE(q_) do { _Pragma("unroll") for (int mm = 0; mm < 2; ++mm) { const size_t ro = (size_t)(r0 + ((q_) >> 1) * 128 + (((q_) & 1) * 2 + mm) * 16) * 1024; _Pragma("unroll") for (int bj = 0; bj < 2; ++bj) { \
            const int c = col0 + bj * 128; const pg8::f32x4 o0 = acc[(q_) >> 1][bj][((q_) & 1) * 2 + mm][0], o1 = acc[(q_) >> 1][bj][((q_) & 1) * 2 + mm][1]; \
            if constexpr (DST16) *(v4u*)(xb_dst + ro + c) = (v4u){cvtpk(o0[0], o0[1]), cvtpk(o0[2], o0[3]), cvtpk(o1[0], o1[1]), cvtpk(o1[2], o1[3])}; \
            else if (final_out) { __builtin_nontemporal_store(o0, (pg8::f32x4*)(out + ro + c)); __builtin_nontemporal_store(o1, (pg8::f32x4*)(out + ro + c + 4)); } else { *(pg8::f32x4*)(out + ro + c) = o0; *(pg8::f32x4*)(out + ro + c + 4) = o1; } \
            if (nn) { const pg8::f32x4 y0 = o0 * gg[bj][0], y1 = o1 * gg[bj][1]; *(v4u*)(H + ro + c) = (v4u){cvtpk(y0[0], y0[1]), cvtpk(y0[2], y0[3]), cvtpk(y1[0], y1[1]), cvtpk(y1[2], y1[3])}; } } } } while (0)
#define RES_FENCE() asm volatile("" ::: "memory")
        if constexpr (SRC16) {
            const bf16* sb0 = xb_src + (size_t)r0 * 1024;
            v4u xh[2][2][2];
#define HALF_LOAD(h_) do { _Pragma("unroll") for (int qq = 0; qq < 2; ++qq) _Pragma("unroll") for (int mm = 0; mm < 2; ++mm) _Pragma("unroll") for (int bj = 0; bj < 2; ++bj) \
                xh[qq][mm][bj] = *(const v4u*)(sb0 + (size_t)((h_) * 128 + (qq * 2 + mm) * 16) * 1024 + col0 + bj * 128); } while (0)
#define HALF_CVT(qq_) do { _Pragma("unroll") for (int mm = 0; mm < 2; ++mm) _Pragma("unroll") for (int bj = 0; bj < 2; ++bj) { const v4u w = xh[qq_][mm][bj]; \
                x[mm][bj][0] = (pg8::f32x4){__builtin_bit_cast(float, w.x << 16), __builtin_bit_cast(float, w.x & 0xffff0000u), __builtin_bit_cast(float, w.y << 16), __builtin_bit_cast(float, w.y & 0xffff0000u)}; \
                x[mm][bj][1] = (pg8::f32x4){__builtin_bit_cast(float, w.z << 16), __builtin_bit_cast(float, w.z & 0xffff0000u), __builtin_bit_cast(float, w.w << 16), __builtin_bit_cast(float, w.w & 0xffff0000u)}; } } while (0)
            HALF_LOAD(0); HALF_CVT(0); RES_MATH(0); HALF_CVT(1); RES_MATH(1); RES_FENCE();
            HALF_LOAD(1); RES_FENCE(); RES_STORE(0); RES_STORE(1); HALF_CVT(0); RES_MATH(2); HALF_CVT(1); RES_MATH(3); RES_FENCE();
            RES_STORE(2); RES_STORE(3);
#undef HALF_LOAD
#undef HALF_CVT
        } else {
        RES_LOAD(0); RES_MATH(0); RES_FENCE();
        RES_LOAD(1); RES_FENCE(); RES_STORE(0); RES_MATH(1); RES_FENCE();
        RES_LOAD(2); RES_FENCE(); RES_STORE(1); RES_MATH(2); RES_FENCE();
        RES_LOAD(3); RES_FENCE(); RES_STORE(2); RES_MATH(3); RES_FENCE();
        RES_STORE(3);
        }
#undef RES_FENCE
#undef RES_LOAD
#undef RES_MATH
#undef RES_STORE
        if (nn) {
            int lq_; asm volatile("v_mbcnt_lo_u32_b32 %0, -1, 0\n\tv_mbcnt_hi_u32_b32 %0, -1, %0" : "=v"(lq_)); lq_ >>= 4;
#pragma unroll
            for (int ai = 0; ai < 2; ++ai)
#pragma unroll
                for (int m = 0; m < 4; ++m) { float ss = ssv[ai][m]; ss = sum16(ss); ss = sum32(ss);
                    if (lq_ == 0) atomicAdd(rowss + r0 + ai * 128 + m * 16, ss); }
        }
    }
};

struct EpiFfn {
    static constexpr bool PERM = true, AFTER_DRAIN = false;
    bf16* ACT_; const float* rowss; const float* bias;
    __device__ __forceinline__ void operator()(const pg8::f32x4 (&acc)[2][2][4][2], const pg8::Unit& u, int wr, int wc, int fr, int fq) const {
        asm volatile("" : "+v"(fr), "+v"(fq));
        unsigned long long zo_ = 0ull; asm volatile("" : "+s"(zo_)); bf16* ACT = ACT_ + zo_;
        const int cond = (u.pm < 32) ? 0 : 1 + ((u.pm - 32) >> 2);
        const float* bp = bias + (size_t)cond * BIAS_LD + u.pn * 256 + wc * 32 + fq * 8;
        float bg[8], bu[8];
        { const pg8::f32x4 b0 = *(const pg8::f32x4*)bp, b1 = *(const pg8::f32x4*)(bp + 4), b2 = *(const pg8::f32x4*)(bp + 128), b3 = *(const pg8::f32x4*)(bp + 132);
#pragma unroll
          for (int e = 0; e < 4; ++e) { bg[e] = b0[e]; bg[4 + e] = b1[e]; bu[e] = b2[e]; bu[4 + e] = b3[e]; } }
        float rsv[2][4];
#pragma unroll
        for (int ai = 0; ai < 2; ++ai)
#pragma unroll
            for (int m = 0; m < 4; ++m) rsv[ai][m] = rowss[u.pm * 256 + ai * 128 + wr * 64 + m * 16 + fr];
#pragma unroll
        for (int ai = 0; ai < 2; ++ai)
#pragma unroll
            for (int m = 0; m < 4; ++m) {
                asm volatile("" ::: "memory"); const int r = u.pm * 256 + ai * 128 + wr * 64 + m * 16 + fr;
                const float rs = __builtin_amdgcn_rsqf(rsv[ai][m] * (1.0f / 1024.0f) + EPSF);
                float g[8], up[8]; ld8(acc[ai][0][m], g); ld8(acc[ai][1][m], up);
#pragma unroll
                for (int e = 0; e < 8; ++e) g[e] = siluf(g[e] * rs + bg[e]) * (up[e] * rs + bu[e]);
                *(v4u*)(ACT + (size_t)r * D_FFN + u.pn * 128 + wc * 32 + fq * 8) = pack8(g);
            }
    }
};

struct RevOrder : pg8::StaticOrder {
    __device__ __forceinline__ bool next(int i, pg8::Unit& u) const { if (!pg8::StaticOrder::next(i, u)) return false; u.pm = nM - 1 - u.pm; return true; }
};

#ifndef CHAIN_QREP
#define CHAIN_QREP 1
#endif
#ifndef CHAIN_KVREP
#define CHAIN_KVREP 1
#endif
struct WinOrder : pg8::StaticOrder {
    bool sp;
    __device__ __forceinline__ bool next(int i, pg8::Unit& u) const {
        if (!sp) { if (!pg8::StaticOrder::next(i, u)) return false; u.pm = nM - 1 - u.pm; return true; }
        const int x = c & 7, k = c >> 3;
        if (k < 10) { if (i > 0) return false; u.pm = 39 - (5 * x + (k >> 1)); u.pn = 8 + (k & 1); return true; }
        const int j = (k - 10) + 22 * i; if (i > 1 || j >= 40) return false;
        u.pm = 39 - (5 * x + j % 5); u.pn = j / 5; return true;
    }
};
struct QOrder : pg8::StaticOrder {
    int cpm;
    __device__ __forceinline__ bool next(int i, pg8::Unit& u) const {
        if (cpm < 0) { if (!pg8::StaticOrder::next(i, u)) return false; u.pm = nM - 1 - u.pm; return true; }
        if (i >= nN * CHAIN_QREP) return false; u.pm = cpm; u.pn = i % nN; return true;
    }
};

struct KvOrder : pg8::StaticOrder {
    static constexpr bool SPLITK = true, HANDOFF = false;
    int cpm, cn0, cn1;
    __device__ __forceinline__ bool next(int i, pg8::Unit& u) const {
        u.k0 = 0; u.nkt = 2; u.role = 0; u.slab = -1; u.src2 = -1;
        if (cpm >= 0) { if (i >= (cn1 - cn0) * CHAIN_KVREP) return false; u.pm = cpm; u.pn = cn0 + i % (cn1 - cn0); return true; }
        if (G != 256) return pg8::StaticOrder::next(i, u);
        if (c < 120 || i > 1) return false;
        const int L = i * 136 + (c - 120); if (L >= nwg) return false;
        map(L, u); return true;
    }
};

struct PanelOrder : pg8::StaticOrder {
    __device__ __forceinline__ bool next(int i, pg8::Unit& u) const {
        if (G != 256 || nwg != 160) return pg8::StaticOrder::next(i, u);
        if (i > 0 || c >= 160) return false;
        const int x = c & 7, t = c >> 3; u.pm = 5 * x + t % 5; u.pn = t / 5; return true;
    }
};

#ifndef FO_NMAIN
#define FO_NMAIN 32
#endif
template <int NMAIN, int NTOT>
struct SplitOrder : pg8::StaticOrder {
    static constexpr bool SPLITK = true, HANDOFF = true;
    float* slab; unsigned* flags; unsigned epoch;
    __device__ __forceinline__ bool next(int i, pg8::Unit& u) const {
        u.src2 = -1;
        if (G != 256) { if (!pg8::StaticOrder::next(i, u)) return false; u.k0 = 0; u.nkt = NTOT; u.role = 0; u.slab = -1; return true; }
        if (c < 160) { if (i > 0) return false; pmap(c, u); u.k0 = 0; u.nkt = NMAIN; u.role = 1; u.slab = c; return true; }
        const int L = (i == 0) ? c - 160 : c - 64; if (i > 1 || L >= 160) return false;
        pmap(L, u); u.k0 = NMAIN; u.nkt = NTOT - NMAIN; u.role = 2; u.slab = L; return true;
    }
    __device__ __forceinline__ void pmap(int L, pg8::Unit& u) const { const int x = L & 7, t = L >> 3; u.pm = 5 * x + t % 5; u.pn = t / 5;
    }
};

template <int P, bool REV>
struct StreamKOrder : pg8::StaticOrder {
    static constexpr bool SPLITK = true, HANDOFF = true;
    float* slab; unsigned* flags; unsigned epoch;
    __device__ __forceinline__ bool next(int i, pg8::Unit& u) const {
        if (G != 256 || (nwg & 7)) { if (!pg8::StaticOrder::next(i, u)) return false; if (REV) u.pm = nM - 1 - u.pm; u.k0 = 0; u.nkt = 2 * P; u.role = 0; u.slab = -1; u.src2 = -1; return true; }
        const int x = c & 7, k = c >> 3, TX = nwg >> 3, R = TX * P;
        const int s = (k * R) >> 5, e = ((k + 1) * R) >> 5;
        const int ta = s / P, oa = s - ta * P, tb = (e - 1) / P, ob = e - tb * P, nseg = tb - ta + 1;
        if (i >= nseg) return false;
        const bool dl = ob < P;
        const int j = dl ? (i == 0 ? nseg - 1 : i - 1) : i;
        const int t = ta + j, lo = (j == 0) ? oa : 0, hi = (j == nseg - 1) ? ob : P;
        map2(x * TX + t, u); if (REV) u.pm = nM - 1 - u.pm;
        u.k0 = 2 * lo; u.nkt = 2 * (hi - lo); u.slab = -1; u.src2 = -1;
        if (hi < P) { u.role = 2; u.slab = c; }
        else if (lo == 0) u.role = 0;
        else { u.role = 1; u.slab = c - 8; const int sp = ((k - 1) * R) >> 5; if (sp > t * P) u.src2 = c - 16; }
        return true;
    }
};

struct Frame {
    LAS unsigned char* lds;
    volatile LAS unsigned* MISC;
    gu32* ctl;
    int tid, lane, wave, G, bx;
};

__device__ __forceinline__ int fresh_tid(int wave) { int lane; asm volatile("v_mbcnt_lo_u32_b32 %0, -1, 0\n\tv_mbcnt_hi_u32_b32 %0, -1, %0" : "=v"(lane)); return (wave << 6) | lane; }
__device__ __forceinline__ void frame_refresh(Frame& F) { const int t = fresh_tid(F.wave); F.tid = t; F.lane = t & 63; }
__device__ __forceinline__ float wave_sum(float v) {
    v += shx<1>(v); v += shx<2>(v); v += shx<4>(v); v += shx<8>(v); v = sum16(v); v = sum32(v);
    return v;
}

__device__ __forceinline__ void transpose_item(const float* W, int Nsrc, int Ksrc, bf16* WT, int Kdst, int k0, int n0dst, int sc0, float scale, LAS float* scr, int lane) {
    const bool zero = (sc0 < 0) || (k0 >= Ksrc);
    if (!zero) {
        float tv[32];
#pragma unroll
        for (int i = 0; i < 32; ++i) tv[i] = __builtin_nontemporal_load(&W[(size_t)(k0 + 2 * i + (lane >> 5)) * Nsrc + sc0 + (lane & 31)]);
#pragma unroll
        for (int i = 0; i < 32; ++i) scr[(2 * i + (lane >> 5)) * 33 + (lane & 31)] = tv[i] * scale;
    }
    LDS_WAIT(); asm volatile("" ::: "memory");
    const int c = lane & 7;
#pragma unroll
    for (int j = 0; j < 4; ++j) { const int n = (lane >> 3) + 8 * j; const LAS float* s = scr + (8 * c) * 33 + n;
        v4u o; if (zero) { o = (v4u){0u, 0u, 0u, 0u}; } else { o.x = cvtpk(s[0 * 33], s[1 * 33]); o.y = cvtpk(s[2 * 33], s[3 * 33]); o.z = cvtpk(s[4 * 33], s[5 * 33]); o.w = cvtpk(s[6 * 33], s[7 * 33]); }
        *(GAS v4u*)(WT + (size_t)(n0dst + n) * Kdst + k0 + 8 * c) = o; }
    LDS_WAIT(); asm volatile("" ::: "memory");
}
__device__ __forceinline__ int map_win(int nb) { return nb < 77 ? nb * 32 : -1; }
__device__ __forceinline__ int map_wqb(int nb) { const int c = nb * 32; if (c < 512) { const int pn = c >> 8, bj = (c >> 7) & 1, wc = (c >> 5) & 3; return (4 * pn + wc) * 96 + 32 * bj; } const int cc = c - 512, bj = cc >> 7, wc = (cc >> 5) & 3; return (4 * bj + wc) * 96 + 64; }
__device__ __forceinline__ int map_wkvb(int nb) { const int c = nb * 32, pn = c >> 8, bj = (c >> 7) & 1, wc = (c >> 5) & 3; return pn < 2 ? (4 * pn + wc) * 128 + 32 * bj : (4 * (pn - 2) + wc) * 128 + 64 + 32 * bj; }
__device__ __forceinline__ int map_wfi(int nb) { const int c = nb * 32, pn = c >> 8, bj = (c >> 7) & 1, j = c & 127; return bj * D_FFN + 128 * pn + j; }

__device__ __forceinline__ void p0_prologue(Frame& F, const Params& P) {
    unsigned char* ws = P.ws;
    if (F.bx < 192) {
        const int l = F.bx / 96, n0 = (F.bx % 96) * 64;
        LAS float* sil = (LAS float*)(F.lds);
        LAS float* red = (LAS float*)(F.lds + 12288);
        for (int i = F.tid; i < 3072; i += 512) { const int cd = i >> 10, k = i & 1023; const float x = (cd == 0) ? P.in[7][k] : P.in[6][(cd - 1) * 1024 + k]; sil[i] = siluf(x); }
        __syncthreads();
        const float* W = P.in[8] + (size_t)l * 1024 * 6144 + n0 + F.lane;
        float a0 = 0.f, a1 = 0.f, a2 = 0.f;
        const int kb = F.wave * 128;
#pragma unroll 16
        for (int k = 0; k < 128; ++k) { const float w = __builtin_nontemporal_load(&W[(size_t)(kb + k) * 6144]); a0 += sil[kb + k] * w; a1 += sil[1024 + kb + k] * w; a2 += sil[2048 + kb + k] * w; }
        red[(F.wave * 3 + 0) * 64 + F.lane] = a0; red[(F.wave * 3 + 1) * 64 + F.lane] = a1; red[(F.wave * 3 + 2) * 64 + F.lane] = a2;
        __syncthreads();
        if (F.tid < 192) { const int cd = F.tid >> 6, cl = F.tid & 63; float s = P.in[9][l * 6144 + n0 + cl];
#pragma unroll
            for (int w = 0; w < 8; ++w) s += red[(w * 3 + cd) * 64 + cl];
            ((float*)(ws + WS_MOD))[(l * 3 + cd) * 6144 + n0 + cl] = s; }
        __syncthreads();
    }
    if (F.bx == F.G - 1) {
        if (F.tid < 32) { const int l_ = F.tid >> 4, d_ = (F.tid >> 3) & 1, h_ = F.tid & 7; const float p_ = (d_ ? P.in[22] : P.in[21])[l_ * 8 + h_];
            ((float*)(ws + WS_TAB + 16384))[F.tid] = log1pf(-exp2f(-p_)) * 1.4426950408889634f; }
        float2* t64 = (float2*)(ws + WS_TAB); float2* t32 = t64 + 64 * 16;
        for (int i = F.tid; i < 64 * 16; i += 512) { const int pos = i >> 4, j = i & 15; const float inv = powf(10000.0f, -(float)j / 16.0f); const float ang = (float)pos * inv; float s, c; sincosf(ang, &s, &c); t64[i] = make_float2(c, s); }
        for (int i = F.tid; i < 64 * 8; i += 512) { const int pos = i >> 3, j = i & 7; const float inv = powf(10000.0f, -(float)j / 8.0f); const float ang = (float)pos * inv; float s, c; sincosf(ang, &s, &c); t32[i] = make_float2(c, s); }
    }
    {
        LAS float* scr = (LAS float*)(F.lds + RING_OFF + F.wave * 16384);
        const int gw = F.bx * NWAVES + F.wave, NGW = F.G * NWAVES;
        constexpr int I_IN = 16 * 80, I_QB = 4 * 24, I_KVB = 4 * 32, I_O = 16 * 32, I_FI = 16 * 176, I_FO = 44 * 32, I_L = I_IN + I_QB + I_KVB + I_O + I_FI + I_FO;
        for (int it = gw; it < 2 * I_L; it += NGW) {
            const int l = it / I_L; int r = it % I_L;
            unsigned char* wl = ws + WS_W + (size_t)l * LAYER_W;
            if (r < I_IN) { const int kb = r / 80, nb = r % 80; const int sc = map_win(nb); transpose_item(P.in[12] + (size_t)l * 1024 * 2464, 2464, 1024, (bf16*)(wl + W_IN_OFF), 1024, 64 * kb, 32 * nb, sc, (nb >= 16 && nb < 32) ? 0.125f : 1.0f, scr, F.lane); continue; } r -= I_IN;
            if (r < I_QB) { const int kb = r / 24, nb = r % 24; transpose_item(P.in[14] + (size_t)l * 256 * 768, 768, 256, (bf16*)(wl + W_QB_OFF), 256, 64 * kb, 32 * nb, map_wqb(nb), 1.0f, scr, F.lane); continue; } r -= I_QB;
            if (r < I_KVB) { const int kb = r / 32, nb = r % 32; transpose_item(P.in[16] + (size_t)l * 128 * 1024, 1024, 128, (bf16*)(wl + W_KVB_OFF), 256, 64 * kb, 32 * nb, map_wkvb(nb), 1.0f, scr, F.lane); continue; } r -= I_KVB;
            if (r < I_O) { const int kb = r / 32, nb = r % 32; transpose_item(P.in[25] + (size_t)l * 1024 * 1024, 1024, 1024, (bf16*)(wl + W_O_OFF), 1024, 64 * kb, 32 * nb, 32 * nb, 1.0f, scr, F.lane); continue; } r -= I_O;
            if (r < I_FI) { const int kb = r / 176, nb = r % 176; transpose_item(P.in[26] + (size_t)l * 1024 * N_FI, N_FI, 1024, (bf16*)(wl + W_FI_OFF), 1024, 64 * kb, 32 * nb, map_wfi(nb), 1.0f, scr, F.lane); continue; } r -= I_FI;
            { const int kb = r / 32, nb = r % 32; transpose_item(P.in[27] + (size_t)l * D_FFN * 1024, 1024, D_FFN, (bf16*)(wl + W_FO_OFF), D_FFN, 64 * kb, 32 * nb, 32 * nb, 1.0f, scr, F.lane); }
        }
    }
}

__device__ __forceinline__ void norm_phase(Frame& F, const Params& P, int layer, int which) {
    unsigned char* ws = P.ws;
    const int gw = F.bx * NWAVES + F.wave, NGW = F.G * NWAVES;
    const float* g = P.in[which == 0 ? 10 : 11] + layer * 1024;
    const float* mod = (const float*)(ws + WS_MOD) + (size_t)layer * 3 * 6144;
    bf16* H = (bf16*)(ws + WS_H);
    for (int m = gw; m < M_TOK; m += NGW) {
        const float* xrow;
        if (which == 0 && layer == 0) xrow = (m < M_CTX) ? P.in[0] + (size_t)m * 1024 : P.in[1] + (size_t)(m - M_CTX) * 1024;
        else xrow = P.out + (size_t)m * 1024;
        const int cond = (m < M_CTX) ? 0 : 1 + ((m - M_CTX) >> 10);
        const float* sh = mod + cond * 6144 + (which == 0 ? 0 : 3) * 1024;
        const float* sc = sh + 1024;
        const GAS f32x4* xr = (const GAS f32x4*)xrow + F.lane;
        f32x4 v[4]; float s = 0.f;
#pragma unroll
        for (int j = 0; j < 4; ++j) { v[j] = __builtin_nontemporal_load(xr + 64 * j); s += (v[j].x * v[j].x + v[j].y * v[j].y) + (v[j].z * v[j].z + v[j].w * v[j].w); }
        const float rstd = __builtin_amdgcn_rsqf(wave_sum(s) * (1.0f / 1024.0f) + EPSF);
        GAS unsigned long long* o8 = (GAS unsigned long long*)(H + (size_t)m * 1024) + F.lane;
#pragma unroll
        for (int j = 0; j < 4; ++j) {
            const f32x4 gg = *((const f32x4*)g + F.lane + 64 * j), s1 = *((const f32x4*)sc + F.lane + 64 * j), h1 = *((const f32x4*)sh + F.lane + 64 * j);
            const f32x4 y = v[j] * rstd * gg * (s1 + 1.0f) + h1;
            o8[64 * j] = (unsigned long long)cvtpk(y.x, y.y) | ((unsigned long long)cvtpk(y.z, y.w) << 32);
        }
    }
}
__device__ __forceinline__ void cache_rows_job(Frame& F, const Params& P, int layer) {
    unsigned char* ws = P.ws;
    const int gw = F.bx * NWAVES + F.wave, NGW = F.G * NWAVES;
    bf16* KVA = (bf16*)(ws + WS_KVA); bf16* KR = (bf16*)(ws + WS_KR);
    for (int cr = gw; cr < M_KV - M_TOK; cr += NGW) {
        const int m = M_TOK + cr, b = cr >> 8, n = cr & 255;
        const float* ck = P.in[2] + ((size_t)(b * 2 + layer) * 256 + n) * 128;
        const float* kr = P.in[3] + ((size_t)(b * 2 + layer) * 256 + n) * 32;
        const f32x2_t a = *((const f32x2_t*)ck + F.lane);
        *((unsigned*)(KVA + (size_t)m * 256) + F.lane) = cvtpk(a.x, a.y);
        if (F.lane < 16) { const f32x2_t k2 = *((const f32x2_t*)kr + F.lane); *((unsigned*)(KR + (size_t)m * 32) + F.lane) = cvtpk(k2.x, k2.y); }
    }
}
__device__ __forceinline__ void bias_job(Frame& F, const Params& P, int gw, int NGW) {
    unsigned char* ws = P.ws;
    for (int it = gw; it < 2 * (BIAS_LD / 8); it += NGW) {
        const int l = it / (BIAS_LD / 8), cc0 = (it % (BIAS_LD / 8)) * 8;
        const bf16* wrow = (cc0 < 2560) ? (const bf16*)(ws + WS_W + (size_t)l * LAYER_W + W_IN_OFF) + (size_t)cc0 * 1024 : (const bf16*)(ws + WS_W + (size_t)l * LAYER_W + W_FI_OFF) + (size_t)(cc0 - 2560) * 1024;
        const float* shb = (const float*)(ws + WS_MOD) + (size_t)l * 3 * 6144 + (cc0 < 2560 ? 0 : 3) * 1024 + F.lane * 16;
        f32x4 sh[3][4];
#pragma unroll
        for (int cd = 0; cd < 3; ++cd)
#pragma unroll
            for (int q = 0; q < 4; ++q) sh[cd][q] = *(const f32x4*)(shb + cd * 6144 + 4 * q);
        float res[3] = {0.f, 0.f, 0.f};
#pragma unroll
        for (int jb = 0; jb < 2; ++jb) {
        v4u wv[4][2];
#pragma unroll
        for (int j = 0; j < 4; ++j) { wv[j][0] = *(const v4u*)(wrow + (size_t)(4 * jb + j) * 1024 + F.lane * 16); wv[j][1] = *(const v4u*)(wrow + (size_t)(4 * jb + j) * 1024 + F.lane * 16 + 8); }
#pragma unroll
        for (int j = 0; j < 4; ++j) {
            float wf[16];
#pragma unroll
            for (int h = 0; h < 2; ++h) { const v4u x = wv[j][h];
                wf[8 * h + 0] = b2f((unsigned short)(x.x & 0xffffu)); wf[8 * h + 1] = b2f((unsigned short)(x.x >> 16)); wf[8 * h + 2] = b2f((unsigned short)(x.y & 0xffffu)); wf[8 * h + 3] = b2f((unsigned short)(x.y >> 16));
                wf[8 * h + 4] = b2f((unsigned short)(x.z & 0xffffu)); wf[8 * h + 5] = b2f((unsigned short)(x.z >> 16)); wf[8 * h + 6] = b2f((unsigned short)(x.w & 0xffffu)); wf[8 * h + 7] = b2f((unsigned short)(x.w >> 16)); }
#pragma unroll
            for (int cd = 0; cd < 3; ++cd) { float a = 0.f;
#pragma unroll
                for (int e = 0; e < 16; ++e) a += wf[e] * sh[cd][e >> 2][e & 3];
                a = wave_sum(a);
                res[cd] = (F.lane == 4 * jb + j) ? a : res[cd]; }
        }
        }
        if (F.lane < 8) { float* bo = (float*)(ws + WS_BIAS) + (size_t)l * 3 * BIAS_LD + cc0 + F.lane; bo[0] = res[0]; bo[BIAS_LD] = res[1]; bo[2 * BIAS_LD] = res[2]; }
    }
}

struct MixP {
    const bf16 *Q, *KN, *KR, *VT, *RQ, *RK, *RKT, *RVT, *RG;
    bf16* MIX;
    const float *s_f0, *s_b0;
    const float *p_f, *p_b;
    const float *g_gn, *b_gn;
    float *out_sf, *out_sb;
    int layer;
    const float* lgtab;
    int defer_states;
};
constexpr int MIX_KBYTES = 128 * 208, MIX_VSTR = 264, MIX_VBYTES = 64 * MIX_VSTR, MIX_BUF = MIX_KBYTES + MIX_VBYTES;

#ifndef MIX_DEFER
#define MIX_DEFER 1
#endif
__device__ __forceinline__ int mix_code(int v, int G, bool att, int i) {
    if (G == 256 && MIX_DEFER) {
        if (att) { if (v < 64) return i == 0 ? v : (i == 1 ? 384 + v : -1); return i == 0 ? 384 + v : -1; }
        if (v < 64) return -1;
        if (v < 128) return i == 0 ? v : -1;
        return i < 2 ? 128 + 2 * (v - 128) + i : -1;
    }
    if (G == 256) {
        if (att) { if (v < 64) return i == 0 ? v : (i <= 2 ? 384 + 2 * v + (i - 1) : -1); if (v < 128) return i < 2 ? 384 + 2 * v + i : -1; return -1; }
        if (v < 64) return -1;
        if (v < 128) return i == 0 ? v : -1;
        return i < 2 ? 128 + 2 * (v - 128) + i : -1;
    }
    if (att) { const int j = v + i * G; return j < 64 ? j : (j < 320 ? 384 + (j - 64) : -1); }
    const int j = v + i * G; return j < 320 ? 64 + j : -1;
}

template <bool ATT>
__device__ __forceinline__ void mix_run(const MixP& P, LAS unsigned char* lds, int v, int G, int tid) {
    constexpr int DK = ATT ? 96 : 64, NKS = DK / 16, KSTR = DK * 2 + 16, KCH = DK / 8, NKL = ATT ? 3 : 2;
    int code = mix_code(v, G, ATT, 0);
    if (code < 0) return;
    asm volatile("" : "+v"(tid));
    const int lane = tid & 63, w = __builtin_amdgcn_readfirstlane(tid >> 6), c = lane & 31, hh = lane >> 5;
    int krow[NKL], kch[NKL];
#pragma unroll
    for (int i = 0; i < NKL; ++i) { const int cid = tid + 512 * i; krow[i] = ATT ? cid / KCH : cid >> 3; kch[i] = ATT ? cid % KCH : cid & 7; }
    const int vrow0 = tid >> 4, vch = tid & 15;
    v4u rk0[NKL], rk1[NKL], rv0[2], rv1[2];
    pg8::bf16x8 qf[NKS];
    LAS unsigned char* const kb0 = lds, * const vb0 = lds + MIX_KBYTES, * const kb1 = lds + MIX_BUF, * const vb1 = lds + MIX_BUF + MIX_KBYTES;
#define MIX_DECODE(code_, lat_, b_, h_, qb_) const bool lat_ = (code_) < 128; const int uu_##b_ = lat_ ? ((code_) & 63) : (((code_) - 128) & 255); \
        const int b_ = lat_ ? (uu_##b_ >> 5) : (uu_##b_ >> 3), h_ = lat_ ? ((uu_##b_ >> 2) & 7) : (uu_##b_ & 7), qb_ = lat_ ? (uu_##b_ & 3) : 0
#define MIX_KROW(lat_, b_, ci) ((lat_) ? (((ci) < 8) ? M_CTX + (b_) * 1024 + 128 * (ci) : M_TOK + (b_) * 256 + 128 * ((ci) - 8)) : (b_) * 256 + 128 * (ci))
#define MIX_LDNT(p) __builtin_nontemporal_load((const v4u*)(p))
#define MIX_ISSUE(SK_, SV_, lat_, b_, h_, ci) do { const int kr_ = MIX_KROW(lat_, b_, ci); \
        _Pragma("unroll") for (int i_ = 0; i_ < NKL; ++i_) { \
            if (ATT) SK_[i_] = (kch[i_] < 8) ? MIX_LDNT(P.KN + (size_t)(kr_ + krow[i_]) * 512 + (h_) * 64 + kch[i_] * 8) : MIX_LDNT(P.KR + (size_t)(kr_ + krow[i_]) * 32 + (kch[i_] - 8) * 8); \
            else SK_[i_] = MIX_LDNT(P.RK + (size_t)(kr_ + krow[i_]) * 512 + (h_) * 64 + kch[i_] * 8); } \
        _Pragma("unroll") for (int i_ = 0; i_ < 2; ++i_) { \
            if (ATT) SV_[i_] = MIX_LDNT(P.VT + (size_t)((h_) * 64 + vrow0 + 32 * i_) * M_KV + kr_ + vch * 8); \
            else SV_[i_] = MIX_LDNT(P.RVT + (size_t)((h_) * 64 + vrow0 + 32 * i_) * M_TOK + kr_ + vch * 8); } } while (0)
#define MIX_STORE(SK_, SV_, kb_, vb_) do { \
        _Pragma("unroll") for (int i_ = 0; i_ < NKL; ++i_) *(LAS v4u*)((kb_) + krow[i_] * KSTR + kch[i_] * 16) = SK_[i_]; \
        _Pragma("unroll") for (int i_ = 0; i_ < 2; ++i_) { LAS unsigned char* p_ = (vb_) + (vrow0 + 32 * i_) * MIX_VSTR + vch * 16; \
            *(LAS u32x2*)p_ = (u32x2){SV_[i_].x, SV_[i_].y}; *(LAS u32x2*)(p_ + 8) = (u32x2){SV_[i_].z, SV_[i_].w}; } } while (0)
#define MIX_LOADQ(QF_, lat_, b_, h_, qb_) do { const int qr_ = ((lat_) ? M_CTX + (b_) * 1024 : (b_) * 256) + (qb_) * 256 + w * 32 + c; \
        const bf16* qp_ = ATT ? P.Q + (size_t)qr_ * 768 + (h_) * 96 : P.RQ + (size_t)qr_ * 512 + (h_) * 64; \
        _Pragma("unroll") for (int ks_ = 0; ks_ < NKS; ++ks_) QF_[ks_] = *(const pg8::bf16x8*)(qp_ + 16 * ks_ + 8 * hh); } while (0)
#define MIX_DECAY(SX_, kblk_, kb0_) do { \
        if ((kblk_) == qblk) { \
            _Pragma("unroll") for (int r = 0; r < 16; ++r) { const float d_ = (float)(qpos - ((kb0_) + (r & 3) + 8 * (r >> 2))); \
                const float e_ = d_ > 0.f ? d_ * lgf2 : -d_ * lgb2; float w_ = __builtin_amdgcn_exp2f(e_); w_ = (d_ == 0.f) ? 2.0f : w_; SX_[r] *= w_; } \
        } else { const bool fw_ = (kblk_) < qblk; const float lg_ = fw_ ? lgf2 : -lgb2; const float eq_ = __builtin_amdgcn_exp2f((float)(qpos - (kb0_)) * lg_); \
              \
            const float c0_ = eq_, c1_ = eq_ * (fw_ ? tf8[0] : tb8[0]), c2_ = eq_ * (fw_ ? tf8[1] : tb8[1]), c3_ = eq_ * (fw_ ? tf8[2] : tb8[2]); \
            const float u1_ = fw_ ? tf1[0] : tb1[0], u2_ = fw_ ? tf1[1] : tb1[1], u3_ = fw_ ? tf1[2] : tb1[2]; \
            SX_[0] *= c0_; SX_[1] *= c0_ * u1_; SX_[2] *= c0_ * u2_; SX_[3] *= c0_ * u3_; \
            SX_[4] *= c1_; SX_[5] *= c1_ * u1_; SX_[6] *= c1_ * u2_; SX_[7] *= c1_ * u3_; \
            SX_[8] *= c2_; SX_[9] *= c2_ * u1_; SX_[10] *= c2_ * u2_; SX_[11] *= c2_ * u3_; \
            SX_[12] *= c3_; SX_[13] *= c3_ * u1_; SX_[14] *= c3_ * u2_; SX_[15] *= c3_ * u3_; } } while (0)
#define MIX_QK(SA_, SB_, kt_) do { \
        _Pragma("unroll") \
        for (int ks = 0; ks < NKS; ++ks) { \
            const pg8::bf16x8 a0 = *(const LAS pg8::bf16x8*)((kt_) + c * KSTR + (16 * ks + 8 * hh) * 2); \
            const pg8::bf16x8 a1 = *(const LAS pg8::bf16x8*)((kt_) + (32 + c) * KSTR + (16 * ks + 8 * hh) * 2); \
            SA_ = __builtin_amdgcn_mfma_f32_32x32x16_bf16(a0, qf[ks], SA_, 0, 0, 0); \
            SB_ = __builtin_amdgcn_mfma_f32_32x32x16_bf16(a1, qf[ks], SB_, 0, 0, 0); \
        } } while (0)
#define MIX_EW(SA_, SB_, ci, sub, STATE_) do { \
        if (ATT) { \
            _Pragma("unroll") \
            for (int r = 0; r < 16; ++r) { SA_[r] = __builtin_amdgcn_exp2f(SA_[r]); SB_[r] = __builtin_amdgcn_exp2f(SB_[r]); lsum += SA_[r] + SB_[r]; } \
        } else if (!(STATE_)) { \
            const int kblk0_ = 4 * (ci) + 2 * (sub), kpos0_ = 128 * (ci) + 64 * (sub) + 4 * hh; \
            MIX_DECAY(SA_, kblk0_, kpos0_); MIX_DECAY(SB_, kblk0_ + 1, kpos0_ + 32); \
        } else { \
            const float wq = ((sub) == 0) ? __builtin_amdgcn_exp2f((float)(qpos + 1) * lgf2) : __builtin_amdgcn_exp2f((float)(1024 - qpos) * lgb2); \
            _Pragma("unroll") \
            for (int r = 0; r < 16; ++r) { SA_[r] *= wq; SB_[r] *= wq; } \
        } } while (0)
#define MIX_PV(SA_, SB_, vb, sub) do { \
        pg8::bf16x8 pf[2][2]; \
        { v4u t0, t1, t2, t3; \
          t0 = (v4u){cvtpk(SA_[0], SA_[1]), cvtpk(SA_[2], SA_[3]), cvtpk(SA_[4], SA_[5]), cvtpk(SA_[6], SA_[7])}; \
          t1 = (v4u){cvtpk(SA_[8], SA_[9]), cvtpk(SA_[10], SA_[11]), cvtpk(SA_[12], SA_[13]), cvtpk(SA_[14], SA_[15])}; \
          t2 = (v4u){cvtpk(SB_[0], SB_[1]), cvtpk(SB_[2], SB_[3]), cvtpk(SB_[4], SB_[5]), cvtpk(SB_[6], SB_[7])}; \
          t3 = (v4u){cvtpk(SB_[8], SB_[9]), cvtpk(SB_[10], SB_[11]), cvtpk(SB_[12], SB_[13]), cvtpk(SB_[14], SB_[15])}; \
          pf[0][0] = __builtin_bit_cast(pg8::bf16x8, t0); pf[0][1] = __builtin_bit_cast(pg8::bf16x8, t1); pf[1][0] = __builtin_bit_cast(pg8::bf16x8, t2); pf[1][1] = __builtin_bit_cast(pg8::bf16x8, t3); } \
        _Pragma("unroll") \
        for (int kt = 0; kt < 2; ++kt) \
            _Pragma("unroll") \
            for (int s = 0; s < 2; ++s) { \
                const int koff = (64 * (sub) + 32 * kt + 16 * s + 4 * hh) * 2; \
                const u32x2 l0 = *(const LAS u32x2*)((vb) + c * MIX_VSTR + koff), h0 = *(const LAS u32x2*)((vb) + c * MIX_VSTR + koff + 16); \
                const u32x2 l1 = *(const LAS u32x2*)((vb) + (32 + c) * MIX_VSTR + koff), h1 = *(const LAS u32x2*)((vb) + (32 + c) * MIX_VSTR + koff + 16); \
                const pg8::bf16x8 vf0 = __builtin_bit_cast(pg8::bf16x8, (v4u){l0.x, l0.y, h0.x, h0.y}); \
                const pg8::bf16x8 vf1 = __builtin_bit_cast(pg8::bf16x8, (v4u){l1.x, l1.y, h1.x, h1.y}); \
                o0 = __builtin_amdgcn_mfma_f32_32x32x16_bf16(vf0, pf[kt][s], o0, 0, 0, 0); \
                o1 = __builtin_amdgcn_mfma_f32_32x32x16_bf16(vf1, pf[kt][s], o1, 0, 0, 0); \
            } } while (0)
#define MIX_COMPUTE(kb, vb, ci, STATE_) do { \
        f32x16 sa0 = {}, sb0 = {}, sa1 = {}, sb1 = {}; \
        MIX_QK(sa0, sb0, (kb)); \
        MIX_QK(sa1, sb1, (kb) + 64 * KSTR); \
        MIX_EW(sa0, sb0, ci, 0, STATE_); \
        MIX_PV(sa0, sb0, vb, 0); \
        MIX_EW(sa1, sb1, ci, 1, STATE_); \
        MIX_PV(sa1, sb1, vb, 1); \
        } while (0)
    {
        MIX_DECODE(code, lat0, b0, h0, qb0);
        MIX_LOADQ(qf, lat0, b0, h0, qb0);
        MIX_ISSUE(rk0, rv0, lat0, b0, h0, 0);
        MIX_ISSUE(rk1, rv1, lat0, b0, h0, 1);
    }
    for (int ui = 0; code >= 0; ++ui) {
        const int ncode = mix_code(v, G, ATT, ui + 1);
        const int pcode = ncode >= 0 ? ncode : code;
        MIX_DECODE(code, lat, b, h, qb);
        MIX_DECODE(pcode, nlat, nb, nh, nqb);
        const int nld = lat ? (ATT ? 10 : 8) : 2;
        const int qpos = qb * 256 + w * 32 + c;
        const int qblk = qb * 8 + w;
        const int qrow = (lat ? M_CTX + b * 1024 : b * 256) + qpos;
        float lgf2 = 0.f, lgb2 = 0.f;
        float tf1[3] = {1.f, 1.f, 1.f}, tf8[3] = {1.f, 1.f, 1.f}, tb1[3] = {1.f, 1.f, 1.f}, tb8[3] = {1.f, 1.f, 1.f};
        if (!ATT) { lgf2 = P.lgtab[h]; lgb2 = P.lgtab[8 + h];
#pragma unroll
            for (int i = 0; i < 3; ++i) { tf1[i] = __builtin_amdgcn_exp2f(-(float)(i + 1) * lgf2); tf8[i] = __builtin_amdgcn_exp2f(-(float)(8 * (i + 1)) * lgf2);
                                          tb1[i] = __builtin_amdgcn_exp2f((float)(i + 1) * lgb2); tb8[i] = __builtin_amdgcn_exp2f((float)(8 * (i + 1)) * lgb2); } }

        f32x16 o0 = {}, o1 = {};
        float lsum = 0.f;
        for (int c2 = 0; c2 < nld; c2 += 2) {
            const bool lastp = (c2 + 2 >= nld);
            const bool ilat = lastp ? nlat : lat; const int ib = lastp ? nb : b, ih = lastp ? nh : h, ic = lastp ? 0 : c2 + 2;
            MIX_STORE(rk0, rv0, kb0, vb0);
            __syncthreads();
            MIX_ISSUE(rk0, rv0, ilat, ib, ih, ic);
            MIX_COMPUTE(kb0, vb0, c2, 0);
            MIX_STORE(rk1, rv1, kb1, vb1);
            __syncthreads();
            MIX_ISSUE(rk1, rv1, ilat, ib, ih, ic + 1);
            MIX_COMPUTE(kb1, vb1, c2 + 1, 0);
        }
        if (!ATT && lat) {
#pragma unroll
            for (int i = 0; i < NKL; ++i) { unsigned wd[4];
#pragma unroll
                for (int q = 0; q < 4; ++q) { const int d0 = kch[i] * 8 + 2 * q, rr = krow[i] & 63; wd[q] = (d0 == rr ? 0x3F80u : 0u) | (d0 + 1 == rr ? 0x3F800000u : 0u); }
                *(LAS v4u*)(kb0 + krow[i] * KSTR + kch[i] * 16) = (v4u){wd[0], wd[1], wd[2], wd[3]}; }
            const float* Sf = P.s_f0 + ((size_t)(b * 2 + P.layer) * 8 + h) * 4096; const float* Sb = P.s_b0 + ((size_t)(b * 2 + P.layer) * 8 + h) * 4096;
#pragma unroll
            for (int i = 0; i < 8; ++i) { const int e = tid + 512 * i, dk = e >> 6, dv = e & 63;
                *(LAS bf16*)(vb0 + dv * MIX_VSTR + dk * 2) = f2b(Sf[e]); *(LAS bf16*)(vb0 + dv * MIX_VSTR + (64 + dk) * 2) = f2b(Sb[e]); }
            __syncthreads();
            MIX_COMPUTE(kb0, vb0, 0, 1);
            __syncthreads();
        }
        MIX_LOADQ(qf, nlat, nb, nh, nqb);
        int lane_e = lane; asm volatile("" : "+v"(lane_e));
        const int c_e = lane_e & 31, hh_e = lane_e >> 5; const int qrow_e = (lat ? M_CTX + b * 1024 : b * 256) + qb * 256 + w * 32 + c_e;
        if (ATT) {
            lsum = sum32(lsum);
            const float inv = __builtin_amdgcn_rcpf(lsum);
            bf16* op = P.MIX + (size_t)qrow_e * 1024 + 512 + h * 64 + 8 * hh_e;
#pragma unroll
            for (int dvt = 0; dvt < 2; ++dvt)
#pragma unroll
                for (int g = 0; g < 4; g += 2) {
                    unsigned ax, ay, bx, by;
                    if (dvt == 0) { ax = cvtpk(o0[4 * g] * inv, o0[4 * g + 1] * inv); ay = cvtpk(o0[4 * g + 2] * inv, o0[4 * g + 3] * inv); bx = cvtpk(o0[4 * g + 4] * inv, o0[4 * g + 5] * inv); by = cvtpk(o0[4 * g + 6] * inv, o0[4 * g + 7] * inv); }
                    else          { ax = cvtpk(o1[4 * g] * inv, o1[4 * g + 1] * inv); ay = cvtpk(o1[4 * g + 2] * inv, o1[4 * g + 3] * inv); bx = cvtpk(o1[4 * g + 4] * inv, o1[4 * g + 5] * inv); by = cvtpk(o1[4 * g + 6] * inv, o1[4 * g + 7] * inv); }
                    { auto r_ = __builtin_amdgcn_permlane32_swap(ax, bx, false, false); ax = r_[0]; bx = r_[1]; }
                    { auto r_ = __builtin_amdgcn_permlane32_swap(ay, by, false, false); ay = r_[0]; by = r_[1]; }
                    *(v4u*)(op + 32 * dvt + 8 * g) = (v4u){ax, ay, bx, by};
                }
        } else {
            float sum = 0.f;
#pragma unroll
            for (int r = 0; r < 16; ++r) sum += o0[r] + o1[r];
            sum = sum32(sum);
            const float mu = sum * (1.0f / 64.0f);
            float var = 0.f;
#pragma unroll
            for (int r = 0; r < 16; ++r) { const float a = o0[r] - mu, bq = o1[r] - mu; var += a * a + bq * bq; }
            var = sum32(var);
            const float rstd = 1.0f / sqrtf(var * (1.0f / 64.0f) + EPSF);
            const int cbase = h * 64 + 4 * hh_e;
            bf16* op = P.MIX + (size_t)qrow_e * 1024 + h * 64 + 8 * hh_e;
            const bf16* rgp = P.RG + (size_t)qrow_e * 512 + cbase;
#pragma unroll
            for (int dvt = 0; dvt < 2; ++dvt)
#pragma unroll
                for (int g = 0; g < 4; g += 2) {
                    unsigned pk[2][2];
#pragma unroll
                    for (int gi = 0; gi < 2; ++gi) {
                        const int cc = 32 * dvt + 8 * (g + gi);
                        const f32x4 gg = *(const f32x4*)(P.g_gn + cbase + cc), bb = *(const f32x4*)(P.b_gn + cbase + cc);
                        const u32x2 rg2 = *(const u32x2*)(rgp + cc);
                        float y[4];
#pragma unroll
                        for (int i = 0; i < 4; ++i) { const float ov = dvt ? o1[4 * (g + gi) + i] : o0[4 * (g + gi) + i]; y[i] = (ov - mu) * rstd * gg[i] + bb[i]; }
                        y[0] *= b2f((unsigned short)(rg2.x & 0xffffu)); y[1] *= b2f((unsigned short)(rg2.x >> 16)); y[2] *= b2f((unsigned short)(rg2.y & 0xffffu)); y[3] *= b2f((unsigned short)(rg2.y >> 16));
                        pk[gi][0] = cvtpk(y[0], y[1]); pk[gi][1] = cvtpk(y[2], y[3]);
                    }
                    { auto r_ = __builtin_amdgcn_permlane32_swap(pk[0][0], pk[1][0], false, false); pk[0][0] = r_[0]; pk[1][0] = r_[1]; }
                    { auto r_ = __builtin_amdgcn_permlane32_swap(pk[0][1], pk[1][1], false, false); pk[0][1] = r_[0]; pk[1][1] = r_[1]; }
                    *(v4u*)(op + 32 * dvt + 8 * g) = (v4u){pk[0][0], pk[0][1], pk[1][0], pk[1][1]};
                }
            if (!lat && !P.defer_states) {
                const int st = w >> 2, dkt = (w >> 1) & 1, dvt = w & 1;
                const float lg = st ? lgb2 : lgf2;
                float stj[8];
#pragma unroll
                for (int j = 0; j < 8; ++j) stj[j] = __builtin_amdgcn_exp2f((st ? (float)j : -(float)j) * lg);
                const bf16* kp = P.RKT + (size_t)(h * 64 + 32 * dkt + c_e) * M_CTX + b * 256 + 8 * hh_e;
                const bf16* vp = P.RVT + (size_t)(h * 64 + 32 * dvt + c_e) * M_TOK + b * 256 + 8 * hh_e;
                f32x16 acc = {};
                v4u kra[4], krb[4]; pg8::bf16x8 vra[4], vrb[4];
#define ST_LOAD(KR_, VR_, bt_) do { _Pragma("unroll") for (int i = 0; i < 4; ++i) { KR_[i] = *(const v4u*)(kp + 16 * (4 * (bt_) + i)); VR_[i] = *(const pg8::bf16x8*)(vp + 16 * (4 * (bt_) + i)); } } while (0)
#define ST_COMP(KR_, VR_, bt_) do { _Pragma("unroll") for (int i = 0; i < 4; ++i) { \
                    const int tok0 = 16 * (4 * (bt_) + i) + 8 * hh_e; float kv[8]; \
                    kv[0] = b2f((unsigned short)(KR_[i].x & 0xffffu)); kv[1] = b2f((unsigned short)(KR_[i].x >> 16)); kv[2] = b2f((unsigned short)(KR_[i].y & 0xffffu)); kv[3] = b2f((unsigned short)(KR_[i].y >> 16)); \
                    kv[4] = b2f((unsigned short)(KR_[i].z & 0xffffu)); kv[5] = b2f((unsigned short)(KR_[i].z >> 16)); kv[6] = b2f((unsigned short)(KR_[i].w & 0xffffu)); kv[7] = b2f((unsigned short)(KR_[i].w >> 16)); \
                    const float wb_ = __builtin_amdgcn_exp2f((st ? (float)tok0 : (float)(255 - tok0)) * lg); _Pragma("unroll") for (int j = 0; j < 8; ++j) kv[j] *= wb_ * stj[j]; \
                    const pg8::bf16x8 kfr = __builtin_bit_cast(pg8::bf16x8, pack8(kv)); \
                    acc = __builtin_amdgcn_mfma_f32_32x32x16_bf16(kfr, VR_[i], acc, 0, 0, 0); } } while (0)
                ST_LOAD(kra, vra, 0); ST_LOAD(krb, vrb, 1);
                ST_COMP(kra, vra, 0); ST_LOAD(kra, vra, 2);
                ST_COMP(krb, vrb, 1); ST_LOAD(krb, vrb, 3);
                ST_COMP(kra, vra, 2); ST_COMP(krb, vrb, 3);
#undef ST_LOAD
#undef ST_COMP
                float* so = (st ? P.out_sb : P.out_sf) + ((size_t)(b * 2 + P.layer) * 8 + h) * 4096 + 32 * dvt + c_e;
#pragma unroll
                for (int r = 0; r < 16; ++r) { const int dk = 32 * dkt + (r & 3) + 8 * (r >> 2) + 4 * hh_e; __builtin_nontemporal_store(acc[r], so + dk * 64); }
            }
        }
        code = ncode;
    }
#undef MIX_DECODE
#undef MIX_KROW
#undef MIX_ISSUE
#undef MIX_STORE
#undef MIX_LOADQ
#undef MIX_DECAY
#undef MIX_COMPUTE
#undef MIX_QK
#undef MIX_EW
#undef MIX_PV
}

__device__ __forceinline__ void ret_state_job(const MixP& P, int b, int h, int w, int lane) {
    const float lgf2 = P.lgtab[h], lgb2 = P.lgtab[8 + h];
    int lane_e = lane; asm volatile("" : "+v"(lane_e));
    const int c_e = lane_e & 31, hh_e = lane_e >> 5;
    const int st = w >> 2, dkt = (w >> 1) & 1, dvt = w & 1;
    const float lg = st ? lgb2 : lgf2;
    const bf16* kp = P.RKT + (size_t)(h * 64 + 32 * dkt + c_e) * M_CTX + b * 256 + 8 * hh_e;
    const bf16* vp = P.RVT + (size_t)(h * 64 + 32 * dvt + c_e) * M_TOK + b * 256 + 8 * hh_e;
    f32x16 acc = {};
#pragma nounroll
    for (int bt = 0; bt < 4; ++bt) {
        v4u kr[4]; pg8::bf16x8 vr[4];
#pragma unroll
        for (int i = 0; i < 4; ++i) { kr[i] = *(const v4u*)(kp + 16 * (4 * bt + i)); vr[i] = *(const pg8::bf16x8*)(vp + 16 * (4 * bt + i)); }
#pragma unroll
        for (int i = 0; i < 4; ++i) {
            const int tok0 = 16 * (4 * bt + i) + 8 * hh_e; float kv[8];
            kv[0] = b2f((unsigned short)(kr[i].x & 0xffffu)); kv[1] = b2f((unsigned short)(kr[i].x >> 16)); kv[2] = b2f((unsigned short)(kr[i].y & 0xffffu)); kv[3] = b2f((unsigned short)(kr[i].y >> 16));
            kv[4] = b2f((unsigned short)(kr[i].z & 0xffffu)); kv[5] = b2f((unsigned short)(kr[i].z >> 16)); kv[6] = b2f((unsigned short)(kr[i].w & 0xffffu)); kv[7] = b2f((unsigned short)(kr[i].w >> 16));
#pragma unroll
            for (int j = 0; j < 8; ++j) kv[j] *= __builtin_amdgcn_exp2f((st ? (float)(tok0 + j) : (float)(255 - tok0 - j)) * lg);
            const pg8::bf16x8 kfr = __builtin_bit_cast(pg8::bf16x8, pack8(kv));
            acc = __builtin_amdgcn_mfma_f32_32x32x16_bf16(kfr, vr[i], acc, 0, 0, 0);
        }
    }
    float* so = (st ? P.out_sb : P.out_sf) + ((size_t)(b * 2 + P.layer) * 8 + h) * 4096 + 32 * dvt + c_e;
#pragma unroll
    for (int r = 0; r < 16; ++r) { const int dk = 32 * dkt + (r & 3) + 8 * (r >> 2) + 4 * hh_e; __builtin_nontemporal_store(acc[r], so + dk * 64); }
}

__device__ __forceinline__ void mix_phase(Frame& F, const MixP& P) {
    mix_run<false>(P, F.lds, F.bx, F.G, F.tid);
    __syncthreads();
    mix_run<true>(P, F.lds, F.bx, F.G, F.tid);
}

__global__ void __launch_bounds__(NWAVES * 64, 2) mk_fwd(Params P) {
    extern __shared__ __attribute__((aligned(16))) unsigned char lds_raw[];
    Frame F;
    F.lds = (LAS unsigned char*)lds_raw;
    F.MISC = (volatile LAS unsigned*)(F.lds + MISC_OFF);
    F.wave = __builtin_amdgcn_readfirstlane((int)threadIdx.x >> 6); frame_refresh(F);
    F.G = gridDim.x; F.bx = blockIdx.x;
    unsigned char* ws = P.ws;
    F.ctl = (gu32*)(ws + WS_CTL);
    for (int u = F.tid; u < (LDS_BYTES - LDSCTL_OFF) / 4; u += NWAVES * 64) ((LAS unsigned*)(F.lds + LDSCTL_OFF))[u] = 0u;
    __syncthreads();
    XcdBarrier bar; bar.bar = (unsigned*)(F.ctl + CW_BAR); bar.x = 0; bar.st = nullptr;
    if (!MK_PER_PHASE) bar = xcd_barrier_post((unsigned*)(F.ctl + CW_BAR), F.MISC + 8, F.tid);
    const int lo = P.ph_lo, hi = P.ph_hi;
#define IN(k) (lo <= (k) && (k) < hi)
#define SEAM(k) do { if (IN(k) && IN((k) + 1)) { xcd_barrier(bar, fresh_tid(F.wave)); if (REPS(15) > 1) xcd_barrier(bar, fresh_tid(F.wave)); } } while (0)

    if (PH_EN(0) && IN(0)) { for (int rep = 0; rep < REPS(0); ++rep) { frame_refresh(F); p0_prologue(F, P); if (rep + 1 < REPS(0)) xcd_barrier(bar, fresh_tid(F.wave)); } SEAM(0); }

    const float2* tab64 = (const float2*)(ws + WS_TAB); const float2* tab32 = tab64 + 64 * 16;
    for (int l = 0; l < 2; ++l) {
        const int pb = 1 + 8 * l;
        const bool chain = F.G == 256 && !MK_PER_PHASE;
        unsigned char* wl = ws + WS_W + (size_t)l * LAYER_W;
        const float* mod = (const float*)(ws + WS_MOD) + (size_t)l * 3 * 6144;
        float* const ssb = (float*)(F.ctl + CW_SS);
        float* sskv = ssb + (size_t)(l * 2 + 1) * M_TOK;
        const float* bias = (const float*)(ws + WS_BIAS) + (size_t)l * 3 * BIAS_LD;
        if (l == 0 && PH_EN(1) && IN(pb + 0)) { for (int rep = 0; rep < REPS(1); ++rep) { frame_refresh(F); norm_phase(F, P, 0, 0); cache_rows_job(F, P, 0); if (F.G < 64) bias_job(F, P, F.bx * NWAVES + F.wave, F.G * NWAVES); if (rep + 1 < REPS(1)) xcd_barrier(bar, fresh_tid(F.wave)); } SEAM(pb + 0); }
        if (PH_EN(2) && IN(pb + 1)) {
            unsigned long long zz_ = 0ull; asm volatile("" : "+s"(zz_)); unsigned char* const ws = P.ws + zz_; (void)ws;
            unsigned char* const wl = ws + WS_W + (size_t)l * LAYER_W; (void)wl; const float* const mod = (const float*)(ws + WS_MOD) + (size_t)l * 3 * 6144; (void)mod;
            const float* const bias = (const float*)(ws + WS_BIAS) + (size_t)l * 3 * BIAS_LD; (void)bias; float* const ssb = (float*)(F.ctl + CW_SS); (void)ssb; float* const sskv = ssb + (size_t)(l * 2 + 1) * M_TOK; (void)sskv;
            {
                pg8::Gemm g{(const pg8::bf16_t*)(ws + WS_H), (const pg8::bf16_t*)(wl + W_IN_OFF), M_TOK, N_IN, 1024}; WinOrder S; S.init(M_TOK, N_IN, F.G, F.bx); S.sp = chain;
                EpiG1 E{ws, {P.in[13] + l * 256, P.in[15] + l * 128, P.in[20] + l * 32}, P.out, l, 0, l == 0 ? -1 : 5, chain ? (LAS float*)(F.lds + LDSCTL_OFF + 8192) : (LAS float*)nullptr};
                pg8::gemm_phase<EpiG1, WinOrder, true, true>(F.lds + RING_OFF, g, S, E, fresh_tid(F.wave));
            }
            if (chain) {
                frame_refresh(F);
                const int xk = F.bx >> 3, xx = F.bx & 7;
                if (xk < 10) {
                    const int cpm = 39 - (5 * xx + (xk >> 1));
                    if (F.tid < 256) { const LAS float* lp = (const LAS float*)(F.lds + LDSCTL_OFF + 8192) + F.tid;
                        (((xk & 1) == 0) ? ssb + (size_t)(l * 2) * M_TOK : sskv)[cpm * 256 + F.tid] = (lp[0] + lp[256]) + (lp[512] + lp[768]); }
                    asm volatile("s_waitcnt vmcnt(0)" ::: "memory"); __syncthreads();
                    __builtin_amdgcn_fence(__ATOMIC_ACQUIRE, "agent");
                    if ((xk & 1) == 0) {
                        pg8::Gemm g{(const pg8::bf16_t*)(ws + WS_QA), (const pg8::bf16_t*)(wl + W_QB_OFF), M_TOK, N_Q, 256}; QOrder S; S.init(M_TOK, N_Q, F.G, F.bx); S.cpm = cpm;
                        EpiQ E{ws, P.in[17] + l * 64, P.in[18] + l * 32, l};
                        pg8::gemm_phase<EpiQ, QOrder, true, true>(F.lds + RING_OFF, g, S, E, fresh_tid(F.wave));
                    } else {
                        pg8::Gemm g{(const pg8::bf16_t*)(ws + WS_KVA), (const pg8::bf16_t*)(wl + W_KVB_OFF), M_KV, N_KV, 256}; KvOrder S; S.init(M_KV, N_KV, F.G, F.bx); S.cpm = cpm; S.cn0 = 0; S.cn1 = 4;
                        EpiKV E{ws, P.in[19] + l * 64, l};
                        pg8::gemm_phase<EpiKV, KvOrder, true, true>(F.lds + RING_OFF, g, S, E, fresh_tid(F.wave));
                        if (cpm < 32) {
                            frame_refresh(F); const bf16* KVA = (const bf16*)(ws + WS_KVA);
                            for (int m = cpm * 256 + F.wave; m < cpm * 256 + 256; m += NWAVES) {
                                const float rstd = __builtin_amdgcn_rsqf(sskv[m] * (1.0f / 128.0f) + EPSF);
                                const unsigned pk = *((const unsigned*)(KVA + (size_t)m * 256) + F.lane);
                                float* o = P.out + OUT_CKV + ((size_t)((m >> 8) * 2 + l) * 256 + (m & 255)) * 128 + 2 * F.lane;
                                __builtin_nontemporal_store((f32x2_t){b2f((unsigned short)(pk & 0xffffu)) * rstd, b2f((unsigned short)(pk >> 16)) * rstd}, (f32x2_t*)o);
                            }
                        }
                    }
                } else if (xk >= 28) {
                    if (xk == 28) {
                        pg8::Gemm g{(const pg8::bf16_t*)(ws + WS_KVA), (const pg8::bf16_t*)(wl + W_KVB_OFF), M_KV, N_KV, 256}; KvOrder S; S.init(M_KV, N_KV, F.G, F.bx); S.cpm = 40 + (xx >> 2); S.cn0 = xx & 3; S.cn1 = S.cn0 + 1;
                        EpiKV E{ws, P.in[19] + l * 64, l};
                        pg8::gemm_phase<EpiKV, KvOrder, true, true>(F.lds + RING_OFF, g, S, E, fresh_tid(F.wave));
                    }
                }
                SEAM(pb + 2);
            } else SEAM(pb + 1);
        }
        if (PH_EN(3) && IN(pb + 2) && !chain) {
            unsigned long long zz_ = 0ull; asm volatile("" : "+s"(zz_)); unsigned char* const ws = P.ws + zz_; (void)ws;
            unsigned char* const wl = ws + WS_W + (size_t)l * LAYER_W; (void)wl; const float* const mod = (const float*)(ws + WS_MOD) + (size_t)l * 3 * 6144; (void)mod;
            const float* const bias = (const float*)(ws + WS_BIAS) + (size_t)l * 3 * BIAS_LD; (void)bias; float* const ssb = (float*)(F.ctl + CW_SS); (void)ssb; float* const sskv = ssb + (size_t)(l * 2 + 1) * M_TOK; (void)sskv;
            {
                pg8::Gemm g{(const pg8::bf16_t*)(ws + WS_QA), (const pg8::bf16_t*)(wl + W_QB_OFF), M_TOK, N_Q, 256}; QOrder S; S.init(M_TOK, N_Q, F.G, F.bx); S.cpm = -1;
                EpiQ E{ws, P.in[17] + l * 64, P.in[18] + l * 32, l};
                pg8::gemm_phase<EpiQ, QOrder, true, true>(F.lds + RING_OFF, g, S, E, fresh_tid(F.wave));
            }
            {
                pg8::Gemm g{(const pg8::bf16_t*)(ws + WS_KVA), (const pg8::bf16_t*)(wl + W_KVB_OFF), M_KV, N_KV, 256}; KvOrder S; S.init(M_KV, N_KV, F.G, F.G == 256 ? F.bx : (F.bx + 136) % F.G); S.cpm = -1; S.cn0 = 0; S.cn1 = 0;
                EpiKV E{ws, P.in[19] + l * 64, l};
                pg8::gemm_phase<EpiKV, KvOrder, true, true>(F.lds + RING_OFF, g, S, E, fresh_tid(F.wave));
            }
            {
                frame_refresh(F); const bool sl = F.G == 256;
                const int gw = (sl ? F.bx - 152 : F.bx) * NWAVES + F.wave, NGW = (sl ? 104 : F.G) * NWAVES;
                const bf16* KVA = (const bf16*)(ws + WS_KVA);
                for (int m = gw < 0 ? M_CTX : gw; m < M_CTX; m += NGW) {
                    const float rstd = 1.0f / sqrtf(sskv[m] * (1.0f / 128.0f) + EPSF);
                    const unsigned pk = *((const unsigned*)(KVA + (size_t)m * 256) + F.lane);
                    float* o = P.out + OUT_CKV + ((size_t)((m >> 8) * 2 + l) * 256 + (m & 255)) * 128 + 2 * F.lane;
                    __builtin_nontemporal_store((f32x2_t){b2f((unsigned short)(pk & 0xffffu)) * rstd, b2f((unsigned short)(pk >> 16)) * rstd}, (f32x2_t*)o);
                }
            }
            if (l == 0 && F.G >= 256) { frame_refresh(F); if (F.bx < 120 || F.bx >= 152) bias_job(F, P, (F.bx < 120 ? F.bx : F.bx - 32) * NWAVES + F.wave, (F.G - 32) * NWAVES); }
            else if (l == 0) { frame_refresh(F); bias_job(F, P, F.bx * NWAVES + F.wave, F.G * NWAVES); }
            SEAM(pb + 2);
        }
        if (PH_EN(4) && IN(pb + 3)) {
            unsigned long long zz_ = 0ull; asm volatile("" : "+s"(zz_)); unsigned char* const ws = P.ws + zz_; (void)ws;
            unsigned char* const wl = ws + WS_W + (size_t)l * LAYER_W; (void)wl; const float* const mod = (const float*)(ws + WS_MOD) + (size_t)l * 3 * 6144; (void)mod;
            const float* const bias = (const float*)(ws + WS_BIAS) + (size_t)l * 3 * BIAS_LD; (void)bias; float* const ssb = (float*)(F.ctl + CW_SS); (void)ssb; float* const sskv = ssb + (size_t)(l * 2 + 1) * M_TOK; (void)sskv;
            MixP MP{(const bf16*)(ws + WS_Q), (const bf16*)(ws + WS_KN), (const bf16*)(ws + WS_KR), (const bf16*)(ws + WS_VT), (const bf16*)(ws + WS_RQ), (const bf16*)(ws + WS_RK),
                    (const bf16*)(ws + WS_RKT), (const bf16*)(ws + WS_RVT), (const bf16*)(ws + WS_RG), (bf16*)(ws + WS_MIX), P.in[4], P.in[5], P.in[21] + l * 8, P.in[22] + l * 8,
                    P.in[23] + l * 512, P.in[24] + l * 512, P.out + OUT_SF, P.out + OUT_SB, l, (const float*)(ws + WS_TAB + 16384) + l * 16, (chain && MIX_DEFER) ? 1 : 0};
            for (int rep = 0; rep < REPS(4); ++rep) { frame_refresh(F); mix_phase(F, MP); if (rep + 1 < REPS(4)) xcd_barrier(bar, fresh_tid(F.wave)); }
            SEAM(pb + 3);
        }
        if (PH_EN(5) && IN(pb + 4)) {
            unsigned long long zz_ = 0ull; asm volatile("" : "+s"(zz_)); unsigned char* const ws = P.ws + zz_; (void)ws;
            unsigned char* const wl = ws + WS_W + (size_t)l * LAYER_W; (void)wl; const float* const mod = (const float*)(ws + WS_MOD) + (size_t)l * 3 * 6144; (void)mod;
            const float* const bias = (const float*)(ws + WS_BIAS) + (size_t)l * 3 * BIAS_LD; (void)bias; float* const ssb = (float*)(F.ctl + CW_SS); (void)ssb; float* const sskv = ssb + (size_t)(l * 2 + 1) * M_TOK; (void)sskv;
            pg8::Gemm g{(const pg8::bf16_t*)(ws + WS_MIX), (const pg8::bf16_t*)(wl + W_O_OFF), M_TOK, 1024, 1024}; PanelOrder S; S.init(M_TOK, 1024, F.G, F.bx);
            if (l == 0) { EpiResW<false, true> E{P.in[0], P.in[1], P.out, mod + 2 * 1024, (bf16*)(ws + WS_H), P.in[11] + l * 1024, mod + 4 * 1024, ssb + (size_t)4 * M_TOK, 0, (bf16*)(ws + WS_Q), nullptr};
                pg8::gemm_phase<EpiResW<false, true>, PanelOrder, true, true>(F.lds + RING_OFF, g, S, E, fresh_tid(F.wave)); }
            else { EpiResW<true, true> E{nullptr, nullptr, P.out, mod + 2 * 1024, (bf16*)(ws + WS_H), P.in[11] + l * 1024, mod + 4 * 1024, ssb + (size_t)6 * M_TOK, 0, (bf16*)(ws + WS_Q), (const bf16*)P.out};
                pg8::gemm_phase<EpiResW<true, true>, PanelOrder, true, true>(F.lds + RING_OFF, g, S, E, fresh_tid(F.wave)); }
            if (l == 0 && chain) { frame_refresh(F); if (F.bx >= 160) bias_job(F, P, (F.bx - 160) * NWAVES + F.wave, 96 * NWAVES); }
            SEAM(pb + 4);
        }
        if (PH_EN(7) && IN(pb + 6)) {
            unsigned long long zz_ = 0ull; asm volatile("" : "+s"(zz_)); unsigned char* const ws = P.ws + zz_; (void)ws;
            unsigned char* const wl = ws + WS_W + (size_t)l * LAYER_W; (void)wl; const float* const mod = (const float*)(ws + WS_MOD) + (size_t)l * 3 * 6144; (void)mod;
            const float* const bias = (const float*)(ws + WS_BIAS) + (size_t)l * 3 * BIAS_LD; (void)bias; float* const ssb = (float*)(F.ctl + CW_SS); (void)ssb; float* const sskv = ssb + (size_t)(l * 2 + 1) * M_TOK; (void)sskv;
            if (chain && MIX_DEFER && F.bx >= 112) {
                frame_refresh(F);
                unsigned long long zs_ = 0ull; asm volatile("" : "+s"(zs_)); unsigned char* const wsx = ws + zs_; float* const outx = P.out + zs_;
                MixP SP{nullptr, nullptr, nullptr, nullptr, nullptr, nullptr, (const bf16*)(wsx + WS_RKT), (const bf16*)(wsx + WS_RVT), nullptr, nullptr, nullptr, nullptr, nullptr, nullptr,
                        nullptr, nullptr, outx + OUT_SF, outx + OUT_SB, l, (const float*)(wsx + WS_TAB + 16384) + l * 16, 1};
                for (int uu = F.bx - 112; uu < 256; uu += 144) ret_state_job(SP, uu >> 3, uu & 7, F.wave, F.lane);
            }
            pg8::Gemm g{(const pg8::bf16_t*)(ws + WS_H), (const pg8::bf16_t*)(wl + W_FI_OFF), M_TOK, N_FI, 1024}; pg8::StaticOrder S; S.init(M_TOK, N_FI, F.G, F.bx);
            EpiFfn E{(bf16*)(ws + WS_ACT), ssb + (size_t)(l == 0 ? 4 : 6) * M_TOK, bias + 2560};
            for (int rep = 0; rep < REPS(7); ++rep) { pg8::gemm_phase<EpiFfn, pg8::StaticOrder, true, true>(F.lds + RING_OFF, g, S, E, fresh_tid(F.wave)); if (rep + 1 < REPS(7)) xcd_barrier(bar, fresh_tid(F.wave)); }
            SEAM(pb + 6);
        }
        if (PH_EN(8) && IN(pb + 7)) {
            unsigned long long zz_ = 0ull; asm volatile("" : "+s"(zz_)); unsigned char* const ws = P.ws + zz_; (void)ws;
            unsigned char* const wl = ws + WS_W + (size_t)l * LAYER_W; (void)wl; const float* const mod = (const float*)(ws + WS_MOD) + (size_t)l * 3 * 6144; (void)mod;
            const float* const bias = (const float*)(ws + WS_BIAS) + (size_t)l * 3 * BIAS_LD; (void)bias; float* const ssb = (float*)(F.ctl + CW_SS); (void)ssb; float* const sskv = ssb + (size_t)(l * 2 + 1) * M_TOK; (void)sskv;
            pg8::Gemm g{(const pg8::bf16_t*)(ws + WS_ACT), (const pg8::bf16_t*)(wl + W_FO_OFF), M_TOK, 1024, D_FFN}; SplitOrder<FO_NMAIN, D_FFN / 64> S; S.init(M_TOK, 1024, F.G, F.bx);
            S.slab = (float*)(ws + WS_RQ); S.flags = (unsigned*)(F.ctl + CW_SPLIT); S.epoch = (unsigned)(pb + 8);
            if (l == 0) { EpiResW<true, true> E{nullptr, nullptr, P.out, mod + 5 * 1024, (bf16*)(ws + WS_H), P.in[10] + 1024, (const float*)(ws + WS_MOD) + (size_t)3 * 6144 + 1 * 1024, ssb + (size_t)5 * M_TOK, 0, (bf16*)P.out, (const bf16*)(ws + WS_Q)};
                pg8::gemm_phase<EpiResW<true, true>, SplitOrder<FO_NMAIN, D_FFN / 64>, true, true>(F.lds + RING_OFF, g, S, E, fresh_tid(F.wave)); }
            else { EpiResW<true, false> E{nullptr, nullptr, P.out, mod + 5 * 1024, (bf16*)(ws + WS_H), nullptr, (const float*)(ws + WS_MOD) + (size_t)3 * 6144 + 1 * 1024, ssb + (size_t)5 * M_TOK, 1, nullptr, (const bf16*)(ws + WS_Q)};
                pg8::gemm_phase<EpiResW<true, false>, SplitOrder<FO_NMAIN, D_FFN / 64>, true, true>(F.lds + RING_OFF, g, S, E, fresh_tid(F.wave)); }
            if (l == 0) { frame_refresh(F); cache_rows_job(F, P, 1); SEAM(pb + 7); }
        }
    }
#undef IN
#undef SEAM
}

extern "C" void kernel_launch(void* const* d_in, const int* in_sizes, int n_in, void* d_out, int out_size, void* d_ws, size_t ws_size, hipStream_t stream) {
    static int grid = 0;
    if (grid == 0) {
        if (n_in != 28 || out_size != (int)OUT_TOTAL || ws_size < WS_END) { fprintf(stderr, "kernel_launch: unexpected shapes (n_in %d, out %d, ws %zu); nothing launched\n", n_in, out_size, ws_size); grid = -1; return; }
        int dev = 0, cus = 0, per_cu = 0;
        if (hipGetDevice(&dev) != hipSuccess || hipDeviceGetAttribute(&cus, hipDeviceAttributeMultiprocessorCount, dev) != hipSuccess) { grid = -1; return; }
        if (hipFuncSetAttribute((const void*)mk_fwd, hipFuncAttributeMaxDynamicSharedMemorySize, LDS_BYTES) != hipSuccess) { fprintf(stderr, "kernel_launch: hipFuncSetAttribute failed\n"); grid = -1; return; }
        if (hipOccupancyMaxActiveBlocksPerMultiprocessor(&per_cu, (const void*)mk_fwd, NWAVES * 64, LDS_BYTES) != hipSuccess || per_cu < 1) { fprintf(stderr, "kernel_launch: occupancy query reports %d blocks per CU\n", per_cu); }
        (void)hipGetLastError();
        grid = cus;
    }
    if (grid < 0) return;
    if (hipMemsetAsync((char*)d_ws + WS_CTL, 0, CTL_ZERO_BYTES, stream) != hipSuccess) { fprintf(stderr, "kernel_launch: memset failed\n"); return; }
    Params p{};
    for (int i = 0; i < 28; ++i) p.in[i] = (const float*)d_in[i];
    p.out = (float*)d_out; p.ws = (unsigned char*)d_ws;
#if MK_PER_PHASE
    for (int ph = 0; ph < N_PHASES; ++ph) { p.ph_lo = ph; p.ph_hi = ph + 1; hipLaunchKernelGGL(mk_fwd, dim3(grid), dim3(NWAVES * 64), LDS_BYTES, stream, p); }
#else
    p.ph_lo = 0; p.ph_hi = N_PHASES;
    hipLaunchKernelGGL(mk_fwd, dim3(grid), dim3(NWAVES * 64), LDS_BYTES, stream, p);
#endif
    const hipError_t le = hipPeekAtLastError();
    if (le != hipSuccess) fprintf(stderr, "kernel_launch: launch failed: %s\n", hipGetErrorName(le));
}
```
